# Optimizing an MI355X kernel written in HIP

```python
import jax, jax.numpy as jnp
from jax import lax
import numpy as np

D_MODEL = 2048
BATCH = 1
SEQ = 8192
DEPTH = 2

N_HEADS_A = D_MODEL // 256
HEAD_DIM_A = 128
WIDTH_A = N_HEADS_A * HEAD_DIM_A
MOBA_BLOCK = 256
MOBA_TOPK = 3
Q_CHUNK = 128
SGU_WIDTH = D_MODEL // 2
SGU_GROUPS = 8
SGU_GROUP_DIM = SGU_WIDTH // SGU_GROUPS
SGU_CHUNK = 128
N_MEM = 256
N_HEADS_M = 4
HEAD_DIM_M = D_MODEL // 8
WIDTH_M = N_HEADS_M * HEAD_DIM_M
D_FF = -(-8 * D_MODEL // (3 * 256)) * 256
N_BRANCH = 3
W_IN_COLS = 3 * WIDTH_A + 2 * SGU_WIDTH + WIDTH_M + N_BRANCH * D_MODEL
SPLITS = [WIDTH_A, 2 * WIDTH_A, 3 * WIDTH_A, 3 * WIDTH_A + SGU_WIDTH,
          3 * WIDTH_A + 2 * SGU_WIDTH, 3 * WIDTH_A + 2 * SGU_WIDTH + WIDTH_M]
NEG_INF = -1e30
EPS = 1e-6

kernel_name = 'hybrid_moba_gmlp_memxattn_block'


def rmsnorm(x, g):
    xf = x.astype(jnp.float32)
    y = xf * lax.rsqrt(jnp.mean(xf * xf, axis=-1, keepdims=True) + EPS)
    return (y * g.astype(jnp.float32)).astype(x.dtype)


def alibi_slopes(n_heads):
    return 2.0 ** (-8.0 * jnp.arange(1, n_heads + 1, dtype=jnp.float32) / n_heads)


def moba_attention(q, k, v):
    B, H, S, dh = q.shape
    nb = -(-S // MOBA_BLOCK)
    pad = nb * MOBA_BLOCK - S
    kb = jnp.pad(k, ((0, 0), (0, 0), (0, pad), (0, 0))).reshape(B, H, nb, MOBA_BLOCK, dh)
    vb = jnp.pad(v, ((0, 0), (0, 0), (0, pad), (0, 0))).reshape(B, H, nb, MOBA_BLOCK, dh)
    slopes = alibi_slopes(H)
    q = q * dh ** -0.5
    kmean = jnp.mean(kb.astype(jnp.float32), axis=3)
    gate = jnp.einsum('bhtd,bhnd->bhtn', q.astype(jnp.float32), kmean)
    q_block = jnp.arange(S) // MOBA_BLOCK
    past = jnp.arange(nb)[None, :] < q_block[:, None]
    gate = jnp.where(past, gate, NEG_INF)
    n_sel = min(MOBA_TOPK, nb)
    _, sel = lax.top_k(gate, n_sel)
    nq = S // Q_CHUNK
    qc = jnp.moveaxis(q.reshape(B, H, nq, Q_CHUNK, dh), 2, 0)
    selc = jnp.moveaxis(sel.reshape(B, H, nq, Q_CHUNK, n_sel), 2, 0)
    bi = jnp.arange(B)[:, None, None, None]
    hi = jnp.arange(H)[None, :, None, None]

    def one_chunk(args):
        qi, si, c = args
        t = c * Q_CHUNK + jnp.arange(Q_CHUNK)
        own = (c * Q_CHUNK) // MOBA_BLOCK
        k_sel = kb[bi, hi, si]
        v_sel = vb[bi, hi, si]
        s_pos = si[..., None] * MOBA_BLOCK + jnp.arange(MOBA_BLOCK)
        sc_sel = jnp.einsum('bhqd,bhqnkd->bhqnk', qi, k_sel).astype(jnp.float32)
        dist_sel = (t[None, None, :, None, None] - s_pos).astype(jnp.float32)
        sc_sel = sc_sel - slopes[None, :, None, None, None] * dist_sel
        valid = jnp.arange(n_sel) < own
        sc_sel = jnp.where(valid[:, None], sc_sel, NEG_INF)
        k_own = lax.dynamic_index_in_dim(kb, own, axis=2, keepdims=False)
        v_own = lax.dynamic_index_in_dim(vb, own, axis=2, keepdims=False)
        o_pos = own * MOBA_BLOCK + jnp.arange(MOBA_BLOCK)
        dist_own = (t[:, None] - o_pos[None, :]).astype(jnp.float32)
        sc_own = jnp.einsum('bhqd,bhkd->bhqk', qi, k_own).astype(jnp.float32)
        sc_own = jnp.where(dist_own >= 0, sc_own - slopes[None, :, None, None] * dist_own, NEG_INF)
        sc = jnp.concatenate([sc_sel.reshape(B, H, Q_CHUNK, n_sel * MOBA_BLOCK), sc_own], axis=-1)
        p = jax.nn.softmax(sc, axis=-1).astype(v.dtype)
        p_sel = p[..., :n_sel * MOBA_BLOCK].reshape(B, H, Q_CHUNK, n_sel, MOBA_BLOCK)
        p_own = p[..., n_sel * MOBA_BLOCK:]
        return (jnp.einsum('bhqnk,bhqnkd->bhqd', p_sel, v_sel)
                + jnp.einsum('bhqk,bhkd->bhqd', p_own, v_own))

    out = lax.map(one_chunk, (qc, selc, jnp.arange(nq)))
    return jnp.moveaxis(out, 0, 2).reshape(B, H, S, dh)


def spatial_gating(u, v, g, w_s, b_s):
    B, S, _ = u.shape
    u = jax.nn.gelu(u)
    v = rmsnorm(jax.nn.gelu(v), g)
    nc = S // SGU_CHUNK
    vc = v.reshape(B, nc, SGU_CHUNK, SGU_GROUPS, SGU_GROUP_DIM)
    w = w_s * jnp.tril(jnp.ones((SGU_CHUNK, SGU_CHUNK), dtype=w_s.dtype))
    mixed = jnp.einsum('gts,bnsgc->bntgc', w, vc) + b_s.T[None, None, :, :, None]
    return u * mixed.reshape(B, S, SGU_WIDTH)


def memory_attention(qm, km, vm):
    sc = jnp.einsum('bshd,bmhd->bhsm', qm, km).astype(jnp.float32) * HEAD_DIM_M ** -0.5
    p = jax.nn.softmax(sc, axis=-1).astype(vm.dtype)
    return jnp.einsum('bhsm,bmhd->bshd', p, vm)


def setup_inputs(seed: int = 0) -> dict:
    key = jax.random.key(seed)
    ks = jax.random.split(key, 20)
    f32 = jnp.float32

    def nrm(k, shape, fan_in):
        return jax.random.normal(k, shape, f32) * fan_in ** -0.5

    def gain(k, shape):
        return 1.0 + 0.01 * jax.random.normal(k, shape, f32)

    return {
        'x': jax.random.normal(ks[0], (BATCH, SEQ, D_MODEL), f32),
        'mem': jax.random.normal(ks[1], (BATCH, N_MEM, D_MODEL), f32),
        'g_mix': gain(ks[2], (DEPTH, D_MODEL)),
        'w_in': nrm(ks[3], (DEPTH, D_MODEL, W_IN_COLS), D_MODEL),
        'gq_a': gain(ks[4], (DEPTH, HEAD_DIM_A)),
        'gk_a': gain(ks[5], (DEPTH, HEAD_DIM_A)),
        'g_sgu': gain(ks[6], (DEPTH, SGU_WIDTH)),
        'w_sgu': nrm(ks[7], (DEPTH, SGU_GROUPS, SGU_CHUNK, SGU_CHUNK), SGU_CHUNK),
        'b_sgu': gain(ks[8], (DEPTH, SGU_GROUPS, SGU_CHUNK)),
        'gq_m': gain(ks[9], (DEPTH, HEAD_DIM_M)),
        'gk_m': gain(ks[10], (DEPTH, HEAD_DIM_M)),
        'g_mem': gain(ks[11], (DEPTH, D_MODEL)),
        'w_mem_kv': nrm(ks[12], (DEPTH, D_MODEL, 2 * WIDTH_M), D_MODEL),
        'w_branch': nrm(ks[13], (DEPTH, N_BRANCH, WIDTH_A, D_MODEL), WIDTH_A),
        'w_out': nrm(ks[14], (DEPTH, D_MODEL, D_MODEL), D_MODEL),
        'g_ffn': gain(ks[15], (DEPTH, D_MODEL)),
        'w_gate_up': nrm(ks[16], (DEPTH, D_MODEL, 2 * D_FF), D_MODEL),
        'w_down': nrm(ks[17], (DEPTH, D_FF, D_MODEL), D_FF),
    }


def reference(x, mem, g_mix, w_in, gq_a, gk_a, g_sgu, w_sgu, b_sgu, gq_m, gk_m, g_mem,
              w_mem_kv, w_branch, w_out, g_ffn, w_gate_up, w_down):
    B, S, _ = x.shape
    M = mem.shape[1]
    for l in range(DEPTH):
        h = rmsnorm(x, g_mix[l])
        z = h @ w_in[l]
        qa, ka, va, ub, vb, qm, gates = jnp.split(z, SPLITS, axis=-1)
        qa = rmsnorm(qa.reshape(B, S, N_HEADS_A, HEAD_DIM_A), gq_a[l]).transpose(0, 2, 1, 3)
        ka = rmsnorm(ka.reshape(B, S, N_HEADS_A, HEAD_DIM_A), gk_a[l]).transpose(0, 2, 1, 3)
        va = va.reshape(B, S, N_HEADS_A, HEAD_DIM_A).transpose(0, 2, 1, 3)
        ya = moba_attention(qa, ka, va).transpose(0, 2, 1, 3).reshape(B, S, WIDTH_A)
        yb = spatial_gating(ub, vb, g_sgu[l], w_sgu[l], b_sgu[l])
        kvm = rmsnorm(mem, g_mem[l]) @ w_mem_kv[l]
        km, vm = jnp.split(kvm, 2, axis=-1)
        km = rmsnorm(km.reshape(B, M, N_HEADS_M, HEAD_DIM_M), gk_m[l])
        vm = vm.reshape(B, M, N_HEADS_M, HEAD_DIM_M)
        qm = rmsnorm(qm.reshape(B, S, N_HEADS_M, HEAD_DIM_M), gq_m[l])
        ym = memory_attention(qm, km, vm).reshape(B, S, WIDTH_M)
        ga, gb, gm = jnp.split(jax.nn.sigmoid(gates), N_BRANCH, axis=-1)
        merged = (ga * (ya @ w_branch[l, 0]) + gb * (yb @ w_branch[l, 1])
                  + gm * (ym @ w_branch[l, 2]))
        x = x + merged @ w_out[l]
        hf = rmsnorm(x, g_ffn[l])
        gt, up = jnp.split(hf @ w_gate_up[l], 2, axis=-1)
        x = x + (jax.nn.silu(gt) * up) @ w_down[l]
    return x
```

```cpp
#include <hip/hip_runtime.h>
#include <hip/hip_cooperative_groups.h>
#include <cstdio>
#include <cstdint>
namespace cg = cooperative_groups;

#define LAS __attribute__((address_space(3)))
#define GAS __attribute__((address_space(1)))
typedef unsigned short e16_t;
typedef short h8 __attribute__((ext_vector_type(8)));
typedef short h4 __attribute__((ext_vector_type(4)));
typedef __bf16 mf8 __attribute__((ext_vector_type(8)));
typedef __bf16 mf2 __attribute__((ext_vector_type(2)));
typedef float f32x2 __attribute__((ext_vector_type(2)));
typedef float f32x4 __attribute__((ext_vector_type(4)));
typedef float f32x16 __attribute__((ext_vector_type(16)));
typedef unsigned u32x2 __attribute__((ext_vector_type(2)));
typedef unsigned u32x4 __attribute__((ext_vector_type(4)));

#define MFMA32(a, b, c) __builtin_amdgcn_mfma_f32_32x32x16_bf16(__builtin_bit_cast(mf8, (a)), __builtin_bit_cast(mf8, (b)), (c), 0, 0, 0)
#define MFMA16(a, b, c) __builtin_amdgcn_mfma_f32_16x16x32_bf16(__builtin_bit_cast(mf8, (a)), __builtin_bit_cast(mf8, (b)), (c), 0, 0, 0)

__device__ __forceinline__ unsigned cvt_pk(float lo, float hi) { f32x2 v = {lo, hi}; mf2 b = __builtin_convertvector(v, mf2); return __builtin_bit_cast(unsigned, b); }
__device__ __forceinline__ float up16(short x) { return __uint_as_float(((unsigned)(unsigned short)x) << 16); }
__device__ __forceinline__ float up_lo(unsigned w) { return __uint_as_float(w << 16); }
__device__ __forceinline__ float up_hi(unsigned w) { return __uint_as_float(w & 0xffff0000u); }
__device__ __forceinline__ h8 pack8(const float* f) { u32x4 w = {cvt_pk(f[0], f[1]), cvt_pk(f[2], f[3]), cvt_pk(f[4], f[5]), cvt_pk(f[6], f[7])}; return __builtin_bit_cast(h8, w); }
__device__ __forceinline__ float wave_sum(float v) {
#pragma unroll
    for (int o = 1; o < 64; o <<= 1) v += __shfl_xor(v, o);
    return v;
}
__device__ __forceinline__ float gelu_tanh(float x) {
    const float u = 0.7978845608028654f * (x + 0.044715f * x * x * x);
    return x / (1.0f + __builtin_amdgcn_exp2f(-2.885390081777927f * u));
}
__device__ __forceinline__ float sigmoidf_(float x) { return 1.0f / (1.0f + __builtin_amdgcn_exp2f(-1.4426950408889634f * x)); }
__device__ __forceinline__ int crow(int r, int hi) { return (r & 3) + 8 * (r >> 2) + 4 * hi; }

constexpr int S_ = 8192, D_ = 2048, NLAYER = 2;
constexpr int HA = 8, DA = 128, NBLK = 32;
constexpr int HM = 4, DMH = 256, NMEM = 256;
constexpr int DFF = 5632, WINC = 12288;
constexpr int ZP = 4096, ZN = 10240;
constexpr int ZQ = 0, ZK = 1024, ZU = 2048, ZQM = 3072, ZG = 4096;
constexpr int ZTP = 8192;
constexpr int YP = 3072;
constexpr float EPS = 1e-6f, LOG2E = 1.4426950408889634f;

constexpr size_t MiB = 1u << 20;
constexpr size_t WS_CTL = 0;
constexpr size_t WL_IN = 0, WL_B = 48 * MiB, WL_O = 60 * MiB, WL_GU = 68 * MiB, WL_D = 112 * MiB, WL_M = 134 * MiB, WL_SIZE = 142 * MiB;
constexpr size_t WS_W = 1 * MiB;
constexpr size_t WS_HN = WS_W + 2 * WL_SIZE;
constexpr size_t WS_Z = WS_HN + 32 * MiB;
constexpr size_t WS_GATE = WS_Z + 64 * MiB;
constexpr size_t WS_ZT = WS_GATE + 96 * MiB;
constexpr size_t WS_Y = WS_ZT + 32 * MiB;
constexpr size_t WS_PART = WS_Y + 48 * MiB;
constexpr size_t WS_MG = WS_PART + 64 * MiB;
constexpr size_t WS_MEMN = WS_MG + 32 * MiB;
constexpr size_t WS_KM = WS_MEMN + 2 * MiB;
constexpr size_t WS_VMT = WS_KM + 1 * MiB;
constexpr size_t WS_KMEAN = WS_VMT + 1 * MiB;
constexpr size_t WS_RSSV = WS_KMEAN + 256 * 1024;
constexpr size_t WS_RSS = WS_RSSV + 64 * 1024;
constexpr size_t WS_RSTDV = WS_RSSV + 384 * 1024;
constexpr size_t WS_LIST = WS_RSSV + 512 * 1024;
constexpr size_t WS_ML = WS_LIST + 8 * MiB;
constexpr size_t WS_SEL = WS_ML + 2 * MiB;
constexpr size_t WS_ONES = WS_SEL + 1 * MiB;
constexpr size_t WS_END = WS_ONES + 1 * MiB;
constexpr int CW_CNT = 2048;

namespace pg8 {
constexpr int EPI_OFF = 139264;
constexpr int BM = 256, BK = 64, HALF = 128, HTB = HALF * BK * 2, STAGE_BYTES = 8 * HTB, NXCD = 8, WGM = 8;
__host__ __device__ __forceinline__ int lds_byte(int r, int c) { const int st = (r >> 4) * 2 + (c >> 5), rr = r & 15, cc = c & 31, ob = rr * 64 + cc * 2; return st * 1024 + (ob ^ (((ob >> 9) & 1) << 5)); }
__host__ __device__ __forceinline__ void stage_rc(int b, int& R, int& C) { const int st = b / 1024, sb = b % 1024, swz = sb ^ (((sb >> 9) & 1) << 5); R = (st >> 1) * 16 + swz / 64; C = (st & 1) * 32 + (swz % 64) / 2; }
__host__ __device__ __forceinline__ int perm32(int rho) { const int n = rho >> 4, i = rho & 15; return 8 * (i >> 2) + 4 * n + (i & 3); }

struct Unit { int pm, pn; };
struct Gemm { const e16_t* A; const e16_t* Bt; int M, N, K, lda, ldb; };

struct StaticOrder {
    int nM, nN, nwg, G, c;
    __host__ __device__ void init(int M, int N, int G_, int c_) { nM = M / BM; nN = N / BM; nwg = nM * nN; G = G_; c = c_; }
    __host__ __device__ bool next(int i, Unit& u) const {
        const long L = (long)i * G + c; if (L >= nwg) return false;
        int wgid = (int)L; { const int q = nwg / NXCD, r = nwg % NXCD, xcd = wgid % NXCD, off = wgid / NXCD; wgid = (xcd < r ? xcd * (q + 1) : r * (q + 1) + (xcd - r) * q) + off; }
        const int nig = WGM * nN, gid = wgid / nig, fm = gid * WGM, gsz = (nM - fm) < WGM ? (nM - fm) : WGM;
        u.pm = fm + ((wgid % nig) % gsz); u.pn = (wgid % nig) / gsz; return true;
    }
    __device__ __forceinline__ void a_ready(const Unit&) const {}
    __device__ __forceinline__ void done(const Unit&) const {}
};

#ifndef ST_AUX
#define ST_AUX 0
#endif
struct WT {
    __amdgpu_buffer_rsrc_t r;
    __device__ __forceinline__ explicit WT(const void* p) : r(__builtin_amdgcn_make_buffer_rsrc((void*)p, 0, 0x7fffffff, 0x00020000)) {}
    __device__ __forceinline__ void st(unsigned byteoff, u32x4 v) const { __builtin_amdgcn_raw_buffer_store_b128(v, r, byteoff, 0, ST_AUX); }
    __device__ __forceinline__ void stf(unsigned byteoff, f32x4 v) const { __builtin_amdgcn_raw_buffer_store_b128(__builtin_bit_cast(u32x4, v), r, byteoff, 0, ST_AUX); }
};
typedef unsigned long long fx_t;
constexpr float FX_ONE = 1048576.f, FX_INV = 1.f / 1048576.f;
__device__ __forceinline__ float fx2f(fx_t v) { return (float)v * FX_INV; }
__device__ __forceinline__ fx_t f2fx(float v) { return (fx_t)(v * FX_ONE); }
__device__ __forceinline__ float rstd_of(float ss) { return rsqrtf(ss * (1.f / 2048.f) + 1e-6f); }
struct EpiStore16 {
    static constexpr bool PERM = true, HAS_MID = false;
    e16_t* O; int ldc; const fx_t* rss; int mode; fx_t* rssv;
    __device__ __forceinline__ void operator()(const f32x4 (&acc)[2][2][4][2], const Unit& u, int wr, int wc, int fr, int fq) const {
        const int row0 = u.pm * BM + wr * 64 + fr, col0 = u.pn * BM + wc * 32 + 8 * fq;
        f32x4 cs[2][2];
#pragma unroll
        for (int bj = 0; bj < 2; ++bj)
#pragma unroll
            for (int n = 0; n < 2; ++n) { cs[bj][n] = (f32x4){1.f, 1.f, 1.f, 1.f};
                if (mode == 2) { const fx_t* rp = rss + col0 + bj * HALF + 4 * n; cs[bj][n] = (f32x4){rstd_of(fx2f(rp[0])), rstd_of(fx2f(rp[1])), rstd_of(fx2f(rp[2])), rstd_of(fx2f(rp[3]))}; } }
        const WT wt(O); const bool dogelu = (mode == 2) && rssv != nullptr && u.pm >= 4;
        float sq[2][8];
#pragma unroll
        for (int bj = 0; bj < 2; ++bj)
#pragma unroll
            for (int e = 0; e < 8; ++e) sq[bj][e] = 0.f;
        float rsv[2][4];
#pragma unroll
        for (int ai = 0; ai < 2; ++ai)
#pragma unroll
            for (int m = 0; m < 4; ++m) rsv[ai][m] = (mode == 1) ? fx2f(rss[row0 + ai * HALF + m * 16]) : 0.f;
#pragma unroll
        for (int ai = 0; ai < 2; ++ai)
#pragma unroll
            for (int m = 0; m < 4; ++m) { const int row = row0 + ai * HALF + m * 16; const unsigned rowb = (unsigned)(row * ldc + col0) * 2u;
                const float rs = (mode == 1) ? rstd_of(rsv[ai][m]) : 1.f;
#pragma unroll
                for (int bj = 0; bj < 2; ++bj) { f32x4 v0 = acc[ai][bj][m][0] * cs[bj][0] * rs, v1 = acc[ai][bj][m][1] * cs[bj][1] * rs;
                    if (dogelu) {
#pragma unroll
                        for (int e = 0; e < 4; ++e) { v0[e] = gelu_tanh(v0[e]); v1[e] = gelu_tanh(v1[e]); sq[bj][e] += v0[e] * v0[e]; sq[bj][4 + e] += v1[e] * v1[e]; } }
                    u32x4 w; w.x = cvt_pk(v0[0], v0[1]); w.y = cvt_pk(v0[2], v0[3]); w.z = cvt_pk(v1[0], v1[1]); w.w = cvt_pk(v1[2], v1[3]);
                    wt.st(rowb + bj * HALF * 2, w); } }
        if (dogelu) {
#pragma unroll
            for (int bj = 0; bj < 2; ++bj)
#pragma unroll
                for (int e = 0; e < 8; ++e) { float v = sq[bj][e]; v += __shfl_xor(v, 1); v += __shfl_xor(v, 2); v += __shfl_xor(v, 4); v += __shfl_xor(v, 8);
                    if (fr == 0) atomicAdd(rssv + col0 + bj * HALF + e, f2fx(v)); } }
    }
};
struct EpiSwiGLU {
    static constexpr bool PERM = true, HAS_MID = false;
    e16_t* O; int ldc; const fx_t* rss;
    __device__ __forceinline__ void operator()(const f32x4 (&acc)[2][2][4][2], const Unit& u, int wr, int wc, int fr, int fq) const {
        const int row0 = u.pm * BM + wr * 64 + fr, col0 = u.pn * HALF + wc * 32 + 8 * fq;
        const WT wt(O);
        float rsv[2][4];
#pragma unroll
        for (int ai = 0; ai < 2; ++ai)
#pragma unroll
            for (int m = 0; m < 4; ++m) rsv[ai][m] = fx2f(rss[row0 + ai * HALF + m * 16]);
#pragma unroll
        for (int ai = 0; ai < 2; ++ai)
#pragma unroll
            for (int m = 0; m < 4; ++m) { const int row = row0 + ai * HALF + m * 16; const unsigned rowb = (unsigned)(row * ldc + col0) * 2u; const float rs = rstd_of(rsv[ai][m]);
                float hv[8];
#pragma unroll
                for (int n = 0; n < 2; ++n)
#pragma unroll
                    for (int i = 0; i < 4; ++i) { const float g = acc[ai][0][m][n][i] * rs, up = acc[ai][1][m][n][i] * rs; hv[n * 4 + i] = g * sigmoidf_(g) * up; }
                u32x4 w; w.x = cvt_pk(hv[0], hv[1]); w.y = cvt_pk(hv[2], hv[3]); w.z = cvt_pk(hv[4], hv[5]); w.w = cvt_pk(hv[6], hv[7]);
                wt.st(rowb, w); }
    }
};
struct EpiRes {
    static constexpr bool PERM = true, HAS_MID = false;
    const float* base; const e16_t* base16; float* out; e16_t* xb; fx_t* rss; int ldc;
    __device__ __forceinline__ void operator()(const f32x4 (&acc)[2][2][4][2], const Unit& u, int wr, int wc, int fr, int fq) const {
        const int row0 = u.pm * BM + wr * 64 + fr, col0 = u.pn * BM + wc * 32 + 8 * fq;
        const WT wo(out ? (const void*)out : (const void*)xb), wx(xb ? (const void*)xb : (const void*)out);
        if (base16) {
            h8 raw[2][4][2];
#pragma unroll
            for (int ai = 0; ai < 2; ++ai)
#pragma unroll
                for (int m = 0; m < 4; ++m) { const e16_t* bp = base16 + (size_t)(row0 + ai * HALF + m * 16) * ldc + col0;
#pragma unroll
                    for (int bj = 0; bj < 2; ++bj) raw[ai][m][bj] = *(const h8*)(bp + bj * HALF); }
#pragma unroll
            for (int ai = 0; ai < 2; ++ai)
#pragma unroll
                for (int m = 0; m < 4; ++m) { const int row = row0 + ai * HALF + m * 16; const size_t off = (size_t)row * ldc + col0; float ss = 0.f;
#pragma unroll
                    for (int bj = 0; bj < 2; ++bj) { const h8 r = raw[ai][m][bj];
                        const f32x4 v0 = (f32x4){up16(r[0]), up16(r[1]), up16(r[2]), up16(r[3])} + acc[ai][bj][m][0], v1 = (f32x4){up16(r[4]), up16(r[5]), up16(r[6]), up16(r[7])} + acc[ai][bj][m][1];
                        if (out) { wo.stf((unsigned)(off + bj * HALF) * 4u, v0); wo.stf((unsigned)(off + bj * HALF + 4) * 4u, v1); }
                        ss += (v0[0] * v0[0] + v0[1] * v0[1]) + (v0[2] * v0[2] + v0[3] * v0[3]) + (v1[0] * v1[0] + v1[1] * v1[1]) + (v1[2] * v1[2] + v1[3] * v1[3]);
                        if (xb) { u32x4 w; w.x = cvt_pk(v0[0], v0[1]); w.y = cvt_pk(v0[2], v0[3]); w.z = cvt_pk(v1[0], v1[1]); w.w = cvt_pk(v1[2], v1[3]); wx.st((unsigned)(off + bj * HALF) * 2u, w); } }
                    if (rss) { ss += __shfl_xor(ss, 16); ss += __shfl_xor(ss, 32); if (fq == 0) atomicAdd(rss + row, f2fx(ss)); } }
            return; }
#pragma unroll
        for (int ai = 0; ai < 2; ++ai) {
            f32x4 bv[4][2][2];
#pragma unroll
            for (int m = 0; m < 4; ++m) { const float* bp = base + (size_t)(row0 + ai * HALF + m * 16) * ldc + col0;
#pragma unroll
                for (int bj = 0; bj < 2; ++bj) { bv[m][bj][0] = *(const f32x4*)(bp + bj * HALF); bv[m][bj][1] = *(const f32x4*)(bp + bj * HALF + 4); } }
#pragma unroll
            for (int m = 0; m < 4; ++m) { const int row = row0 + ai * HALF + m * 16; const size_t off = (size_t)row * ldc + col0; float ss = 0.f;
#pragma unroll
                for (int bj = 0; bj < 2; ++bj) { const f32x4 v0 = bv[m][bj][0] + acc[ai][bj][m][0], v1 = bv[m][bj][1] + acc[ai][bj][m][1];
                    if (out) { wo.stf((unsigned)(off + bj * HALF) * 4u, v0); wo.stf((unsigned)(off + bj * HALF + 4) * 4u, v1); }
                    ss += (v0[0] * v0[0] + v0[1] * v0[1]) + (v0[2] * v0[2] + v0[3] * v0[3]) + (v1[0] * v1[0] + v1[1] * v1[1]) + (v1[2] * v1[2] + v1[3] * v1[3]);
                    if (xb) { u32x4 w; w.x = cvt_pk(v0[0], v0[1]); w.y = cvt_pk(v0[2], v0[3]); w.z = cvt_pk(v1[0], v1[1]); w.w = cvt_pk(v1[2], v1[3]); wx.st((unsigned)(off + bj * HALF) * 2u, w); } }
                if (rss) { ss += __shfl_xor(ss, 16); ss += __shfl_xor(ss, 32); if (fq == 0) atomicAdd(rss + row, f2fx(ss)); } }
        }
    }
};

struct EpiZ {
    static constexpr bool PERM = true, HAS_MID = false;
    e16_t* Z; e16_t* GATE; const fx_t* rss; LAS unsigned char* lds; const float* gk; float* kmean;
    __device__ __forceinline__ void operator()(const f32x4 (&acc)[2][2][4][2], const Unit& u, int wr, int wc, int fr, int fq) const {
        const int row0 = u.pm * BM + wr * 64 + fr, col0 = u.pn * BM + wc * 32 + 8 * fq;
        const WT wz(Z), wg(GATE);
        float rsv[2][4];
#pragma unroll
        for (int ai = 0; ai < 2; ++ai)
#pragma unroll
            for (int m = 0; m < 4; ++m) rsv[ai][m] = fx2f(rss[row0 + ai * HALF + m * 16]);
        if (u.pn >= 4 && u.pn < 8) {
            LAS float* P = (LAS float*)(lds + EPI_OFF); LAS float* KS = P + 2048;
#pragma unroll
            for (int ai = 0; ai < 2; ++ai)
#pragma unroll
                for (int m = 0; m < 4; ++m) { const float rs = rstd_of(rsv[ai][m]); const int rl = ai * HALF + wr * 64 + m * 16 + fr;
#pragma unroll
                    for (int bj = 0; bj < 2; ++bj) { const f32x4 v0 = acc[ai][bj][m][0] * rs, v1 = acc[ai][bj][m][1] * rs;
                        float ss = (v0[0] * v0[0] + v0[1] * v0[1]) + (v0[2] * v0[2] + v0[3] * v0[3]) + (v1[0] * v1[0] + v1[1] * v1[1]) + (v1[2] * v1[2] + v1[3] * v1[3]);
                        ss += __shfl_xor(ss, 16); ss += __shfl_xor(ss, 32);
                        if (fq == 0) P[(rl * 2 + bj) * 4 + wc] = ss; } }
            asm volatile("s_waitcnt lgkmcnt(0)" ::: "memory"); __builtin_amdgcn_s_barrier(); asm volatile("" ::: "memory");
            const f32x4 g0 = *(const f32x4*)(gk + wc * 32 + 8 * fq), g1 = *(const f32x4*)(gk + wc * 32 + 8 * fq + 4);
            float cs[2][8];
#pragma unroll
            for (int bj = 0; bj < 2; ++bj)
#pragma unroll
                for (int e = 0; e < 8; ++e) cs[bj][e] = 0.f;
#pragma unroll
            for (int ai = 0; ai < 2; ++ai)
#pragma unroll
                for (int m = 0; m < 4; ++m) { const int rl = ai * HALF + wr * 64 + m * 16 + fr; const unsigned rowb = (unsigned)((row0 + ai * HALF + m * 16) * ZP + col0) * 2u; const float rs = rstd_of(rsv[ai][m]);
#pragma unroll
                    for (int bj = 0; bj < 2; ++bj) { const f32x4 pt = *(const LAS f32x4*)(P + (rl * 2 + bj) * 4);
                        const float rk = rsqrtf(((pt[0] + pt[1]) + (pt[2] + pt[3])) * (1.f / 128.f) + 1e-6f) * rs;
                        const f32x4 v0 = acc[ai][bj][m][0] * rk * g0, v1 = acc[ai][bj][m][1] * rk * g1;
#pragma unroll
                        for (int e = 0; e < 4; ++e) { cs[bj][e] += v0[e]; cs[bj][4 + e] += v1[e]; }
                        u32x4 w; w.x = cvt_pk(v0[0], v0[1]); w.y = cvt_pk(v0[2], v0[3]); w.z = cvt_pk(v1[0], v1[1]); w.w = cvt_pk(v1[2], v1[3]);
                        wz.st(rowb + bj * HALF * 2, w); } }
#pragma unroll
            for (int bj = 0; bj < 2; ++bj)
#pragma unroll
                for (int e = 0; e < 8; ++e) { float v = cs[bj][e]; v += __shfl_xor(v, 1); v += __shfl_xor(v, 2); v += __shfl_xor(v, 4); v += __shfl_xor(v, 8); cs[bj][e] = v; }
            if (fr == 0) {
#pragma unroll
                for (int bj = 0; bj < 2; ++bj)
#pragma unroll
                    for (int e = 0; e < 8; ++e) KS[wr * 256 + bj * HALF + wc * 32 + 8 * fq + e] = cs[bj][e]; }
            asm volatile("s_waitcnt lgkmcnt(0)" ::: "memory"); __builtin_amdgcn_s_barrier(); asm volatile("" ::: "memory");
            const int tl = (wr * 4 + wc) * 64 + fq * 16 + fr;
            if (tl < 256) kmean[(size_t)((2 * (u.pn - 4) + (tl >> 7)) * 32 + u.pm) * 128 + (tl & 127)] = (KS[tl] + KS[256 + tl]) * (1.f / 256.f);
        } else if (u.pn < 16) {
#pragma unroll
            for (int ai = 0; ai < 2; ++ai)
#pragma unroll
                for (int m = 0; m < 4; ++m) { const unsigned rowb = (unsigned)((row0 + ai * HALF + m * 16) * ZP + col0) * 2u; const float rs = rstd_of(rsv[ai][m]);
#pragma unroll
                    for (int bj = 0; bj < 2; ++bj) { const f32x4 v0 = acc[ai][bj][m][0] * rs, v1 = acc[ai][bj][m][1] * rs;
                        u32x4 w; w.x = cvt_pk(v0[0], v0[1]); w.y = cvt_pk(v0[2], v0[3]); w.z = cvt_pk(v1[0], v1[1]); w.w = cvt_pk(v1[2], v1[3]);
                        wz.st(rowb + bj * HALF * 2, w); } }
        } else {
            const int gt = u.pn - 16;
            const unsigned lo = (unsigned)((wr * 4 + wc) * 8192 + (fq * 16 + fr) * 8);
            if (gt < 16) {
                const unsigned g0 = (unsigned)(((0 * 32 + u.pm) * 8 + (gt >> 1)) * 65536 + lo) * 2u; const WT wg1(GATE + (size_t)32 * 8 * 65536);
#pragma unroll
                for (int ai = 0; ai < 2; ++ai)
#pragma unroll
                    for (int m = 0; m < 4; ++m) { const float rs = rstd_of(rsv[ai][m]) * -1.4426950408889634f;
                        float r1[8], eb[8];
#pragma unroll
                        for (int n = 0; n < 2; ++n)
#pragma unroll
                            for (int i = 0; i < 4; ++i) { const float ea = __builtin_amdgcn_exp2f(__builtin_amdgcn_fmed3f(acc[ai][0][m][n][i] * rs, -43.28f, 43.28f)); eb[n * 4 + i] = __builtin_amdgcn_exp2f(__builtin_amdgcn_fmed3f(acc[ai][1][m][n][i] * rs, -43.28f, 43.28f));
                                const float sb = __builtin_amdgcn_rcpf(1.f + eb[n * 4 + i]); r1[n * 4 + i] = __builtin_amdgcn_rcpf(sb * (1.f + ea)); eb[n * 4 + i] = sb; }
                        const unsigned o = (unsigned)(((ai * 4 + m) * 2 + (gt & 1)) * 1024);
                        wg.st(g0 + o, __builtin_bit_cast(u32x4, pack8(r1))); wg1.st(g0 + o, __builtin_bit_cast(u32x4, pack8(eb))); }
            } else {
                const unsigned gb = (unsigned)(((2 * 32 + u.pm) * 8 + (gt - 16)) * 65536 + lo) * 2u;
#pragma unroll
                for (int ai = 0; ai < 2; ++ai)
#pragma unroll
                    for (int m = 0; m < 4; ++m) { const float rs = rstd_of(rsv[ai][m]) * -1.4426950408889634f;
#pragma unroll
                        for (int bj = 0; bj < 2; ++bj) { float g[8];
#pragma unroll
                            for (int i = 0; i < 4; ++i) { g[i] = 1.f + __builtin_amdgcn_exp2f(__builtin_amdgcn_fmed3f(acc[ai][bj][m][0][i] * rs, -43.28f, 43.28f)); g[4 + i] = 1.f + __builtin_amdgcn_exp2f(__builtin_amdgcn_fmed3f(acc[ai][bj][m][1][i] * rs, -43.28f, 43.28f)); }
                            wg.st(gb + (unsigned)(((ai * 4 + m) * 2 + bj) * 1024), __builtin_bit_cast(u32x4, pack8(g))); } }
            }
        }
    }
};
struct EpiMerge {
    static constexpr bool PERM = true, HAS_MID = true;
    const e16_t* GATE; e16_t* MG;
    __device__ __forceinline__ const e16_t* gptr(int b, const Unit& u, int wr, int wc, int fr, int fq) const { return GATE + ((size_t)((b * 32 + u.pm) * 8 + u.pn)) * 65536 + (wr * 4 + wc) * 8192 + (fq * 16 + fr) * 8; }
    __device__ __forceinline__ void mid(f32x4 (&acc)[2][2][4][2], const Unit& u, int t, int wr, int wc, int fr, int fq) const {
        const e16_t* np = gptr(t == 16 ? 0 : 1, u, wr, wc, fr, fq); const e16_t* dp = (t == 16) ? GATE + (WS_ONES - WS_GATE) / 2 + (wr * 4 + wc) * 8192 + (fq * 16 + fr) * 8 : gptr(2, u, wr, wc, fr, fq);
#pragma unroll
        for (int ai = 0; ai < 2; ++ai)
#pragma unroll
            for (int m = 0; m < 4; ++m) {
#pragma unroll
                for (int bj = 0; bj < 2; ++bj) { const int o = ((ai * 4 + m) * 2 + bj) * 512; const h8 nn = *(const h8*)(np + o), dd = *(const h8*)(dp + o);
#pragma unroll
                    for (int i = 0; i < 4; ++i) { acc[ai][bj][m][0][i] *= up16(dd[i]) * up16(nn[i]); acc[ai][bj][m][1][i] *= up16(dd[4 + i]) * up16(nn[4 + i]); } }
                if (m == 3) asm volatile("" ::: "memory"); }
    }
    __device__ __forceinline__ void operator()(const f32x4 (&acc)[2][2][4][2], const Unit& u, int wr, int wc, int fr, int fq) const {
        const int row0 = u.pm * BM + wr * 64 + fr, col0 = u.pn * BM + wc * 32 + 8 * fq; const e16_t* sp = gptr(2, u, wr, wc, fr, fq); const WT wm(MG);
        h8 sg[2][4][2];
#pragma unroll
        for (int ai = 0; ai < 2; ++ai)
#pragma unroll
            for (int m = 0; m < 4; ++m)
#pragma unroll
                for (int bj = 0; bj < 2; ++bj) sg[ai][m][bj] = *(const h8*)(sp + ((ai * 4 + m) * 2 + bj) * 512);
#pragma unroll
        for (int ai = 0; ai < 2; ++ai)
#pragma unroll
            for (int m = 0; m < 4; ++m) { const unsigned rowb = (unsigned)((row0 + ai * HALF + m * 16) * 2048 + col0) * 2u;
#pragma unroll
                for (int bj = 0; bj < 2; ++bj) { float v[8];
#pragma unroll
                    for (int i = 0; i < 4; ++i) { v[i] = acc[ai][bj][m][0][i] * __builtin_amdgcn_rcpf(up16(sg[ai][m][bj][i])); v[4 + i] = acc[ai][bj][m][1][i] * __builtin_amdgcn_rcpf(up16(sg[ai][m][bj][4 + i])); }
                    wm.st(rowb + bj * HALF * 2, __builtin_bit_cast(u32x4, pack8(v))); } }
    }
};

template <class Epi, class Sched, bool ALIGN_EPI = true, bool SP2 = true>
__device__ __forceinline__ void gemm_phase(LAS unsigned char* lds, const int tid, const Gemm g, const Sched& S, const Epi& E) {
    const int wid = __builtin_amdgcn_readfirstlane(tid >> 6), lane = tid & 63, wr = wid >> 2, wc = wid & 3, fr = lane & 15, fq = lane >> 4;
    const int K = g.K, nt = K / BK;
    unsigned voffA[2], voffB[2];
#pragma unroll
    for (int i = 0; i < 2; ++i) { int R, C; stage_rc(tid * 16 + i * 8192, R, C); const int Rb = Epi::PERM ? ((R & ~31) + perm32(R & 31)) : R;
        voffA[i] = (unsigned)(R * g.lda + C) * 2u; voffB[i] = (unsigned)(Rb * g.ldb + C) * 2u; }
    const size_t kstep = (size_t)(BK * 2);
    const size_t hstepA = (size_t)HALF * g.lda * 2, hstepB = (size_t)HALF * g.ldb * 2;
    const size_t tstepA = 2 * hstepA, tstepB = 2 * hstepB;
    const unsigned ldsw = (unsigned)wid * 1024u;
    const int aoff = lds_byte(wr * 64 + fr, fq * 8), boff = lds_byte(wc * 32 + fr, fq * 8);
#define PG8_SA(b, h) (((b) * 2 + (h)) * HTB)
#define PG8_SB(b, h) ((4 + (b) * 2 + (h)) * HTB)
#define PG8_STAGE(bufoff, gbase, voff) do { _Pragma("unroll") for (int _i = 0; _i < 2; ++_i) \
        __builtin_amdgcn_global_load_lds((const unsigned*)((const char*)(gbase) + (voff)[_i]), (LAS unsigned*)(lds + (bufoff) + ldsw + _i * 8192), 16, 0, 0); } while (0)
#define PG8_LDA(dst, b, h) do { _Pragma("unroll") for (int m = 0; m < 4; ++m) _Pragma("unroll") for (int k = 0; k < 2; ++k) dst[m][k] = *(const LAS h8*)(lds + PG8_SA(b, h) + aoff + m * 2048 + k * 1024); } while (0)
#define PG8_LDB(dst, b, h) do { _Pragma("unroll") for (int n = 0; n < 2; ++n) _Pragma("unroll") for (int k = 0; k < 2; ++k) dst[n][k] = *(const LAS h8*)(lds + PG8_SB(b, h) + boff + n * 2048 + k * 1024); } while (0)
#define PG8_MMA(ai, bj, At, Bt) do { __builtin_amdgcn_s_setprio(1); _Pragma("unroll") for (int m = 0; m < 4; ++m) _Pragma("unroll") for (int n = 0; n < 2; ++n) _Pragma("unroll") for (int k = 0; k < 2; ++k) \
        acc[ai][bj][m][n] = MFMA16(Bt[n][k], At[m][k], acc[ai][bj][m][n]); __builtin_amdgcn_s_setprio(0); } while (0)
#define PG8_WAIT_V(n) asm volatile("s_waitcnt vmcnt(" #n ")" ::: "memory")
#define PG8_WAIT_L(n) asm volatile("s_waitcnt lgkmcnt(" #n ")" ::: "memory")
#define PG8_BAR __builtin_amdgcn_s_barrier()
#define PG8_SCHED __builtin_amdgcn_sched_barrier(0)
    Unit cur, nxt; int ui = 0;
    if (!S.next(0, cur)) return;
    f32x4 acc[2][2][4][2];
#pragma unroll
    for (int a = 0; a < 2; ++a)
#pragma unroll
        for (int b = 0; b < 2; ++b)
#pragma unroll
            for (int m = 0; m < 4; ++m)
#pragma unroll
                for (int n = 0; n < 2; ++n) acc[a][b][m][n] = (f32x4){0.f, 0.f, 0.f, 0.f};
    h8 At[4][2], B0[2][2], B1[2][2];
    const char* cA = (const char*)g.A + (size_t)cur.pm * tstepA; const char* cB = (const char*)g.Bt + (size_t)cur.pn * tstepB;
    S.a_ready(cur);
    if constexpr (SP2) {
        PG8_STAGE(PG8_SB(0, 0), cB, voffB); PG8_STAGE(PG8_SB(0, 1), cB + hstepB, voffB); PG8_STAGE(PG8_SA(0, 0), cA, voffA); PG8_STAGE(PG8_SA(0, 1), cA + hstepA, voffA);
        if (wr == 1) PG8_BAR;
        PG8_WAIT_V(2); PG8_BAR;
        PG8_STAGE(PG8_SB(1, 0), cB + kstep, voffB); PG8_STAGE(PG8_SA(1, 0), cA + kstep, voffA); PG8_STAGE(PG8_SB(1, 1), cB + hstepB + kstep, voffB);
        PG8_WAIT_V(6); PG8_BAR;
    } else {
        PG8_STAGE(PG8_SB(0, 0), cB, voffB); PG8_STAGE(PG8_SA(0, 0), cA, voffA); PG8_STAGE(PG8_SB(0, 1), cB + hstepB, voffB); PG8_STAGE(PG8_SA(0, 1), cA + hstepA, voffA);
        if (wr == 1) PG8_BAR;
        PG8_WAIT_V(4); PG8_BAR;
        PG8_STAGE(PG8_SB(1, 0), cB + kstep, voffB); PG8_STAGE(PG8_SA(1, 0), cA + kstep, voffA); PG8_STAGE(PG8_SB(1, 1), cB + hstepB + kstep, voffB);
        PG8_WAIT_V(6); PG8_BAR;
    }
    for (;;) {
        const bool has_next = S.next(ui + 1, nxt);
        const char* nA = has_next ? (const char*)g.A + (size_t)nxt.pm * tstepA : cA; const char* nB = has_next ? (const char*)g.Bt + (size_t)nxt.pn * tstepB : cB;
        for (int t = 0; t < nt; t += 2) {
            const bool last = (t == nt - 2);
            const char* a1 = cA + (size_t)(t + 1) * kstep;
            const char* a2 = last ? nA : cA + (size_t)(t + 2) * kstep; const char* b2 = last ? nB : cB + (size_t)(t + 2) * kstep;
            const char* a3 = a2 + kstep; const char* b3 = b2 + kstep;
            if (last && has_next) S.a_ready(nxt);
            if constexpr (Epi::HAS_MID) { if (t == 16 || t == 32) E.mid(acc, cur, t, wr, wc, fr, fq); }
            if constexpr (SP2) {
            PG8_LDB(B0, 0, 0); PG8_LDB(B1, 0, 1); PG8_SCHED; PG8_LDA(At, 0, 0); PG8_STAGE(PG8_SA(1, 1), a1 + hstepA, voffA);
            PG8_WAIT_V(8); PG8_WAIT_L(0); PG8_BAR; PG8_MMA(0, 0, At, B0); PG8_MMA(0, 1, At, B1); PG8_BAR; PG8_SCHED;
            PG8_LDA(At, 0, 1); PG8_STAGE(PG8_SB(0, 0), b2, voffB); PG8_STAGE(PG8_SB(0, 1), b2 + hstepB, voffB); PG8_STAGE(PG8_SA(0, 0), a2, voffA);
            PG8_WAIT_V(8); PG8_WAIT_L(0); PG8_BAR; PG8_MMA(1, 0, At, B0); PG8_MMA(1, 1, At, B1); PG8_BAR; PG8_SCHED;
            PG8_LDB(B0, 1, 0); PG8_LDB(B1, 1, 1); PG8_SCHED; PG8_LDA(At, 1, 0); PG8_STAGE(PG8_SA(0, 1), a2 + hstepA, voffA);
            PG8_WAIT_V(8); PG8_WAIT_L(0); PG8_BAR; PG8_MMA(0, 0, At, B0); PG8_MMA(0, 1, At, B1); PG8_BAR; PG8_SCHED;
            PG8_LDA(At, 1, 1); PG8_STAGE(PG8_SB(1, 0), b3, voffB); PG8_STAGE(PG8_SB(1, 1), b3 + hstepB, voffB); PG8_STAGE(PG8_SA(1, 0), a3, voffA);
            PG8_WAIT_V(8); PG8_WAIT_L(0); PG8_BAR; PG8_MMA(1, 0, At, B0); PG8_MMA(1, 1, At, B1); PG8_BAR; PG8_SCHED;
            } else {
            PG8_LDB(B0, 0, 0); PG8_SCHED; PG8_LDA(At, 0, 0); PG8_STAGE(PG8_SA(1, 1), a1 + hstepA, voffA);
            PG8_WAIT_L(8); PG8_BAR; PG8_WAIT_L(0); PG8_MMA(0, 0, At, B0); PG8_BAR; PG8_SCHED;
            PG8_LDB(B1, 0, 1); PG8_STAGE(PG8_SB(0, 0), b2, voffB);
            PG8_BAR; PG8_WAIT_L(0); PG8_MMA(0, 1, At, B1); PG8_BAR;
            PG8_LDA(At, 0, 1); PG8_STAGE(PG8_SA(0, 0), a2, voffA);
            PG8_BAR; PG8_WAIT_L(0); PG8_MMA(1, 0, At, B0); PG8_BAR; PG8_SCHED;
            PG8_STAGE(PG8_SB(0, 1), b2 + hstepB, voffB);
            PG8_WAIT_V(6); PG8_BAR; PG8_MMA(1, 1, At, B1); PG8_BAR;
            PG8_LDB(B0, 1, 0); PG8_SCHED; PG8_LDA(At, 1, 0); PG8_STAGE(PG8_SA(0, 1), a2 + hstepA, voffA);
            PG8_WAIT_L(8); PG8_BAR; PG8_WAIT_L(0); PG8_MMA(0, 0, At, B0); PG8_BAR; PG8_SCHED;
            PG8_LDB(B1, 1, 1); PG8_STAGE(PG8_SB(1, 0), b3, voffB);
            PG8_BAR; PG8_WAIT_L(0); PG8_MMA(0, 1, At, B1); PG8_BAR;
            PG8_LDA(At, 1, 1); PG8_STAGE(PG8_SA(1, 0), a3, voffA);
            PG8_BAR; PG8_WAIT_L(0); PG8_MMA(1, 0, At, B0); PG8_BAR; PG8_SCHED;
            PG8_STAGE(PG8_SB(1, 1), b3 + hstepB, voffB);
            PG8_WAIT_V(6); PG8_BAR; PG8_MMA(1, 1, At, B1); PG8_BAR;
            }
        }
        if constexpr (ALIGN_EPI) { if (wr == 0) PG8_BAR; }
        E(acc, cur, wr, wc, fr, fq); S.done(cur);
        if (!has_next) break;
#pragma unroll
        for (int a = 0; a < 2; ++a)
#pragma unroll
            for (int b = 0; b < 2; ++b)
#pragma unroll
                for (int m = 0; m < 4; ++m)
#pragma unroll
                    for (int n = 0; n < 2; ++n) acc[a][b][m][n] = (f32x4){0.f, 0.f, 0.f, 0.f};
        cur = nxt; cA = nA; cB = nB; ++ui;
        if constexpr (ALIGN_EPI) { if (wr == 1) PG8_BAR; }
    }
    PG8_WAIT_V(0);
    if constexpr (!ALIGN_EPI) { if (wr == 0) PG8_BAR; }
    PG8_BAR;
#undef PG8_SA
#undef PG8_SB
#undef PG8_STAGE
#undef PG8_LDA
#undef PG8_LDB
#undef PG8_MMA
#undef PG8_WAIT_V
#undef PG8_WAIT_L
#undef PG8_BAR
#undef PG8_SCHED
}
}
using pg8::fx_t; using pg8::fx2f; using pg8::f2fx;

constexpr int NWAVES = 8, NTHREADS = 512;
constexpr int LDS_BYTES = 155648;
struct Args { const float* in[18]; float* out; unsigned char* ws; int ph_lo, ph_hi; };

struct Ctx {
    LAS unsigned char* lds; int tid, lane, wave, gw, NGW, G;
    float* out; unsigned char* ws;
    __device__ __forceinline__ e16_t* w16(size_t off) const { return (e16_t*)(ws + off); }
    __device__ __forceinline__ e16_t* wl(int l, size_t off) const { return (e16_t*)(ws + WS_W + (size_t)l * WL_SIZE + off); }
};

#define LDS_WAIT() asm volatile("s_waitcnt lgkmcnt(0)" ::: "memory")
__device__ __forceinline__ int map_win(int n) {
    if (n < 2048) return n;
    if (n < 3072) return 10240 + (n - 2048);
    if (n < 4096) return 2048 + (n - 3072);
    if (n < 5120) return 11264 + (n - 4096);
    if (n < 6144) return 3072 + (n - 5120);
    if (n < 8192) { const int c = n - 6144; return 4096 + (c >> 7) * 256 + (c & 127); }
    if (n < 10240) { const int c = n - 8192; return 4096 + (c >> 7) * 256 + 128 + (c & 127); }
    return n - 2048;
}
__device__ __forceinline__ int map_gu(int n) { return n < DFF ? 256 * (n >> 7) + (n & 127) : 256 * ((n - DFF) >> 7) + 128 + ((n - DFF) & 127); }
struct TD { const float* W; const float* g; e16_t* WT; int K, N, ldo, koff, map; };
__device__ __forceinline__ TD weight_td(const Args& a, const Ctx& C, int id) {
    const int l = id >> 3, m = id & 7; TD t; t.g = nullptr; t.koff = 0; t.map = 0;
    if (m == 0) { t.W = a.in[3] + (size_t)l * D_ * WINC; t.g = a.in[2] + l * D_; t.WT = C.wl(l, WL_IN); t.K = D_; t.N = WINC; t.ldo = D_; t.map = 1; }
    else if (m <= 3) { t.W = a.in[13] + (size_t)(l * 3 + m - 1) * 1024 * D_; t.WT = C.wl(l, WL_B); t.K = 1024; t.N = D_; t.ldo = 3072; t.koff = (m - 1) * 1024; }
    else if (m == 4) { t.W = a.in[14] + (size_t)l * D_ * D_; t.WT = C.wl(l, WL_O); t.K = D_; t.N = D_; t.ldo = D_; }
    else if (m == 5) { t.W = a.in[16] + (size_t)l * D_ * 2 * DFF; t.g = a.in[15] + l * D_; t.WT = C.wl(l, WL_GU); t.K = D_; t.N = 2 * DFF; t.ldo = D_; t.map = 2; }
    else if (m == 6) { t.W = a.in[17] + (size_t)l * DFF * D_; t.WT = C.wl(l, WL_D); t.K = DFF; t.N = D_; t.ldo = DFF; }
    else { t.W = a.in[12] + (size_t)l * D_ * D_; t.WT = C.wl(l, WL_M); t.K = D_; t.N = D_; t.ldo = D_; }
    return t;
}
__device__ __forceinline__ bool job_decode(int job, int i, int& id, int& it) {
    if (job == 0) { if (i < 12288) { id = 0; it = i; } else if (i < 14336) { id = 7; it = i - 12288; } else if (i < 16384) { id = 15; it = i - 14336; } else if (i < 19456) { id = 5; it = i - 16384 + 8192; }
                    else if (i < 22528) { id = 13; it = i - 19456 + 8192; } else return false; }
    else if (job == 4) { if (i < 8192) { id = 5; it = i; } else if (i < 12288) { id = 8; it = i; } else if (i < 20480) { id = 13; it = i - 12288; } else return false; }
    else if (job == 1) { if (i < 3072) { id = 1 + (i >> 10); it = i & 1023; } else if (i < 5120) { id = 4; it = i - 3072; } else if (i < 10752) { id = 6; it = i - 5120; }
                         else if (i < 13824) { id = 9 + ((i - 10752) >> 10); it = (i - 10752) & 1023; } else if (i < 15872) { id = 12; it = i - 13824; } else return false; }
    else if (job == 2) { if (i >= 8192) return false; id = 8; it = i; }
    else { if (i >= 5632) return false; id = 14; it = i; }
    return true;
}
__device__ __forceinline__ void convert_job(const Args& a, const Ctx& C, int job, int slot, int stride, int k_lo, int k_hi, LAS float* scr) {
    const int lane = C.lane, c = lane & 7;
    int k = k_lo, id, it;
    if (k >= k_hi || !job_decode(job, slot + k * stride, id, it)) return;
    TD t = weight_td(a, C, id); int nblk = t.N / 32;
    float r[32];
    { const int k0 = (it / nblk) * 64, n0 = (it % nblk) * 32;
#pragma unroll
      for (int i = 0; i < 32; ++i) r[i] = t.W[(size_t)(k0 + 2 * i + (lane >> 5)) * t.N + n0 + (lane & 31)]; }
#pragma unroll 1
    for (;;) {
        const int k0 = (it / nblk) * 64, n0 = (it % nblk) * 32; const int drow0 = t.map == 1 ? map_win(n0) : (t.map == 2 ? map_gu(n0) : n0);
        f32x4 ga = {1.f, 1.f, 1.f, 1.f}, gb = ga;
        if (t.g) { ga = *(const f32x4*)(t.g + k0 + 8 * c); gb = *(const f32x4*)(t.g + k0 + 8 * c + 4); }
        e16_t* wt = t.WT; const int ldo = t.ldo, koff = t.koff;
#pragma unroll
        for (int i = 0; i < 32; ++i) scr[(2 * i + (lane >> 5)) * 33 + (lane & 31)] = r[i];
        ++k; int id2, it2; const bool more = (k < k_hi) && job_decode(job, slot + k * stride, id2, it2);
        if (more) { t = weight_td(a, C, id2); nblk = t.N / 32; it = it2; const int k1 = (it / nblk) * 64, n1 = (it % nblk) * 32;
#pragma unroll
            for (int i = 0; i < 32; ++i) r[i] = t.W[(size_t)(k1 + 2 * i + (lane >> 5)) * t.N + n1 + (lane & 31)]; }
        LDS_WAIT(); asm volatile("" ::: "memory");
#pragma unroll
        for (int j = 0; j < 4; ++j) { const int n = (lane >> 3) + 8 * j; const LAS float* sp = scr + (8 * c) * 33 + n;
            u32x4 o; o.x = cvt_pk(sp[0 * 33] * ga[0], sp[1 * 33] * ga[1]); o.y = cvt_pk(sp[2 * 33] * ga[2], sp[3 * 33] * ga[3]); o.z = cvt_pk(sp[4 * 33] * gb[0], sp[5 * 33] * gb[1]); o.w = cvt_pk(sp[6 * 33] * gb[2], sp[7 * 33] * gb[3]);
            *(u32x4*)(wt + (size_t)(drow0 + n) * ldo + koff + k0 + 8 * c) = o; }
        LDS_WAIT(); asm volatile("" ::: "memory");
        if (!more) break;
    }
}
__device__ __forceinline__ void rms_rows(const Ctx& C, const float* X, const float* g, e16_t* O, int rows) {
    for (int m = C.gw; m < rows; m += C.NGW) {
        const f32x4* xr = (const f32x4*)(X + (size_t)m * D_) + C.lane; f32x4 v[8]; float s = 0.f;
#pragma unroll
        for (int j = 0; j < 8; ++j) { v[j] = xr[64 * j]; s += (v[j].x * v[j].x + v[j].y * v[j].y) + (v[j].z * v[j].z + v[j].w * v[j].w); }
        const float rstd = rsqrtf(wave_sum(s) * (1.f / D_) + EPS);
        const f32x4* gr = (const f32x4*)g + C.lane; u32x2* o8 = (u32x2*)(O + (size_t)m * D_) + C.lane;
#pragma unroll
        for (int j = 0; j < 8; ++j) { const f32x4 gg = gr[64 * j]; u32x2 w; w.x = cvt_pk(v[j].x * rstd * gg.x, v[j].y * rstd * gg.y); w.y = cvt_pk(v[j].z * rstd * gg.z, v[j].w * rstd * gg.w); o8[64 * j] = w; }
    }
}

__device__ __forceinline__ void xb_rows(const Ctx& C, const float* X, e16_t* O, fx_t* rss, int rows) {
    for (int m = C.gw; m < rows; m += C.NGW) {
        const f32x4* xr = (const f32x4*)(X + (size_t)m * D_) + C.lane; u32x2* o8 = (u32x2*)(O + (size_t)m * D_) + C.lane; f32x4 v[8]; float s = 0.f;
#pragma unroll
        for (int j = 0; j < 8; ++j) { v[j] = xr[64 * j]; s += (v[j].x * v[j].x + v[j].y * v[j].y) + (v[j].z * v[j].z + v[j].w * v[j].w); }
#pragma unroll
        for (int j = 0; j < 8; ++j) { u32x2 w; w.x = cvt_pk(v[j].x, v[j].y); w.y = cvt_pk(v[j].z, v[j].w); o8[64 * j] = w; }
        s = wave_sum(s); if (C.lane == 0) rss[m] = f2fx(s);
    }
}
__device__ __forceinline__ void kmnorm_phase(const Ctx& C, const float* gkm) {
    for (int it = C.gw; it < NLAYER * NMEM * HM; it += C.NGW) { const int l = it >> 10, m = (it >> 2) & 255, hm = it & 3;
        e16_t* p = C.w16(WS_KM) + (size_t)l * NMEM * 1024 + (size_t)m * 1024 + hm * DMH + 4 * C.lane; const h4 raw = *(const h4*)p;
        float v[4]; float ss = 0.f;
#pragma unroll
        for (int i = 0; i < 4; ++i) { v[i] = up16(raw[i]); ss += v[i] * v[i]; }
        const float rstd = rsqrtf(wave_sum(ss) * (1.f / DMH) + EPS); const float* g = gkm + l * DMH + 4 * C.lane;
        u32x2 w; w.x = cvt_pk(v[0] * rstd * g[0], v[1] * rstd * g[1]); w.y = cvt_pk(v[2] * rstd * g[2], v[3] * rstd * g[3]); *(u32x2*)p = w; }
}
__device__ __forceinline__ void gating_phase(const Ctx& C, int l, const float* gq, const float* gk) {
    const e16_t* Z = C.w16(WS_Z); const float* KMEAN = (const float*)(C.ws + WS_KMEAN); unsigned* LIST = (unsigned*)(C.ws + WS_LIST); unsigned* SEL = (unsigned*)(C.ws + WS_SEL);
    unsigned* CNT = (unsigned*)(C.ws + WS_CTL) + CW_CNT + l * 256;
    LAS float* km = (LAS float*)C.lds;
    LAS unsigned* lcnt = (LAS unsigned*)(C.lds + 16384); LAS unsigned* lbase = lcnt + 32;
    for (int it = blockIdx.x; it < HA * NBLK; it += C.G) { const int h = it >> 5, b = it & 31;
        for (int i = C.tid; i < NBLK * DA; i += NTHREADS) km[i] = KMEAN[(size_t)h * NBLK * DA + i];
        if (C.tid < 32) lcnt[C.tid] = 0u;
        if (C.tid < 64) { float a = fmaxf(fabsf(gq[C.tid]), fabsf(gq[C.tid + 64])), bb = fmaxf(fabsf(gk[C.tid]), fabsf(gk[C.tid + 64]));
#pragma unroll
            for (int o = 1; o < 64; o <<= 1) { a = fmaxf(a, __shfl_xor(a, o)); bb = fmaxf(bb, __shfl_xor(bb, o)); }
            if (C.tid == 0) ((LAS float*)lcnt)[96] = 2.f * (16.3222f * 1.02f * a * bb) + 150.f; }
        __syncthreads();
        const float thr = ((LAS float*)lcnt)[96], slope2 = __builtin_amdgcn_exp2f(-(float)(h + 1)) * LOG2E;
        const int q = b * 256 + (C.tid >> 1), half = C.tid & 1; const int nsel = b < 3 ? b : 3;
        int i0 = 0, i1 = 1, i2 = 2;
        if (b > 3) {
            float qv[64]; float ss = 0.f; const e16_t* zr = Z + (size_t)q * ZP + ZQ + h * DA + half * 64;
#pragma unroll
            for (int c8 = 0; c8 < 8; ++c8) { const h8 r = *(const h8*)(zr + 8 * c8);
#pragma unroll
                for (int j = 0; j < 8; ++j) { const float f = up16(r[j]); qv[c8 * 8 + j] = f; ss += f * f; } }
            ss += __shfl_xor(ss, 1);
            const float rstd = rsqrtf(ss * (1.f / DA) + EPS);
#pragma unroll
            for (int d = 0; d < 64; ++d) qv[d] = qv[d] * rstd * gq[half * 64 + d];
            float v0 = -__builtin_inff(), v1 = v0, v2 = v0;
            for (int j = 0; j < b; ++j) { const LAS f32x4* kr = (const LAS f32x4*)(km + j * DA + half * 64); float g0 = 0.f, g1 = 0.f;
#pragma unroll
                for (int d4 = 0; d4 < 16; d4 += 2) { const f32x4 ka = kr[d4], kb = kr[d4 + 1];
                    g0 += (qv[4 * d4] * ka.x + qv[4 * d4 + 1] * ka.y) + (qv[4 * d4 + 2] * ka.z + qv[4 * d4 + 3] * ka.w);
                    g1 += (qv[4 * d4 + 4] * kb.x + qv[4 * d4 + 5] * kb.y) + (qv[4 * d4 + 6] * kb.z + qv[4 * d4 + 7] * kb.w); }
                float gt = g0 + g1; gt += __shfl_xor(gt, 1);
                if (gt > v0) { v2 = v1; i2 = i1; v1 = v0; i1 = i0; v0 = gt; i0 = j; }
                else if (gt > v1) { v2 = v1; i2 = i1; v1 = gt; i1 = j; }
                else if (gt > v2) { v2 = gt; i2 = j; } }
        }
        const bool u0 = nsel > 0 && !(slope2 * (float)(256 * (b - i0 - 1) + 1) > thr), u1 = nsel > 1 && !(slope2 * (float)(256 * (b - i1 - 1) + 1) > thr), u2 = nsel > 2 && !(slope2 * (float)(256 * (b - i2 - 1) + 1) > thr);
        unsigned p0 = 0u, p1 = 0u, p2 = 0u;
        if (half == 0) { if (u0) p0 = atomicAdd((unsigned*)&lcnt[i0], 1u); if (u1) p1 = atomicAdd((unsigned*)&lcnt[i1], 1u); if (u2) p2 = atomicAdd((unsigned*)&lcnt[i2], 1u);
            SEL[(size_t)h * S_ + q] = (u0 ? 0u : 1u) | (u1 ? 0u : 2u) | (u2 ? 0u : 4u); }
        __syncthreads();
        if (C.tid < 32) { const unsigned n = lcnt[C.tid]; lbase[C.tid] = n ? atomicAdd(&CNT[h * 32 + C.tid], n) : 0u; }
        __syncthreads();
        if (half == 0) { unsigned* L = LIST + (size_t)h * 32 * 8192;
            if (u0) L[(size_t)i0 * 8192 + lbase[i0] + p0] = (unsigned)q;
            if (u1) L[(size_t)i1 * 8192 + lbase[i1] + p1] = (unsigned)q | (1u << 16);
            if (u2) L[(size_t)i2 * 8192 + lbase[i2] + p2] = (unsigned)q | (2u << 16); }
        __syncthreads();
    }
}

__device__ __forceinline__ void softmax_step(f32x16& p, float& m, float& l, f32x16 (&acc)[4], h8& pb0, h8& pb1) {
    float mx = p[0];
#pragma unroll
    for (int r = 1; r < 16; ++r) mx = fmaxf(mx, p[r]);
    mx = fmaxf(mx, __shfl_xor(mx, 32));
    if (__any(mx > m)) {
        const float mn = fmaxf(m, mx); const float alpha = __builtin_amdgcn_exp2f(m - mn); m = mn; l *= alpha;
#pragma unroll
        for (int db = 0; db < 4; ++db)
#pragma unroll
            for (int r = 0; r < 16; ++r) acc[db][r] *= alpha; }
    float ps = 0.f;
#pragma unroll
    for (int r = 0; r < 16; ++r) { p[r] = __builtin_amdgcn_exp2f(p[r] - m); ps += p[r]; }
    l += ps;
    float t[8];
#pragma unroll
    for (int r = 0; r < 8; ++r) t[r] = p[r];
    pb0 = pack8(t);
#pragma unroll
    for (int r = 0; r < 8; ++r) t[r] = p[8 + r];
    pb1 = pack8(t);
}
__device__ __forceinline__ void pv_step(f32x16 (&acc)[4], const e16_t* vt, int vp, int hi, h8 pb0, h8 pb1) {
#pragma unroll
    for (int db = 0; db < 4; ++db) { const e16_t* vr = vt + (size_t)db * 32 * vp + 4 * hi;
        { const h4 lo = *(const h4*)(vr), hh = *(const h4*)(vr + 8); const h8 a = {lo[0], lo[1], lo[2], lo[3], hh[0], hh[1], hh[2], hh[3]}; acc[db] = MFMA32(a, pb0, acc[db]); }
        { const h4 lo = *(const h4*)(vr + 16), hh = *(const h4*)(vr + 24); const h8 a = {lo[0], lo[1], lo[2], lo[3], hh[0], hh[1], hh[2], hh[3]}; acc[db] = MFMA32(a, pb1, acc[db]); } }
}
__device__ __forceinline__ float store_o(const f32x16 (&acc)[4], float l, e16_t* yrow, int hi, bool valid = true) {
    l += __shfl_xor(l, 32); const float inv = 1.0f / l; if (!valid) return l;
#pragma unroll
    for (int db = 0; db < 4; ++db)
#pragma unroll
        for (int g = 0; g < 4; ++g) { u32x2 w; w.x = cvt_pk(acc[db][4 * g] * inv, acc[db][4 * g + 1] * inv); w.y = cvt_pk(acc[db][4 * g + 2] * inv, acc[db][4 * g + 3] * inv);
            *(u32x2*)(yrow + db * 32 + g * 8 + hi * 4) = w; }
    return l;
}

constexpr int LV_OFF = 65536, LV_PITCH = 520;
constexpr int LDS_CTL = 135168;
static_assert(LV_OFF + 128 * LV_PITCH <= LDS_CTL, "LDS map");
static_assert(256 * LV_PITCH <= LDS_CTL, "LDS map (memory attention V^T image)");

__device__ __forceinline__ void moba_wg(const Ctx& C, const float* gqa, int h, int j, int t, int ntile, int slot, bool valid) {
    int tid = C.tid; asm volatile("" : "+v"(tid));
    const int c = tid & 31, hi = (tid >> 5) & 1;
    const e16_t* Z = C.w16(WS_Z); const e16_t* ZT = C.w16(WS_ZT);
    LAS unsigned char* LK = C.lds; LAS unsigned char* LV = C.lds + LV_OFF;
    const float slope2 = __builtin_amdgcn_exp2f(-(float)(h + 1)) * LOG2E;
    h8 qf[8];
    { const e16_t* kg = Z + (size_t)(j * 256) * ZP + ZK + h * DA; const e16_t* vg = ZT + (size_t)(h * DA) * ZTP + j * 256;
      const e16_t* zq = Z + (size_t)t * ZP + ZQ + h * DA + hi * 8; h8 raw[8], kr[8], vr[8];
#pragma unroll
      for (int i = 0; i < 8; ++i) { const int row = i * 32 + (tid >> 4), ch = tid & 15; kr[i] = *(const h8*)(kg + (size_t)row * ZP + ch * 8); }
#pragma unroll
      for (int i = 0; i < 8; ++i) { const int idx = i * 512 + tid, d = idx >> 5, cc = idx & 31; vr[i] = *(const h8*)(vg + (size_t)d * ZTP + cc * 8); }
#pragma unroll
      for (int ks = 0; ks < 8; ++ks) raw[ks] = *(const h8*)(zq + ks * 16);
      float ss = 0.f;
#pragma unroll
      for (int ks = 0; ks < 8; ++ks)
#pragma unroll
          for (int jj = 0; jj < 8; ++jj) { const float f = up16(raw[ks][jj]); ss += f * f; }
      ss += __shfl_xor(ss, 32);
      const float sc = rsqrtf(ss * (1.f / DA) + EPS) * 0.08838834764831845f * LOG2E; const float* gq = gqa + hi * 8;
#pragma unroll
      for (int ks = 0; ks < 8; ++ks) { const f32x4 g0 = *(const f32x4*)(gq + ks * 16), g1 = *(const f32x4*)(gq + ks * 16 + 4); float f[8];
#pragma unroll
          for (int jj = 0; jj < 4; ++jj) { f[jj] = up16(raw[ks][jj]) * sc * g0[jj]; f[4 + jj] = up16(raw[ks][4 + jj]) * sc * g1[jj]; }
          qf[ks] = pack8(f); }
#pragma unroll
      for (int i = 0; i < 8; ++i) { const int row = i * 32 + (tid >> 4), ch = tid & 15; *(LAS h8*)(LK + row * 256 + ((ch ^ (row & 15)) << 4)) = kr[i]; }
#pragma unroll
      for (int i = 0; i < 8; ++i) { const int idx = i * 512 + tid, d = idx >> 5, cc = idx & 31; LAS h4* p = (LAS h4*)(LV + d * LV_PITCH + cc * 16);
          p[0] = (h4){vr[i][0], vr[i][1], vr[i][2], vr[i][3]}; p[1] = (h4){vr[i][4], vr[i][5], vr[i][6], vr[i][7]}; } }
    __syncthreads();
    float m = -1e30f, lsum = 0.f; f32x16 acc[4];
#pragma unroll
    for (int db = 0; db < 4; ++db)
#pragma unroll
        for (int r = 0; r < 16; ++r) acc[db][r] = 0.f;
    const float NEG = -__builtin_inff();
    float sc[16];
#pragma unroll
    for (int r = 0; r < 16; ++r) sc[r] = slope2 * (float)crow(r, hi);
    for (int kt = 0; kt < ntile; ++kt) { const int kb = j * 256 + kt * 32;
        f32x16 p; const float base = slope2 * (float)(kb - t);
#pragma unroll
        for (int r = 0; r < 16; ++r) p[r] = sc[r] + base;
        const LAS unsigned char* kp = LK + (kt * 32 + c) * 256;
        h8 ka[8];
#pragma unroll
        for (int ks = 0; ks < 8; ++ks) ka[ks] = *(const LAS h8*)(kp + (((2 * ks + hi) ^ (c & 15)) << 4));
        u32x2 va[16];
#pragma unroll
        for (int db = 0; db < 4; ++db) { const LAS unsigned char* vp = LV + (db * 32 + c) * LV_PITCH + (kt * 32 + 4 * hi) * 2;
#pragma unroll
            for (int e = 0; e < 4; ++e) va[db * 4 + e] = *(const LAS u32x2*)(vp + 16 * e); }
        __builtin_amdgcn_sched_barrier(0);
#pragma unroll
        for (int ks = 0; ks < 8; ++ks) p = MFMA32(ka[ks], qf[ks], p);
        if (slot == 3 && kt == ntile - 1) {
#pragma unroll
            for (int r = 0; r < 16; ++r) { const int kpos = kb + crow(r, hi); p[r] = (kpos <= t) ? p[r] : NEG; } }
        h8 pb0, pb1; softmax_step(p, m, lsum, acc, pb0, pb1);
#pragma unroll
        for (int db = 0; db < 4; ++db) { const u32x4 a0 = {va[db * 4][0], va[db * 4][1], va[db * 4 + 1][0], va[db * 4 + 1][1]}, a1 = {va[db * 4 + 2][0], va[db * 4 + 2][1], va[db * 4 + 3][0], va[db * 4 + 3][1]};
            acc[db] = MFMA32(a0, pb0, acc[db]); acc[db] = MFMA32(a1, pb1, acc[db]); } }
    __syncthreads();
    if (ntile > 0) { e16_t* PART = C.w16(WS_PART); f32x2* ML = (f32x2*)(C.ws + WS_ML);
        const float lt = store_o(acc, lsum, PART + ((size_t)slot * S_ + t) * 1024 + h * DA, hi, valid);
        if (valid && hi == 0) ML[(size_t)(slot * HA + h) * S_ + t] = (f32x2){m, lt}; }
}
__device__ __forceinline__ void mem_wg(const Ctx& C, int l, const float* gqm, const float* gkm, int hm, int qb) {
    int tid = C.tid; asm volatile("" : "+v"(tid));
    const int c = tid & 31, hi = (tid >> 5) & 1, t = qb * 256 + C.wave * 32 + c;
    const e16_t* Z = C.w16(WS_Z); e16_t* Y = C.w16(WS_Y);
    const e16_t* KM = C.w16(WS_KM) + (size_t)l * NMEM * 1024 + hm * DMH; const e16_t* VMT = C.w16(WS_VMT) + (size_t)l * 1024 * NMEM + (size_t)(hm * DMH) * NMEM;
    LAS unsigned char* LK = C.lds;
    h8 qf[16]; float sbound;
    { h8 kr[16], raw[16]; const e16_t* zq = Z + (size_t)t * ZP + ZQM + hm * DMH + hi * 8;
#pragma unroll
      for (int i = 0; i < 16; ++i) { const int row = i * 16 + (tid >> 5), ch = tid & 31; kr[i] = *(const h8*)(KM + (size_t)row * 1024 + ch * 8); }
#pragma unroll
      for (int ks = 0; ks < 16; ++ks) raw[ks] = *(const h8*)(zq + ks * 16);
      const f32x4 gqv = *(const f32x4*)(gqm + 4 * (tid & 63)), gkv = *(const f32x4*)(gkm + 4 * (tid & 63));
#pragma unroll
      for (int i = 0; i < 16; ++i) { const int row = i * 16 + (tid >> 5), ch = tid & 31; *(LAS h8*)(LK + row * 512 + ((ch ^ (row & 15)) << 4)) = kr[i]; }
      float ss = 0.f;
#pragma unroll
      for (int ks = 0; ks < 16; ++ks)
#pragma unroll
          for (int j = 0; j < 8; ++j) { const float f = up16(raw[ks][j]); ss += f * f; }
      ss += __shfl_xor(ss, 32);
      { float a = fmaxf(fmaxf(fabsf(gqv.x), fabsf(gqv.y)), fmaxf(fabsf(gqv.z), fabsf(gqv.w))), b = fmaxf(fmaxf(fabsf(gkv.x), fabsf(gkv.y)), fmaxf(fabsf(gkv.z), fabsf(gkv.w)));
#pragma unroll
        for (int o = 1; o < 64; o <<= 1) { a = fmaxf(a, __shfl_xor(a, o)); b = fmaxf(b, __shfl_xor(b, o)); }
        sbound = 23.083f * 1.02f * a * b; }
#pragma unroll
      for (int ks = 0; ks < 16; ++ks) asm volatile("" : "+v"(raw[ks]));
      const float sc = rsqrtf(ss * (1.f / DMH) + EPS) * 0.0625f * LOG2E; const float* gq = gqm + hi * 8;
#pragma unroll
      for (int ks = 0; ks < 16; ++ks) { const f32x4 g0 = *(const f32x4*)(gq + ks * 16), g1 = *(const f32x4*)(gq + ks * 16 + 4); float f[8];
#pragma unroll
          for (int j = 0; j < 4; ++j) { f[j] = up16(raw[ks][j]) * sc * g0[j]; f[4 + j] = up16(raw[ks][4 + j]) * sc * g1[j]; }
          qf[ks] = pack8(f); } }
    __syncthreads();
    h8 pb[8][2]; float lsum = 0.f;
    { float mx = -1e30f;
      const bool need_max = __builtin_amdgcn_readfirstlane(sbound > 90.f ? 1 : 0) != 0;
      if (!need_max) mx = 0.f;
#pragma unroll 1
      for (int kt = 0; kt < (need_max ? 8 : 0); ++kt) { f32x16 p;
#pragma unroll
          for (int r = 0; r < 16; ++r) p[r] = 0.f;
          const LAS unsigned char* kp = LK + (kt * 32 + c) * 512;
#pragma unroll
          for (int k8 = 0; k8 < 16; k8 += 8) { h8 ka[8];
#pragma unroll
              for (int ks = 0; ks < 8; ++ks) ka[ks] = *(const LAS h8*)(kp + (((2 * (k8 + ks) + hi) ^ (c & 15)) << 4));
              __builtin_amdgcn_sched_barrier(0);
#pragma unroll
              for (int ks = 0; ks < 8; ++ks) p = MFMA32(ka[ks], qf[k8 + ks], p); }
#pragma unroll
          for (int r = 0; r < 16; ++r) mx = fmaxf(mx, p[r]); }
      mx = fmaxf(mx, __shfl_xor(mx, 32));
#pragma unroll
      for (int kt = 0; kt < 8; ++kt) { f32x16 p; float tv[8];
#pragma unroll
          for (int r = 0; r < 16; ++r) p[r] = 0.f;
          const LAS unsigned char* kp = LK + (kt * 32 + c) * 512;
#pragma unroll
          for (int k8 = 0; k8 < 16; k8 += 8) { h8 ka[8];
#pragma unroll
              for (int ks = 0; ks < 8; ++ks) ka[ks] = *(const LAS h8*)(kp + (((2 * (k8 + ks) + hi) ^ (c & 15)) << 4));
              __builtin_amdgcn_sched_barrier(0);
#pragma unroll
              for (int ks = 0; ks < 8; ++ks) p = MFMA32(ka[ks], qf[k8 + ks], p); }
#pragma unroll
          for (int r = 0; r < 16; ++r) { p[r] = __builtin_amdgcn_exp2f(p[r] - mx); lsum += p[r]; }
#pragma unroll
          for (int r = 0; r < 8; ++r) tv[r] = p[r];
          pb[kt][0] = pack8(tv);
#pragma unroll
          for (int r = 0; r < 8; ++r) tv[r] = p[8 + r];
          pb[kt][1] = pack8(tv); } }
    lsum += __shfl_xor(lsum, 32);
    const float inv = 1.0f / lsum;
    __syncthreads();
    LAS unsigned char* LV = C.lds;
    { h8 vr[16];
#pragma unroll
      for (int i = 0; i < 16; ++i) { const int idx = i * 512 + tid, d = idx >> 5, cc = idx & 31; vr[i] = *(const h8*)(VMT + (size_t)d * NMEM + cc * 8); }
#pragma unroll
      for (int i = 0; i < 16; ++i) { const int idx = i * 512 + tid, d = idx >> 5, cc = idx & 31; LAS h4* pp = (LAS h4*)(LV + d * LV_PITCH + cc * 16);
          pp[0] = (h4){vr[i][0], vr[i][1], vr[i][2], vr[i][3]}; pp[1] = (h4){vr[i][4], vr[i][5], vr[i][6], vr[i][7]}; }
      asm volatile("" ::: "memory"); }
    __syncthreads();
    e16_t* yrow = Y + (size_t)t * YP + 2048 + hm * DMH;
#pragma unroll 1
    for (int dh = 0; dh < 2; ++dh) { f32x16 acc[4];
#pragma unroll
        for (int db = 0; db < 4; ++db)
#pragma unroll
            for (int r = 0; r < 16; ++r) acc[db][r] = 0.f;
#pragma unroll
        for (int kt = 0; kt < 8; ++kt) { u32x2 va[16];
#pragma unroll
            for (int db = 0; db < 4; ++db) { const LAS unsigned char* vp = LV + ((dh * 4 + db) * 32 + c) * LV_PITCH + (kt * 32 + 4 * hi) * 2;
#pragma unroll
                for (int e = 0; e < 4; ++e) va[db * 4 + e] = *(const LAS u32x2*)(vp + 16 * e); }
            __builtin_amdgcn_sched_barrier(0);
#pragma unroll
            for (int db = 0; db < 4; ++db) { const u32x4 a0 = {va[db * 4][0], va[db * 4][1], va[db * 4 + 1][0], va[db * 4 + 1][1]}, a1 = {va[db * 4 + 2][0], va[db * 4 + 2][1], va[db * 4 + 3][0], va[db * 4 + 3][1]};
                acc[db] = MFMA32(a0, pb[kt][0], acc[db]); acc[db] = MFMA32(a1, pb[kt][1], acc[db]); } }
#pragma unroll
        for (int db = 0; db < 4; ++db)
#pragma unroll
            for (int g = 0; g < 4; ++g) { u32x2 w; w.x = cvt_pk(acc[db][4 * g] * inv, acc[db][4 * g + 1] * inv); w.y = cvt_pk(acc[db][4 * g + 2] * inv, acc[db][4 * g + 3] * inv);
                *(u32x2*)(yrow + dh * 128 + db * 32 + g * 8 + hi * 4) = w; } }
    __syncthreads();
}
__device__ __forceinline__ void attn_combine_phase(const Ctx& C) {
    const e16_t* PART = C.w16(WS_PART); const f32x2* ML = (const f32x2*)(C.ws + WS_ML); e16_t* Y = C.w16(WS_Y);
    const int hh = C.lane >> 3, d0 = hh * DA + 16 * (C.lane & 7);
    const unsigned* SEL = (const unsigned*)(C.ws + WS_SEL);
    for (int tb = C.gw; tb < S_; tb += 2 * C.NGW) {
        int tt[2]; unsigned on[2]; f32x2 ml[2][4]; h8 pa[2][4], pb[2][4];
#pragma unroll
        for (int r = 0; r < 2; ++r) { tt[r] = (tb + r * C.NGW < S_) ? tb + r * C.NGW : tb; const int np = (tt[r] >> 8) < 3 ? (tt[r] >> 8) : 3; const unsigned skip = SEL[(size_t)hh * S_ + tt[r]];
            on[r] = 8u | (((1u << np) - 1u) & ~skip); }
#pragma unroll
        for (int r = 0; r < 2; ++r)
#pragma unroll
            for (int sl = 0; sl < 4; ++sl) { const int se = ((on[r] >> sl) & 1u) ? sl : 3; ml[r][sl] = ML[(size_t)(se * HA + hh) * S_ + tt[r]];
                const e16_t* pr = PART + ((size_t)se * S_ + tt[r]) * 1024 + d0; pa[r][sl] = *(const h8*)pr; pb[r][sl] = *(const h8*)(pr + 8); }
#pragma unroll
        for (int r = 0; r < 2; ++r) { float M = -1e30f;
#pragma unroll
            for (int sl = 0; sl < 4; ++sl) if ((on[r] >> sl) & 1u) M = fmaxf(M, ml[r][sl].x);
            float w[4], W = 0.f;
#pragma unroll
            for (int sl = 0; sl < 4; ++sl) { w[sl] = ((on[r] >> sl) & 1u) ? ml[r][sl].y * __builtin_amdgcn_exp2f(ml[r][sl].x - M) : 0.f; W += w[sl]; }
            const float iw = 1.0f / W; float o[16];
#pragma unroll
            for (int i = 0; i < 16; ++i) o[i] = 0.f;
#pragma unroll
            for (int sl = 0; sl < 4; ++sl) { const float ws = w[sl] * iw;
#pragma unroll
                for (int i = 0; i < 8; ++i) { o[i] += ws * up16(pa[r][sl][i]); o[8 + i] += ws * up16(pb[r][sl][i]); } }
            if (r == 0 || tb + C.NGW < S_) { *(h8*)(Y + (size_t)tt[r] * YP + d0) = pack8(o); *(h8*)(Y + (size_t)tt[r] * YP + d0 + 8) = pack8(o + 8); } }
    }
}
__device__ __forceinline__ void sgu_item(const Ctx& C, const float* wsgu, const float* bsgu, const float* gsgu, int n, int g, int w) {
    int ln = C.lane; asm volatile("" : "+v"(ln));
    const int c = ln & 31, hi = ln >> 5, tt = w & 3, cp = w >> 2, tl = 32 * tt + c, t = 128 * n + tl;
    const e16_t* Z = C.w16(WS_Z); const e16_t* ZT = C.w16(WS_ZT); e16_t* Y = C.w16(WS_Y); const float* RSTDV = (const float*)(C.ws + WS_RSTDV);
    const float* wrow = wsgu + ((size_t)g * 128 + tl) * 128;
    f32x16 a0, a1;
#pragma unroll
    for (int r = 0; r < 16; ++r) { a0[r] = 0.f; a1[r] = 0.f; }
    const e16_t* gv0 = ZT + (size_t)(1024 + g * 128 + (2 * cp) * 32 + c) * ZTP + 128 * n + 8 * hi; const e16_t* gv1 = gv0 + (size_t)32 * ZTP;
#pragma unroll
    for (int kh = 0; kh < 2; ++kh) {
        if (kh == 1 && tt < 2) break;
        f32x4 wv[4][2], rv[4][2]; h8 xv[4][2];
#pragma unroll
        for (int k4 = 0; k4 < 4; ++k4) { const int s0 = 16 * (kh * 4 + k4) + 8 * hi;
            wv[k4][0] = *(const f32x4*)(wrow + s0); wv[k4][1] = *(const f32x4*)(wrow + s0 + 4);
            rv[k4][0] = *(const f32x4*)(RSTDV + 128 * n + s0); rv[k4][1] = *(const f32x4*)(RSTDV + 128 * n + s0 + 4);
            xv[k4][0] = *(const h8*)(gv0 + (kh * 4 + k4) * 16); xv[k4][1] = *(const h8*)(gv1 + (kh * 4 + k4) * 16); }
#pragma unroll
        for (int k4 = 0; k4 < 4; ++k4) { const int s0 = 16 * (kh * 4 + k4) + 8 * hi; float f[8];
#pragma unroll
            for (int j = 0; j < 4; ++j) { f[j] = (s0 + j <= tl) ? wv[k4][0][j] * rv[k4][0][j] : 0.f; f[4 + j] = (s0 + 4 + j <= tl) ? wv[k4][1][j] * rv[k4][1][j] : 0.f; }
            const h8 bf = pack8(f); a0 = MFMA32(xv[k4][0], bf, a0); a1 = MFMA32(xv[k4][1], bf, a1); } }
    const float bias = bsgu[g * 128 + tl]; const float* gs = gsgu;
    h4 urv[2][4]; f32x4 ggv[2][4];
#pragma unroll
    for (int cbi = 0; cbi < 2; ++cbi)
#pragma unroll
        for (int gq = 0; gq < 4; ++gq) { const int col = g * 128 + (2 * cp + cbi) * 32 + 8 * gq + 4 * hi; urv[cbi][gq] = *(const h4*)(Z + (size_t)t * ZP + ZU + col); ggv[cbi][gq] = *(const f32x4*)(gs + col); }
#pragma unroll
    for (int cbi = 0; cbi < 2; ++cbi)
#pragma unroll
        for (int gq = 0; gq < 4; ++gq) { const int col = g * 128 + (2 * cp + cbi) * 32 + 8 * gq + 4 * hi; const h4 ur = urv[cbi][gq]; const f32x4 gg = ggv[cbi][gq]; float o[4];
#pragma unroll
            for (int i = 0; i < 4; ++i) { const float mix = gg[i] * (cbi == 0 ? a0[4 * gq + i] : a1[4 * gq + i]) + bias; o[i] = gelu_tanh(up16(ur[i])) * mix; }
            u32x2 wv; wv.x = cvt_pk(o[0], o[1]); wv.y = cvt_pk(o[2], o[3]); *(u32x2*)(Y + (size_t)t * YP + 1024 + col) = wv; }
}
#define XB_TMO      128
#define XB_XCNT(j)  (256  + 64 * (j))
#define XB_XSUB(j)  (1280 + 64 * (j))
#define XB_XGEN(j)  (2304 + 64 * (j))
#define XB_TOP      3328
#define XB_TOPGEN   3392
#define XCD_BAR_WORDS 3456
#define XB_SPIN_CAP (1u << 18)
constexpr int CW_BAR = 4096;
__device__ __forceinline__ unsigned xb_ld(unsigned* p)              { return __hip_atomic_load(p, __ATOMIC_RELAXED, __HIP_MEMORY_SCOPE_AGENT); }
__device__ __forceinline__ unsigned xb_add(unsigned* p, unsigned v) { return __hip_atomic_fetch_add(p, v, __ATOMIC_RELAXED, __HIP_MEMORY_SCOPE_AGENT); }
__device__ __forceinline__ unsigned xb_xcc_id() { return (unsigned)__builtin_amdgcn_s_getreg((3 << 11) | 20) & 0xFu; }
#define XB_SPIN(cond, bar) do { unsigned _sp = 0; while (cond) { __builtin_amdgcn_s_sleep(1); \
    if ((++_sp & 255u) == 0u) { if (xb_ld(&(bar)[XB_TMO])) break; if (_sp > XB_SPIN_CAP) { atomicAdd(&(bar)[XB_TMO], 1u); break; } } } } while (0)
struct XcdBarrier { unsigned* bar; unsigned x; volatile LAS unsigned* st; };
__device__ __forceinline__ XcdBarrier xcd_barrier_post(unsigned* bar, volatile LAS unsigned* st) {
    XcdBarrier b; b.bar = bar; b.x = xb_xcc_id(); b.st = st;
    if (threadIdx.x == 0) (void)xb_add(&bar[XB_XCNT(b.x)], 1u);
    return b;
}
__device__ __forceinline__ void xcd_barrier_complete(unsigned* bar, unsigned x, unsigned& nloc, unsigned& nx) {
    const unsigned G = gridDim.x * gridDim.y * gridDim.z;
    unsigned sum, cnt, mine, sp = 0u;
    for (;;) {
        sum = 0u; cnt = 0u; mine = 0u;
#pragma unroll
        for (unsigned j = 0; j < 16; ++j) { const unsigned c = xb_ld(&bar[XB_XCNT(j)]); sum += c; cnt += (c > 0u) ? 1u : 0u; mine = (j == x) ? c : mine; }
        if (sum == G) break;
        __builtin_amdgcn_s_sleep(1);
        if ((++sp & 255u) == 0u) { if (xb_ld(&bar[XB_TMO])) break; if (sp > XB_SPIN_CAP) { atomicAdd(&bar[XB_TMO], 1u); break; } }
    }
    nloc = mine > 0u ? mine : 1u; nx = cnt > 0u ? cnt : 1u;
}
__device__ __forceinline__ void xcd_barrier(const XcdBarrier& b) {
    asm volatile("s_waitcnt vmcnt(0)" ::: "memory");
    __syncthreads();
    if (threadIdx.x == 0) {
        unsigned* bar = b.bar; asm volatile("" : "+s"(bar));
        __builtin_amdgcn_s_waitcnt(0);
        unsigned nloc = b.st[0], nx = b.st[1];
        if (nloc == 0u) { xcd_barrier_complete(bar, b.x, nloc, nx); b.st[0] = nloc; b.st[1] = nx; }
        const unsigned old = xb_add(&bar[XB_XSUB(b.x)], 1u);
        const unsigned gen = old / nloc;
        if (old + 1u == (gen + 1u) * nloc) {
            __builtin_amdgcn_fence(__ATOMIC_RELEASE, "agent");
            asm volatile("s_waitcnt vmcnt(0)" ::: "memory");
            const unsigned og = xb_add(&bar[XB_TOP], 1u);
            const unsigned tg = og / nx;
            if (og + 1u == (tg + 1u) * nx) xb_add(&bar[XB_TOPGEN], 1u);
            else XB_SPIN(xb_ld(&bar[XB_TOPGEN]) == tg, bar);
            __builtin_amdgcn_fence(__ATOMIC_ACQUIRE, "agent");
            xb_add(&bar[XB_XGEN(b.x)], 1u);
            asm volatile("s_waitcnt vmcnt(0)" ::: "memory");
        } else {
            XB_SPIN(xb_ld(&bar[XB_XGEN(b.x)]) == gen, bar);
            __builtin_amdgcn_fence(__ATOMIC_ACQUIRE, "agent");
            asm volatile("s_waitcnt vmcnt(0)" ::: "memory");
        }
    }
    __syncthreads();
}

constexpr int CW_SEAM = 16384;
constexpr int CW_SPLIT = 12288;
struct SplitBar { unsigned* ctr; unsigned* bar; unsigned x; volatile LAS unsigned* st; };
__device__ __forceinline__ void split_arrive(const SplitBar& b) {
    asm volatile("s_waitcnt vmcnt(0)" ::: "memory");
    __syncthreads();
    if (threadIdx.x == 0) { unsigned nloc = b.st[0];
        if (nloc == 0u) { unsigned nx; __builtin_amdgcn_s_waitcnt(0); xcd_barrier_complete(b.bar, b.x, nloc, nx); b.st[0] = nloc; b.st[1] = nx; }
        const unsigned old = xb_add(b.ctr + 32 * b.x, 1u);
        if (old + 1u == nloc) { __builtin_amdgcn_fence(__ATOMIC_RELEASE, "agent"); asm volatile("s_waitcnt vmcnt(0)" ::: "memory"); (void)xb_add(b.ctr + 32 * 16, nloc); } }
}
__device__ __forceinline__ void split_wait(const SplitBar& b) {
    if (threadIdx.x == 0) { const unsigned G = gridDim.x; XB_SPIN(xb_ld(b.ctr + 32 * 16) != G, b.bar); __builtin_amdgcn_fence(__ATOMIC_ACQUIRE, "agent"); asm volatile("s_waitcnt vmcnt(0)" ::: "memory"); }
    __syncthreads();
}
struct MixP { const float *gqa, *gqm, *gkm, *wsgu, *bsgu, *gsgu; };
__device__ __forceinline__ void mixer_phase(const Ctx& C, int l, const MixP& P, const XcdBarrier& xb) {
    unsigned* ctl = (unsigned*)(C.ws + WS_CTL);
    const SplitBar b1{ctl + CW_SPLIT + 544 * (2 * l), ctl + CW_BAR, xb.x, xb.st}, b2{ctl + CW_SPLIT + 544 * (2 * l + 1), ctl + CW_BAR, xb.x, xb.st};
    const unsigned* CNT = (const unsigned*)(C.ws + WS_CTL) + CW_CNT + l * 256; const unsigned* LIST = (const unsigned*)(C.ws + WS_LIST);
    LAS unsigned* pre = (LAS unsigned*)(C.lds + LDS_CTL + 256);
    LAS unsigned* nch = pre + 256; LAS int* bc = (LAS int*)(C.lds + LDS_CTL + 64); LAS unsigned* cntl = (LAS unsigned*)(C.lds + LDS_CTL + 2816);
    const int myq = (int)(__builtin_amdgcn_s_getreg((3 << 11) | 20) & 7u);
    constexpr int N_OWNWG = HA * NBLK, N_MEMWG = HM * NBLK, N_SGUWG = 64 * 8;
    split_arrive(b1);
    int npast = 0;
#pragma unroll 1
    for (int st = 0; st < 3; ++st) {
        if (st == 1) { split_wait(b1);
            if (C.tid < 256) { const unsigned cn = CNT[C.tid]; cntl[C.tid] = cn; nch[C.tid] = (cn + 255u) >> 8; }
            __syncthreads();
            if (C.tid < 256) { unsigned sum = 0u; for (int k = 0; k < 256; ++k) { const unsigned v = nch[k]; sum += (k <= C.tid) ? v : 0u; } pre[C.tid] = sum; }
            __syncthreads();
            npast = (int)pre[255]; }
        if (st == 2) split_arrive(b2);
        unsigned* qbase = ctl + 8192 + 64 * ((l * 3 + st) * 8);
        const int nA = st == 0 ? N_OWNWG : (st == 1 ? N_MEMWG : N_SGUWG), nB = st == 1 ? npast : 0;
#define QTOT(x_) (((nA * ((x_) + 1)) >> 3) - ((nA * (x_)) >> 3) + (int)(((long)nB * ((x_) + 1)) >> 3) - (int)(((long)nB * (x_)) >> 3))
        int x = myq;
        for (;;) { unsigned* q = qbase + 64 * x;
            const int a_lo = (nA * x) >> 3, a_n = ((nA * (x + 1)) >> 3) - a_lo;
            const int p_lo = (int)(((long)nB * x) >> 3), p_n = (int)(((long)nB * (x + 1)) >> 3) - p_lo;
            const int ntot = a_n + p_n;
            int knx = 0; if (C.tid == 0) knx = (int)atomicAdd(q, 1u);
            for (;;) { if (C.tid == 0) bc[0] = knx;
                __syncthreads(); int k = bc[0]; __syncthreads();
                if (k >= ntot) break;
                if (C.tid == 0) knx = (int)atomicAdd(q, 1u);
                if (st == 2) { const int jj = a_lo + k; sgu_item(C, P.wsgu, P.bsgu, P.gsgu, jj >> 3, jj & 7, C.wave); continue; }
                if (st == 1 && k < a_n) { const int jj = a_lo + k; mem_wg(C, l, P.gqm, P.gkm, jj >> 5, jj & 31); continue; }
                int h_, j_, t_, nt_, sl_; bool va_;
                if (st == 1) { const int it = p_lo + (k - a_n);
                    int lo = 0, hi2 = 255;
                    while (lo < hi2) { const int mid = (lo + hi2) >> 1; if ((int)pre[mid] > it) hi2 = mid; else lo = mid + 1; }
                    const int hj = __builtin_amdgcn_readfirstlane(lo), chunk = it - (hj ? (int)pre[hj - 1] : 0), n = (int)cntl[hj];
                    const int e0 = chunk * 256 + C.wave * 32, e = e0 + (C.lane & 31); va_ = e < n;
                    const unsigned ent = LIST[(size_t)hj * 8192 + (va_ ? e : chunk * 256)];
                    h_ = hj >> 5; j_ = hj & 31; t_ = (int)(ent & 0xffffu); nt_ = e0 < n ? 8 : 0; sl_ = (int)(ent >> 16);
                } else { const int jj = a_lo + k;
                    const int qt = C.wave < 4 ? C.wave : 11 - C.wave;
                    h_ = jj >> 5; j_ = 31 - (jj & 31); t_ = j_ * 256 + qt * 32 + (C.lane & 31); nt_ = qt + 1; sl_ = 3; va_ = true; }
                moba_wg(C, P.gqa, h_, j_, t_, nt_, sl_, va_); }
            if (C.tid == 0) { unsigned cv[8];
#pragma unroll
                for (int y = 0; y < 8; ++y) cv[y] = __hip_atomic_load(qbase + 64 * y, __ATOMIC_RELAXED, __HIP_MEMORY_SCOPE_AGENT);
                int nxq = -1;
#pragma unroll
                for (int sq = 7; sq >= 1; --sq) { const int y = (myq + sq) & 7; if ((int)cv[y] < QTOT(y)) nxq = y; }
                bc[1] = nxq; }
            __syncthreads(); x = bc[1]; __syncthreads();
            if (x < 0) break;
        }
#undef QTOT
    }
    split_wait(b2);
}

#define INP(k) ((const float*)(((unsigned long long)(unsigned)__builtin_amdgcn_readfirstlane((int)((volatile LAS unsigned*)(C.lds + LDS_CTL + 2560))[2 * (k) + 1]) << 32) | (unsigned long long)(unsigned)__builtin_amdgcn_readfirstlane((int)((volatile LAS unsigned*)(C.lds + LDS_CTL + 2560))[2 * (k)])))
__global__ void __launch_bounds__(NTHREADS, 2) fwd_kernel(Args args) {
    extern __shared__ __attribute__((aligned(16))) unsigned char lds_raw[];
    cg::grid_group grid = cg::this_grid();
    Ctx C; C.lds = (LAS unsigned char*)lds_raw; C.tid = threadIdx.x; C.lane = C.tid & 63; C.wave = __builtin_amdgcn_readfirstlane(C.tid >> 6);
    C.G = gridDim.x; C.gw = blockIdx.x * NWAVES + C.wave; C.NGW = C.G * NWAVES;
    C.out = args.out; C.ws = args.ws;
    const int lo = args.ph_lo, hi = args.ph_hi;
    const int wave0 = __builtin_amdgcn_readfirstlane(threadIdx.x >> 6);
    volatile LAS unsigned* bst = (volatile LAS unsigned*)(C.lds + LDS_CTL);
    if (threadIdx.x < 2) bst[threadIdx.x] = 0u;
    if (threadIdx.x < 18) ((LAS unsigned long long*)(C.lds + LDS_CTL + 2560))[threadIdx.x] = (unsigned long long)args.in[threadIdx.x];
    __syncthreads();
    const XcdBarrier xbar = xcd_barrier_post((unsigned*)(args.ws + WS_CTL) + CW_BAR, bst);
    LAS unsigned char* ring = C.lds;
#pragma unroll 1
    for (int ph = lo; ph < hi; ++ph) {
#define REFRESH_TID do { int w0_ = wave0; asm volatile("" : "+s"(w0_)); int tid_ = w0_ * 64 + (int)__builtin_amdgcn_mbcnt_hi(~0u, __builtin_amdgcn_mbcnt_lo(~0u, 0u)); asm volatile("" : "+v"(tid_)); C.tid = tid_; C.lane = tid_ & 63; C.wave = w0_; } while (0)
        REFRESH_TID;
        int bx = blockIdx.x; asm volatile("" : "+s"(bx)); C.gw = bx * NWAVES + C.wave; size_t zo_ = 0; asm volatile("" : "+s"(zo_)); C.ws = args.ws + zo_; C.out = args.out + zo_;
        int l = ph == 0 ? 0 : (ph - 1) / 6, kp = ph == 0 ? -1 : (ph - 1) % 6; asm volatile("" : "+s"(l), "+s"(kp));
        int cj = -1, cslot = 0, cstride = 1;
        if (kp < 0) {
            for (int pl = 0; pl < NLAYER; ++pl) rms_rows(C, INP(1), INP(11) + pl * D_, C.w16(WS_MEMN) + (size_t)pl * NMEM * D_, NMEM);
            { fx_t* RSS = (fx_t*)(C.ws + WS_RSS); xb_rows(C, INP(0), C.w16(WS_HN), RSS, S_);
              for (int i = bx * NTHREADS + C.tid; i < 3 * S_; i += C.G * NTHREADS) RSS[S_ + i] = 0ull;
              fx_t* RSSV = (fx_t*)(C.ws + WS_RSSV); for (int i = bx * NTHREADS + C.tid; i < S_; i += C.G * NTHREADS) RSSV[i] = 0ull;
              unsigned* ONES = (unsigned*)(C.ws + WS_ONES);
_Pragma("unroll 1")
              for (int b = bx; b < 64; b += C.G) ONES[b * NTHREADS + C.tid] = 0x3F803F80u; }
            cj = 0; cslot = C.gw; cstride = C.NGW;
        } else if (kp == 0) {
            { pg8::Gemm g{C.w16(WS_HN), C.wl(l, WL_IN), S_, ZN, D_, D_, D_}; pg8::StaticOrder S; S.init(S_, ZN, C.G, bx); pg8::EpiZ E{C.w16(WS_Z), C.w16(WS_GATE), (const pg8::fx_t*)(C.ws + WS_RSS) + (size_t)(2 * l) * S_, C.lds, INP(5) + l * DA, (float*)(C.ws + WS_KMEAN)};
              pg8::gemm_phase<pg8::EpiZ, pg8::StaticOrder>(ring, C.tid, g, S, E); }
            REFRESH_TID;
            { pg8::Gemm g{C.wl(l, WL_IN) + (size_t)ZN * D_, C.w16(WS_HN), 2048, S_, D_, D_, D_}; pg8::StaticOrder S; S.init(2048, S_, C.G, bx); pg8::EpiStore16 E{C.w16(WS_ZT), ZTP, (const pg8::fx_t*)(C.ws + WS_RSS) + (size_t)(2 * l) * S_, 2, (pg8::fx_t*)(C.ws + WS_RSSV)};
              pg8::gemm_phase<pg8::EpiStore16, pg8::StaticOrder>(ring, C.tid, g, S, E); }
            if (l == 0) for (int ll = 0; ll < NLAYER; ++ll) {
                REFRESH_TID;
                { pg8::Gemm g{C.w16(WS_MEMN) + (size_t)ll * NMEM * D_, C.wl(ll, WL_M), NMEM, 1024, D_, D_, D_}; pg8::StaticOrder S; S.init(NMEM, 1024, C.G, (bx + C.G - 8 * ll) % C.G);
                  pg8::EpiStore16 E{C.w16(WS_KM) + (size_t)ll * NMEM * 1024, 1024, nullptr, 0, nullptr}; pg8::gemm_phase<pg8::EpiStore16, pg8::StaticOrder>(ring, C.tid, g, S, E); }
                REFRESH_TID;
                { pg8::Gemm g{C.wl(ll, WL_M) + (size_t)1024 * D_, C.w16(WS_MEMN) + (size_t)ll * NMEM * D_, 1024, NMEM, D_, D_, D_}; pg8::StaticOrder S; S.init(1024, NMEM, C.G, (bx + C.G - 8 * ll - 4) % C.G);
                  pg8::EpiStore16 E{C.w16(WS_VMT) + (size_t)ll * 1024 * NMEM, NMEM, nullptr, 0, nullptr}; pg8::gemm_phase<pg8::EpiStore16, pg8::StaticOrder>(ring, C.tid, g, S, E); } }
            if (l == 0 && bx >= 16) { cj = 1; cslot = (bx - 16) * NWAVES + C.wave; cstride = (C.G - 16) * NWAVES; }
        } else if (kp == 1) {
            if (l == 0) kmnorm_phase(C, INP(10));
            { const fx_t* RSSV = (const fx_t*)(C.ws + WS_RSSV); float* RSTDV = (float*)(C.ws + WS_RSTDV); for (int i = bx * NTHREADS + C.tid; i < S_; i += C.G * NTHREADS) RSTDV[i] = rsqrtf(fx2f(RSSV[i]) * (1.f / 1024.f) + EPS); }
            gating_phase(C, l, INP(4) + l * DA, INP(5) + l * DA);
            { MixP P{INP(4) + l * DA, INP(9) + l * DMH, INP(10) + l * DMH, INP(7) + (size_t)l * 8 * 128 * 128, INP(8) + l * 8 * 128, INP(6) + l * 1024}; mixer_phase(C, l, P, xbar); }
            attn_combine_phase(C);
        } else if (kp == 2) {
            { pg8::Gemm g{C.w16(WS_Y), C.wl(l, WL_B), S_, D_, 3072, YP, 3072}; pg8::StaticOrder S; S.init(S_, D_, C.G, bx); pg8::EpiMerge E{C.w16(WS_GATE), C.w16(WS_MG)};
              pg8::gemm_phase<pg8::EpiMerge, pg8::StaticOrder>(ring, C.tid, g, S, E); }
        } else if (kp == 3) {
            { pg8::Gemm g{C.w16(WS_MG), C.wl(l, WL_O), S_, D_, D_, D_, D_}; pg8::StaticOrder S; S.init(S_, D_, C.G, bx); pg8::EpiRes E{INP(0), l == 0 ? (const e16_t*)nullptr : (const e16_t*)C.w16(WS_HN), nullptr, C.w16(WS_HN), (pg8::fx_t*)(C.ws + WS_RSS) + (size_t)(2 * l + 1) * S_, D_};
              pg8::gemm_phase<pg8::EpiRes, pg8::StaticOrder>(ring, C.tid, g, S, E); }
        } else if (kp == 4) {
            { pg8::Gemm g{C.w16(WS_HN), C.wl(l, WL_GU), S_, 2 * DFF, D_, D_, D_}; pg8::StaticOrder S; S.init(S_, 2 * DFF, C.G, bx); pg8::EpiSwiGLU E{C.w16(WS_GATE), DFF, (const pg8::fx_t*)(C.ws + WS_RSS) + (size_t)(2 * l + 1) * S_};
              pg8::gemm_phase<pg8::EpiSwiGLU, pg8::StaticOrder>(ring, C.tid, g, S, E); }
            if (bx >= C.G / 2) { cj = 2 + l; cslot = (bx - C.G / 2) * NWAVES + C.wave; cstride = (C.G / 2) * NWAVES; }
        } else {
            if (bx == 0 && l + 1 < NLAYER) { fx_t* RSSV = (fx_t*)(C.ws + WS_RSSV); for (int i = C.tid; i < S_; i += NTHREADS) RSSV[i] = 0ull; }
            { pg8::Gemm g{C.w16(WS_GATE), C.wl(l, WL_D), S_, D_, DFF, DFF, DFF}; pg8::StaticOrder S; S.init(S_, D_, C.G, bx); pg8::EpiRes E{nullptr, C.w16(WS_HN), l + 1 < NLAYER ? (float*)nullptr : C.out, l + 1 < NLAYER ? C.w16(WS_HN) : (e16_t*)nullptr, l + 1 < NLAYER ? (pg8::fx_t*)(C.ws + WS_RSS) + (size_t)(2 * l + 2) * S_ : (pg8::fx_t*)nullptr, D_};
              pg8::gemm_phase<pg8::EpiRes, pg8::StaticOrder>(ring, C.tid, g, S, E); }
        }
        REFRESH_TID;
        const bool seam = ph + 1 < hi, fill = seam && ph < 10;
        unsigned* ctl_ = (unsigned*)C.ws; const SplitBar sb_{ctl_ + CW_SEAM + 544 * (ph < 10 ? ph : 0), ctl_ + CW_BAR, xbar.x, xbar.st};
        int chi = 1 << 20;
#pragma unroll 1
        for (int r = 0; r < 2; ++r) {
            if (r == 1) { if (!fill) break; split_arrive(sb_); cj = 4; cslot = ph * 2048 + C.gw; cstride = C.NGW; chi = 1; }
            if (cj >= 0) convert_job(args, C, cj, cslot, cstride, 0, chi, (LAS float*)(C.lds + C.wave * 16384)); }
        if (seam) { if (hi < 0) grid.sync(); if (fill) split_wait(sb_); else xcd_barrier(xbar); }
    }
}
constexpr int N_PHASES = 1 + NLAYER * 6;

extern "C" void kernel_launch(void* const* d_in, const int* in_sizes, int n_in, void* d_out, int out_size, void* d_ws, size_t ws_size, hipStream_t stream) {
    static int grid = 0;
    if (grid == 0) {
        if (n_in != 18 || in_sizes[0] != S_ * D_ || out_size != S_ * D_ || ws_size < WS_END) {
            fprintf(stderr, "kernel_launch: unexpected shapes / workspace (n_in %d, in0 %d, out %d, ws %zu, need %zu); nothing launched\n", n_in, n_in > 0 ? in_sizes[0] : -1, out_size, ws_size, (size_t)WS_END); grid = -1; return; }
        int dev = 0, cus = 0, per_cu = 0;
        if (hipGetDevice(&dev) != hipSuccess || hipDeviceGetAttribute(&cus, hipDeviceAttributeMultiprocessorCount, dev) != hipSuccess) { grid = -1; return; }
        if (hipFuncSetAttribute((const void*)fwd_kernel, hipFuncAttributeMaxDynamicSharedMemorySize, LDS_BYTES) != hipSuccess) { fprintf(stderr, "kernel_launch: hipFuncSetAttribute failed\n"); grid = -1; return; }
        if (hipOccupancyMaxActiveBlocksPerMultiprocessor(&per_cu, (const void*)fwd_kernel, NTHREADS, LDS_BYTES) != hipSuccess || per_cu < 1) { fprintf(stderr, "kernel_launch: occupancy query says %d\n", per_cu); per_cu = 1; }
        (void)hipGetLastError();
        grid = cus * 1;
        fprintf(stderr, "kernel_launch: grid %d (cus %d, per_cu %d), ws %zu\n", grid, cus, per_cu, ws_size);
    }
    if (grid < 0) return;
    (void)hipMemsetAsync((char*)d_ws + WS_CTL, 0, 131072, stream);
    Args a{};
    for (int i = 0; i < 18; ++i) a.in[i] = (const float*)d_in[i];
    a.out = (float*)d_out; a.ws = (unsigned char*)d_ws; a.ph_lo = 0; a.ph_hi = N_PHASES;
    void* kargs[] = {&a};
    hipError_t e = hipLaunchCooperativeKernel((const void*)fwd_kernel, dim3(grid), dim3(NTHREADS), kargs, LDS_BYTES, stream);
    if (e != hipSuccess) fprintf(stderr, "kernel_launch: cooperative launch failed: %s (grid %d)\n", hipGetErrorString(e), grid);
}
```

```cpp
#include <hip/hip_runtime.h>
#include <hip/hip_cooperative_groups.h>
#include <cstdio>
#include <cstdint>
namespace cg = cooperative_groups;

#define LAS __attribute__((address_space(3)))
#define GAS __attribute__((address_space(1)))
typedef unsigned short e16_t;
typedef short h8 __attribute__((ext_vector_type(8)));
typedef short h4 __attribute__((ext_vector_type(4)));
typedef __bf16 mf8 __attribute__((ext_vector_type(8)));
typedef __bf16 mf2 __attribute__((ext_vector_type(2)));
typedef float f32x2 __attribute__((ext_vector_type(2)));
typedef float f32x4 __attribute__((ext_vector_type(4)));
typedef float f32x16 __attribute__((ext_vector_type(16)));
typedef unsigned u32x2 __attribute__((ext_vector_type(2)));
typedef unsigned u32x4 __attribute__((ext_vector_type(4)));

#define MFMA32(a, b, c) __builtin_amdgcn_mfma_f32_32x32x16_bf16(__builtin_bit_cast(mf8, (a)), __builtin_bit_cast(mf8, (b)), (c), 0, 0, 0)
#define MFMA16(a, b, c) __builtin_amdgcn_mfma_f32_16x16x32_bf16(__builtin_bit_cast(mf8, (a)), __builtin_bit_cast(mf8, (b)), (c), 0, 0, 0)

__device__ __forceinline__ unsigned cvt_pk(float lo, float hi) { f32x2 v = {lo, hi}; mf2 b = __builtin_convertvector(v, mf2); return __builtin_bit_cast(unsigned, b); }
__device__ __forceinline__ float up16(short x) { return __uint_as_float(((unsigned)(unsigned short)x) << 16); }
__device__ __forceinline__ float up_lo(unsigned w) { return __uint_as_float(w << 16); }
__device__ __forceinline__ float up_hi(unsigned w) { return __uint_as_float(w & 0xffff0000u); }
__device__ __forceinline__ h8 pack8(const float* f) { u32x4 w = {cvt_pk(f[0], f[1]), cvt_pk(f[2], f[3]), cvt_pk(f[4], f[5]), cvt_pk(f[6], f[7])}; return __builtin_bit_cast(h8, w); }
__device__ __forceinline__ float wave_sum(float v) {
#pragma unroll
    for (int o = 1; o < 64; o <<= 1) v += __shfl_xor(v, o);
    return v;
}
__device__ __forceinline__ float gelu_tanh(float x) {
    const float u = 0.7978845608028654f * (x + 0.044715f * x * x * x);
    return x / (1.0f + __builtin_amdgcn_exp2f(-2.885390081777927f * u));
}
__device__ __forceinline__ float sigmoidf_(float x) { return 1.0f / (1.0f + __builtin_amdgcn_exp2f(-1.4426950408889634f * x)); }
__device__ __forceinline__ int crow(int r, int hi) { return (r & 3) + 8 * (r >> 2) + 4 * hi; }

constexpr int S_ = 8192, D_ = 2048, NLAYER = 2;
constexpr int HA = 8, DA = 128, NBLK = 32;
constexpr int HM = 4, DMH = 256, NMEM = 256;
constexpr int DFF = 5632, WINC = 12288;
constexpr int ZP = 4096, ZN = 10240;
constexpr int ZQ = 0, ZK = 1024, ZU = 2048, ZQM = 3072, ZG = 4096;
constexpr int ZTP = 8192;
constexpr int YP = 3072;
constexpr float EPS = 1e-6f, LOG2E = 1.4426950408889634f;

constexpr size_t MiB = 1u << 20;
constexpr size_t WS_CTL = 0;
constexpr size_t WL_IN = 0, WL_B = 48 * MiB, WL_O = 60 * MiB, WL_GU = 68 * MiB, WL_D = 112 * MiB, WL_M = 134 * MiB, WL_SIZE = 142 * MiB;
constexpr size_t WS_W = 1 * MiB;
constexpr size_t WS_HN = WS_W + 2 * WL_SIZE;
constexpr size_t WS_Z = WS_HN + 32 * MiB;
constexpr size_t WS_GATE = WS_Z + 64 * MiB;
constexpr size_t WS_ZT = WS_GATE + 96 * MiB;
constexpr size_t WS_Y = WS_ZT + 32 * MiB;
constexpr size_t WS_PART = WS_Y + 48 * MiB;
constexpr size_t WS_MG = WS_PART + 64 * MiB;
constexpr size_t WS_MEMN = WS_MG + 32 * MiB;
constexpr size_t WS_KM = WS_MEMN + 2 * MiB;
constexpr size_t WS_VMT = WS_KM + 1 * MiB;
constexpr size_t WS_KMEAN = WS_VMT + 1 * MiB;
constexpr size_t WS_RSSV = WS_KMEAN + 256 * 1024;
constexpr size_t WS_RSS = WS_RSSV + 64 * 1024;
constexpr size_t WS_RSTDV = WS_RSSV + 384 * 1024;
constexpr size_t WS_LIST = WS_RSSV + 512 * 1024;
constexpr size_t WS_ML = WS_LIST + 8 * MiB;
constexpr size_t WS_SEL = WS_ML + 2 * MiB;
constexpr size_t WS_ONES = WS_SEL + 1 * MiB;
constexpr size_t WS_END = WS_ONES + 1 * MiB;
constexpr int CW_CNT = 2048;

namespace pg8 {
constexpr int EPI_OFF = 139264;
constexpr int BM = 256, BK = 64, HALF = 128, HTB = HALF * BK * 2, STAGE_BYTES = 8 * HTB, NXCD = 8, WGM = 8;
__host__ __device__ __forceinline__ int lds_byte(int r, int c) { const int st = (r >> 4) * 2 + (c >> 5), rr = r & 15, cc = c & 31, ob = rr * 64 + cc * 2; return st * 1024 + (ob ^ (((ob >> 9) & 1) << 5)); }
__host__ __device__ __forceinline__ void stage_rc(int b, int& R, int& C) { const int st = b / 1024, sb = b % 1024, swz = sb ^ (((sb >> 9) & 1) << 5); R = (st >> 1) * 16 + swz / 64; C = (st & 1) * 32 + (swz % 64) / 2; }
__host__ __device__ __forceinline__ int perm32(int rho) { const int n = rho >> 4, i = rho & 15; return 8 * (i >> 2) + 4 * n + (i & 3); }

struct Unit { int pm, pn; };
struct Gemm { const e16_t* A; const e16_t* Bt; int M, N, K, lda, ldb; };

struct StaticOrder {
    int nM, nN, nwg, G, c;
    __host__ __device__ void init(int M, int N, int G_, int c_) { nM = M / BM; nN = N / BM; nwg = nM * nN; G = G_; c = c_; }
    __host__ __device__ bool next(int i, Unit& u) const {
        const long L = (long)i * G + c; if (L >= nwg) return false;
        int wgid = (int)L; { const int q = nwg / NXCD, r = nwg % NXCD, xcd = wgid % NXCD, off = wgid / NXCD; wgid = (xcd < r ? xcd * (q + 1) : r * (q + 1) + (xcd - r) * q) + off; }
        const int nig = WGM * nN, gid = wgid / nig, fm = gid * WGM, gsz = (nM - fm) < WGM ? (nM - fm) : WGM;
        u.pm = fm + ((wgid % nig) % gsz); u.pn = (wgid % nig) / gsz; return true;
    }
    __device__ __forceinline__ void a_ready(const Unit&) const {}
    __device__ __forceinline__ void done(const Unit&) const {}
};

#ifndef ST_AUX
#define ST_AUX 0
#endif
struct WT {
    __amdgpu_buffer_rsrc_t r;
    __device__ __forceinline__ explicit WT(const void* p) : r(__builtin_amdgcn_make_buffer_rsrc((void*)p, 0, 0x7fffffff, 0x00020000)) {}
    __device__ __forceinline__ void st(unsigned byteoff, u32x4 v) const { __builtin_amdgcn_raw_buffer_store_b128(v, r, byteoff, 0, ST_AUX); }
    __device__ __forceinline__ void stf(unsigned byteoff, f32x4 v) const { __builtin_amdgcn_raw_buffer_store_b128(__builtin_bit_cast(u32x4, v), r, byteoff, 0, ST_AUX); }
};
typedef unsigned long long fx_t;
constexpr float FX_ONE = 1048576.f, FX_INV = 1.f / 1048576.f;
__device__ __forceinline__ float fx2f(fx_t v) { return (float)v * FX_INV; }
__device__ __forceinline__ fx_t f2fx(float v) { return (fx_t)(v * FX_ONE); }
__device__ __forceinline__ float rstd_of(float ss) { return rsqrtf(ss * (1.f / 2048.f) + 1e-6f); }
struct EpiStore16 {
    static constexpr bool PERM = true, HAS_MID = false;
    e16_t* O; int ldc; const fx_t* rss; int mode; fx_t* rssv;
    __device__ __forceinline__ void operator()(const f32x4 (&acc)[2][2][4][2], const Unit& u, int wr, int wc, int fr, int fq) const {
        const int row0 = u.pm * BM + wr * 64 + fr, col0 = u.pn * BM + wc * 32 + 8 * fq;
        f32x4 cs[2][2];
#pragma unroll
        for (int bj = 0; bj < 2; ++bj)
#pragma unroll
            for (int n = 0; n < 2; ++n) { cs[bj][n] = (f32x4){1.f, 1.f, 1.f, 1.f};
                if (mode == 2) { const fx_t* rp = rss + col0 + bj * HALF + 4 * n; cs[bj][n] = (f32x4){rstd_of(fx2f(rp[0])), rstd_of(fx2f(rp[1])), rstd_of(fx2f(rp[2])), rstd_of(fx2f(rp[3]))}; } }
        const WT wt(O); const bool dogelu = (mode == 2) && rssv != nullptr && u.pm >= 4;
        float sq[2][8];
#pragma unroll
        for (int bj = 0; bj < 2; ++bj)
#pragma unroll
            for (int e = 0; e < 8; ++e) sq[bj][e] = 0.f;
        float rsv[2][4];
#pragma unroll
        for (int ai = 0; ai < 2; ++ai)
#pragma unroll
            for (int m = 0; m < 4; ++m) rsv[ai][m] = (mode == 1) ? fx2f(rss[row0 + ai * HALF + m * 16]) : 0.f;
#pragma unroll
        for (int ai = 0; ai < 2; ++ai)
#pragma unroll
            for (int m = 0; m < 4; ++m) { const int row = row0 + ai * HALF + m * 16; const unsigned rowb = (unsigned)(row * ldc + col0) * 2u;
                const float rs = (mode == 1) ? rstd_of(rsv[ai][m]) : 1.f;
#pragma unroll
                for (int bj = 0; bj < 2; ++bj) { f32x4 v0 = acc[ai][bj][m][0] * cs[bj][0] * rs, v1 = acc[ai][bj][m][1] * cs[bj][1] * rs;
                    if (dogelu) {
#pragma unroll
                        for (int e = 0; e < 4; ++e) { v0[e] = gelu_tanh(v0[e]); v1[e] = gelu_tanh(v1[e]); sq[bj][e] += v0[e] * v0[e]; sq[bj][4 + e] += v1[e] * v1[e]; } }
                    u32x4 w; w.x = cvt_pk(v0[0], v0[1]); w.y = cvt_pk(v0[2], v0[3]); w.z = cvt_pk(v1[0], v1[1]); w.w = cvt_pk(v1[2], v1[3]);
                    wt.st(rowb + bj * HALF * 2, w); } }
        if (dogelu) {
#pragma unroll
            for (int bj = 0; bj < 2; ++bj)
#pragma unroll
                for (int e = 0; e < 8; ++e) { float v = sq[bj][e]; v += __shfl_xor(v, 1); v += __shfl_xor(v, 2); v += __shfl_xor(v, 4); v += __shfl_xor(v, 8);
                    if (fr == 0) atomicAdd(rssv + col0 + bj * HALF + e, f2fx(v)); } }
    }
};
struct EpiSwiGLU {
    static constexpr bool PERM = true, HAS_MID = false;
    e16_t* O; int ldc; const fx_t* rss;
    __device__ __forceinline__ void operator()(const f32x4 (&acc)[2][2][4][2], const Unit& u, int wr, int wc, int fr, int fq) const {
        const int row0 = u.pm * BM + wr * 64 + fr, col0 = u.pn * HALF + wc * 32 + 8 * fq;
        const WT wt(O);
        float rsv[2][4];
#pragma unroll
        for (int ai = 0; ai < 2; ++ai)
#pragma unroll
            for (int m = 0; m < 4; ++m) rsv[ai][m] = fx2f(rss[row0 + ai * HALF + m * 16]);
#pragma unroll
        for (int ai = 0; ai < 2; ++ai)
#pragma unroll
            for (int m = 0; m < 4; ++m) { const int row = row0 + ai * HALF + m * 16; const unsigned rowb = (unsigned)(row * ldc + col0) * 2u; const float rs = rstd_of(rsv[ai][m]);
                float hv[8];
#pragma unroll
                for (int n = 0; n < 2; ++n)
#pragma unroll
                    for (int i = 0; i < 4; ++i) { const float g = acc[ai][0][m][n][i] * rs, up = acc[ai][1][m][n][i] * rs; hv[n * 4 + i] = g * sigmoidf_(g) * up; }
                u32x4 w; w.x = cvt_pk(hv[0], hv[1]); w.y = cvt_pk(hv[2], hv[3]); w.z = cvt_pk(hv[4], hv[5]); w.w = cvt_pk(hv[6], hv[7]);
                wt.st(rowb, w); }
    }
};
struct EpiRes {
    static constexpr bool PERM = true, HAS_MID = false;
    const float* base; const e16_t* base16; float* out; e16_t* xb; fx_t* rss; int ldc;
    __device__ __forceinline__ void operator()(const f32x4 (&acc)[2][2][4][2], const Unit& u, int wr, int wc, int fr, int fq) const {
        const int row0 = u.pm * BM + wr * 64 + fr, col0 = u.pn * BM + wc * 32 + 8 * fq;
        const WT wo(out ? (const void*)out : (const void*)xb), wx(xb ? (const void*)xb : (const void*)out);
        if (base16) {
            h8 raw[2][4][2];
#pragma unroll
            for (int ai = 0; ai < 2; ++ai)
#pragma unroll
                for (int m = 0; m < 4; ++m) { const e16_t* bp = base16 + (size_t)(row0 + ai * HALF + m * 16) * ldc + col0;
#pragma unroll
                    for (int bj = 0; bj < 2; ++bj) raw[ai][m][bj] = *(const h8*)(bp + bj * HALF); }
#pragma unroll
            for (int ai = 0; ai < 2; ++ai)
#pragma unroll
                for (int m = 0; m < 4; ++m) { const int row = row0 + ai * HALF + m * 16; const size_t off = (size_t)row * ldc + col0; float ss = 0.f;
#pragma unroll
                    for (int bj = 0; bj < 2; ++bj) { const h8 r = raw[ai][m][bj];
                        const f32x4 v0 = (f32x4){up16(r[0]), up16(r[1]), up16(r[2]), up16(r[3])} + acc[ai][bj][m][0], v1 = (f32x4){up16(r[4]), up16(r[5]), up16(r[6]), up16(r[7])} + acc[ai][bj][m][1];
                        if (out) { wo.stf((unsigned)(off + bj * HALF) * 4u, v0); wo.stf((unsigned)(off + bj * HALF + 4) * 4u, v1); }
                        ss += (v0[0] * v0[0] + v0[1] * v0[1]) + (v0[2] * v0[2] + v0[3] * v0[3]) + (v1[0] * v1[0] + v1[1] * v1[1]) + (v1[2] * v1[2] + v1[3] * v1[3]);
                        if (xb) { u32x4 w; w.x = cvt_pk(v0[0], v0[1]); w.y = cvt_pk(v0[2], v0[3]); w.z = cvt_pk(v1[0], v1[1]); w.w = cvt_pk(v1[2], v1[3]); wx.st((unsigned)(off + bj * HALF) * 2u, w); } }
                    if (rss) { ss += __shfl_xor(ss, 16); ss += __shfl_xor(ss, 32); if (fq == 0) atomicAdd(rss + row, f2fx(ss)); } }
            return; }
#pragma unroll
        for (int ai = 0; ai < 2; ++ai) {
            f32x4 bv[4][2][2];
#pragma unroll
            for (int m = 0; m < 4; ++m) { const float* bp = base + (size_t)(row0 + ai * HALF + m * 16) * ldc + col0;
#pragma unroll
                for (int bj = 0; bj < 2; ++bj) { bv[m][bj][0] = *(const f32x4*)(bp + bj * HALF); bv[m][bj][1] = *(const f32x4*)(bp + bj * HALF + 4); } }
#pragma unroll
            for (int m = 0; m < 4; ++m) { const int row = row0 + ai * HALF + m * 16; const size_t off = (size_t)row * ldc + col0; float ss = 0.f;
#pragma unroll
                for (int bj = 0; bj < 2; ++bj) { const f32x4 v0 = bv[m][bj][0] + acc[ai][bj][m][0], v1 = bv[m][bj][1] + acc[ai][bj][m][1];
                    if (out) { wo.stf((unsigned)(off + bj * HALF) * 4u, v0); wo.stf((unsigned)(off + bj * HALF + 4) * 4u, v1); }
                    ss += (v0[0] * v0[0] + v0[1] * v0[1]) + (v0[2] * v0[2] + v0[3] * v0[3]) + (v1[0] * v1[0] + v1[1] * v1[1]) + (v1[2] * v1[2] + v1[3] * v1[3]);
                    if (xb) { u32x4 w; w.x = cvt_pk(v0[0], v0[1]); w.y = cvt_pk(v0[2], v0[3]); w.z = cvt_pk(v1[0], v1[1]); w.w = cvt_pk(v1[2], v1[3]); wx.st((unsigned)(off + bj * HALF) * 2u, w); } }
                if (rss) { ss += __shfl_xor(ss, 16); ss += __shfl_xor(ss, 32); if (fq == 0) atomicAdd(rss + row, f2fx(ss)); } }
        }
    }
};

struct EpiZ {
    static constexpr bool PERM = true, HAS_MID = false;
    e16_t* Z; e16_t* GATE; const fx_t* rss; LAS unsigned char* lds; const float* gk; float* kmean;
    __device__ __forceinline__ void operator()(const f32x4 (&acc)[2][2][4][2], const Unit& u, int wr, int wc, int fr, int fq) const {
        const int row0 = u.pm * BM + wr * 64 + fr, col0 = u.pn * BM + wc * 32 + 8 * fq;
        const WT wz(Z), wg(GATE);
        float rsv[2][4];
#pragma unroll
        for (int ai = 0; ai < 2; ++ai)
#pragma unroll
            for (int m = 0; m < 4; ++m) rsv[ai][m] = fx2f(rss[row0 + ai * HALF + m * 16]);
        if (u.pn >= 4 && u.pn < 8) {
            LAS float* P = (LAS float*)(lds + EPI_OFF); LAS float* KS = P + 2048;
#pragma unroll
            for (int ai = 0; ai < 2; ++ai)
#pragma unroll
                for (int m = 0; m < 4; ++m) { const float rs = rstd_of(rsv[ai][m]); const int rl = ai * HALF + wr * 64 + m * 16 + fr;
#pragma unroll
                    for (int bj = 0; bj < 2; ++bj) { const f32x4 v0 = acc[ai][bj][m][0] * rs, v1 = acc[ai][bj][m][1] * rs;
                        float ss = (v0[0] * v0[0] + v0[1] * v0[1]) + (v0[2] * v0[2] + v0[3] * v0[3]) + (v1[0] * v1[0] + v1[1] * v1[1]) + (v1[2] * v1[2] + v1[3] * v1[3]);
                        ss += __shfl_xor(ss, 16); ss += __shfl_xor(ss, 32);
                        if (fq == 0) P[(rl * 2 + bj) * 4 + wc] = ss; } }
            asm volatile("s_waitcnt lgkmcnt(0)" ::: "memory"); __builtin_amdgcn_s_barrier(); asm volatile("" ::: "memory");
            const f32x4 g0 = *(const f32x4*)(gk + wc * 32 + 8 * fq), g1 = *(const f32x4*)(gk + wc * 32 + 8 * fq + 4);
            float cs[2][8];
#pragma unroll
            for (int bj = 0; bj < 2; ++bj)
#pragma unroll
                for (int e = 0; e < 8; ++e) cs[bj][e] = 0.f;
#pragma unroll
            for (int ai = 0; ai < 2; ++ai)
#pragma unroll
                for (int m = 0; m < 4; ++m) { const int rl = ai * HALF + wr * 64 + m * 16 + fr; const unsigned rowb = (unsigned)((row0 + ai * HALF + m * 16) * ZP + col0) * 2u; const float rs = rstd_of(rsv[ai][m]);
#pragma unroll
                    for (int bj = 0; bj < 2; ++bj) { const f32x4 pt = *(const LAS f32x4*)(P + (rl * 2 + bj) * 4);
                        const float rk = rsqrtf(((pt[0] + pt[1]) + (pt[2] + pt[3])) * (1.f / 128.f) + 1e-6f) * rs;
                        const f32x4 v0 = acc[ai][bj][m][0] * rk * g0, v1 = acc[ai][bj][m][1] * rk * g1;
#pragma unroll
                        for (int e = 0; e < 4; ++e) { cs[bj][e] += v0[e]; cs[bj][4 + e] += v1[e]; }
                        u32x4 w; w.x = cvt_pk(v0[0], v0[1]); w.y = cvt_pk(v0[2], v0[3]); w.z = cvt_pk(v1[0], v1[1]); w.w = cvt_pk(v1[2], v1[3]);
                        wz.st(rowb + bj * HALF * 2, w); } }
#pragma unroll
            for (int bj = 0; bj < 2; ++bj)
#pragma unroll
                for (int e = 0; e < 8; ++e) { float v = cs[bj][e]; v += __shfl_xor(v, 1); v += __shfl_xor(v, 2); v += __shfl_xor(v, 4); v += __shfl_xor(v, 8); cs[bj][e] = v; }
            if (fr == 0) {
#pragma unroll
                for (int bj = 0; bj < 2; ++bj)
#pragma unroll
                    for (int e = 0; e < 8; ++e) KS[wr * 256 + bj * HALF + wc * 32 + 8 * fq + e] = cs[bj][e]; }
            asm volatile("s_waitcnt lgkmcnt(0)" ::: "memory"); __builtin_amdgcn_s_barrier(); asm volatile("" ::: "memory");
            const int tl = (wr * 4 + wc) * 64 + fq * 16 + fr;
            if (tl < 256) kmean[(size_t)((2 * (u.pn - 4) + (tl >> 7)) * 32 + u.pm) * 128 + (tl & 127)] = (KS[tl] + KS[256 + tl]) * (1.f / 256.f);
        } else if (u.pn < 16) {
#pragma unroll
            for (int ai = 0; ai < 2; ++ai)
#pragma unroll
                for (int m = 0; m < 4; ++m) { const unsigned rowb = (unsigned)((row0 + ai * HALF + m * 16) * ZP + col0) * 2u; const float rs = rstd_of(rsv[ai][m]);
#pragma unroll
                    for (int bj = 0; bj < 2; ++bj) { const f32x4 v0 = acc[ai][bj][m][0] * rs, v1 = acc[ai][bj][m][1] * rs;
                        u32x4 w; w.x = cvt_pk(v0[0], v0[1]); w.y = cvt_pk(v0[2], v0[3]); w.z = cvt_pk(v1[0], v1[1]); w.w = cvt_pk(v1[2], v1[3]);
                        wz.st(rowb + bj * HALF * 2, w); } }
        } else {
            const int gt = u.pn - 16;
            const unsigned lo = (unsigned)((wr * 4 + wc) * 8192 + (fq * 16 + fr) * 8);
            if (gt < 16) {
                const unsigned g0 = (unsigned)(((0 * 32 + u.pm) * 8 + (gt >> 1)) * 65536 + lo) * 2u; const WT wg1(GATE + (size_t)32 * 8 * 65536);
#pragma unroll
                for (int ai = 0; ai < 2; ++ai)
#pragma unroll
                    for (int m = 0; m < 4; ++m) { const float rs = rstd_of(rsv[ai][m]) * -1.4426950408889634f;
                        float r1[8], eb[8];
#pragma unroll
                        for (int n = 0; n < 2; ++n)
#pragma unroll
                            for (int i = 0; i < 4; ++i) { const float ea = __builtin_amdgcn_exp2f(__builtin_amdgcn_fmed3f(acc[ai][0][m][n][i] * rs, -43.28f, 43.28f)); eb[n * 4 + i] = __builtin_amdgcn_exp2f(__builtin_amdgcn_fmed3f(acc[ai][1][m][n][i] * rs, -43.28f, 43.28f));
                                const float sb = __builtin_amdgcn_rcpf(1.f + eb[n * 4 + i]); r1[n * 4 + i] = __builtin_amdgcn_rcpf(sb * (1.f + ea)); eb[n * 4 + i] = sb; }
                        const unsigned o = (unsigned)(((ai * 4 + m) * 2 + (gt & 1)) * 1024);
                        wg.st(g0 + o, __builtin_bit_cast(u32x4, pack8(r1))); wg1.st(g0 + o, __builtin_bit_cast(u32x4, pack8(eb))); }
            } else {
                const unsigned gb = (unsigned)(((2 * 32 + u.pm) * 8 + (gt - 16)) * 65536 + lo) * 2u;
#pragma unroll
                for (int ai = 0; ai < 2; ++ai)
#pragma unroll
                    for (int m = 0; m < 4; ++m) { const float rs = rstd_of(rsv[ai][m]) * -1.4426950408889634f;
#pragma unroll
                        for (int bj = 0; bj < 2; ++bj) { float g[8];
#pragma unroll
                            for (int i = 0; i < 4; ++i) { g[i] = 1.f + __builtin_amdgcn_exp2f(__builtin_amdgcn_fmed3f(acc[ai][bj][m][0][i] * rs, -43.28f, 43.28f)); g[4 + i] = 1.f + __builtin_amdgcn_exp2f(__builtin_amdgcn_fmed3f(acc[ai][bj][m][1][i] * rs, -43.28f, 43.28f)); }
                            wg.st(gb + (unsigned)(((ai * 4 + m) * 2 + bj) * 1024), __builtin_bit_cast(u32x4, pack8(g))); } }
            }
        }
    }
};
struct EpiMerge {
    static constexpr bool PERM = true, HAS_MID = true;
    const e16_t* GATE; e16_t* MG;
    __device__ __forceinline__ const e16_t* gptr(int b, const Unit& u, int wr, int wc, int fr, int fq) const { return GATE + ((size_t)((b * 32 + u.pm) * 8 + u.pn)) * 65536 + (wr * 4 + wc) * 8192 + (fq * 16 + fr) * 8; }
    __device__ __forceinline__ void mid(f32x4 (&acc)[2][2][4][2], const Unit& u, int t, int wr, int wc, int fr, int fq) const {
        const e16_t* np = gptr(t == 16 ? 0 : 1, u, wr, wc, fr, fq); const e16_t* dp = (t == 16) ? GATE + (WS_ONES - WS_GATE) / 2 + (wr * 4 + wc) * 8192 + (fq * 16 + fr) * 8 : gptr(2, u, wr, wc, fr, fq);
#pragma unroll
        for (int ai = 0; ai < 2; ++ai)
#pragma unroll
            for (int m = 0; m < 4; ++m) {
#pragma unroll
                for (int bj = 0; bj < 2; ++bj) { const int o = ((ai * 4 + m) * 2 + bj) * 512; const h8 nn = *(const h8*)(np + o), dd = *(const h8*)(dp + o);
#pragma unroll
                    for (int i = 0; i < 4; ++i) { acc[ai][bj][m][0][i] *= up16(dd[i]) * up16(nn[i]); acc[ai][bj][m][1][i] *= up16(dd[4 + i]) * up16(nn[4 + i]); } }
                if (m == 3) asm volatile("" ::: "memory"); }
    }
    __device__ __forceinline__ void operator()(const f32x4 (&acc)[2][2][4][2], const Unit& u, int wr, int wc, int fr, int fq) const {
        const int row0 = u.pm * BM + wr * 64 + fr, col0 = u.pn * BM + wc * 32 + 8 * fq; const e16_t* sp = gptr(2, u, wr, wc, fr, fq); const WT wm(MG);
        h8 sg[2][4][2];
#pragma unroll
        for (int ai = 0; ai < 2; ++ai)
#pragma unroll
            for (int m = 0; m < 4; ++m)
#pragma unroll
                for (int bj = 0; bj < 2; ++bj) sg[ai][m][bj] = *(const h8*)(sp + ((ai * 4 + m) * 2 + bj) * 512);
#pragma unroll
        for (int ai = 0; ai < 2; ++ai)
#pragma unroll
            for (int m = 0; m < 4; ++m) { const unsigned rowb = (unsigned)((row0 + ai * HALF + m * 16) * 2048 + col0) * 2u;
#pragma unroll
                for (int bj = 0; bj < 2; ++bj) { float v[8];
#pragma unroll
                    for (int i = 0; i < 4; ++i) { v[i] = acc[ai][bj][m][0][i] * __builtin_amdgcn_rcpf(up16(sg[ai][m][bj][i])); v[4 + i] = acc[ai][bj][m][1][i] * __builtin_amdgcn_rcpf(up16(sg[ai][m][bj][4 + i])); }
                    wm.st(rowb + bj * HALF * 2, __builtin_bit_cast(u32x4, pack8(v))); } }
    }
};

template <class Epi, class Sched, bool ALIGN_EPI = true, bool SP2 = true>
__device__ __forceinline__ void gemm_phase(LAS unsigned char* lds, const int tid, const Gemm g, const Sched& S, const Epi& E) {
    const int wid = __builtin_amdgcn_readfirstlane(tid >> 6), lane = tid & 63, wr = wid >> 2, wc = wid & 3, fr = lane & 15, fq = lane >> 4;
    const int K = g.K, nt = K / BK;
    unsigned voffA[2], voffB[2];
#pragma unroll
    for (int i = 0; i < 2; ++i) { int R, C; stage_rc(tid * 16 + i * 8192, R, C); const int Rb = Epi::PERM ? ((R & ~31) + perm32(R & 31)) : R;
        voffA[i] = (unsigned)(R * g.lda + C) * 2u; voffB[i] = (unsigned)(Rb * g.ldb + C) * 2u; }
    const size_t kstep = (size_t)(BK * 2);
    const size_t hstepA = (size_t)HALF * g.lda * 2, hstepB = (size_t)HALF * g.ldb * 2;
    const size_t tstepA = 2 * hstepA, tstepB = 2 * hstepB;
    const unsigned ldsw = (unsigned)wid * 1024u;
    const int aoff = lds_byte(wr * 64 + fr, fq * 8), boff = lds_byte(wc * 32 + fr, fq * 8);
#define PG8_SA(b, h) (((b) * 2 + (h)) * HTB)
#define PG8_SB(b, h) ((4 + (b) * 2 + (h)) * HTB)
#define PG8_STAGE(bufoff, gbase, voff) do { _Pragma("unroll") for (int _i = 0; _i < 2; ++_i) \
        __builtin_amdgcn_global_load_lds((const unsigned*)((const char*)(gbase) + (voff)[_i]), (LAS unsigned*)(lds + (bufoff) + ldsw + _i * 8192), 16, 0, 0); } while (0)
#define PG8_LDA(dst, b, h) do { _Pragma("unroll") for (int m = 0; m < 4; ++m) _Pragma("unroll") for (int k = 0; k < 2; ++k) dst[m][k] = *(const LAS h8*)(lds + PG8_SA(b, h) + aoff + m * 2048 + k * 1024); } while (0)
#define PG8_LDB(dst, b, h) do { _Pragma("unroll") for (int n = 0; n < 2; ++n) _Pragma("unroll") for (int k = 0; k < 2; ++k) dst[n][k] = *(const LAS h8*)(lds + PG8_SB(b, h) + boff + n * 2048 + k * 1024); } while (0)
#define PG8_MMA(ai, bj, At, Bt) do { __builtin_amdgcn_s_setprio(1); _Pragma("unroll") for (int m = 0; m < 4; ++m) _Pragma("unroll") for (int n = 0; n < 2; ++n) _Pragma("unroll") for (int k = 0; k < 2; ++k) \
        acc[ai][bj][m][n] = MFMA16(Bt[n][k], At[m][k], acc[ai][bj][m][n]); __builtin_amdgcn_s_setprio(0); } while (0)
#define PG8_WAIT_V(n) asm volatile("s_waitcnt vmcnt(" #n ")" ::: "memory")
#define PG8_WAIT_L(n) asm volatile("s_waitcnt lgkmcnt(" #n ")" ::: "memory")
#define PG8_BAR __builtin_amdgcn_s_barrier()
#define PG8_SCHED __builtin_amdgcn_sched_barrier(0)
    Unit cur, nxt; int ui = 0;
    if (!S.next(0, cur)) return;
    f32x4 acc[2][2][4][2];
#pragma unroll
    for (int a = 0; a < 2; ++a)
#pragma unroll
        for (int b = 0; b < 2; ++b)
#pragma unroll
            for (int m = 0; m < 4; ++m)
#pragma unroll
                for (int n = 0; n < 2; ++n) acc[a][b][m][n] = (f32x4){0.f, 0.f, 0.f, 0.f};
    h8 At[4][2], B0[2][2], B1[2][2];
    const char* cA = (const char*)g.A + (size_t)cur.pm * tstepA; const char* cB = (const char*)g.Bt + (size_t)cur.pn * tstepB;
    S.a_ready(cur);
    if constexpr (SP2) {
        PG8_STAGE(PG8_SB(0, 0), cB, voffB); PG8_STAGE(PG8_SB(0, 1), cB + hstepB, voffB); PG8_STAGE(PG8_SA(0, 0), cA, voffA); PG8_STAGE(PG8_SA(0, 1), cA + hstepA, voffA);
        if (wr == 1) PG8_BAR;
        PG8_WAIT_V(2); PG8_BAR;
        PG8_STAGE(PG8_SB(1, 0), cB + kstep, voffB); PG8_STAGE(PG8_SA(1, 0), cA + kstep, voffA); PG8_STAGE(PG8_SB(1, 1), cB + hstepB + kstep, voffB);
        PG8_WAIT_V(6); PG8_BAR;
    } else {
        PG8_STAGE(PG8_SB(0, 0), cB, voffB); PG8_STAGE(PG8_SA(0, 0), cA, voffA); PG8_STAGE(PG8_SB(0, 1), cB + hstepB, voffB); PG8_STAGE(PG8_SA(0, 1), cA + hstepA, voffA);
        if (wr == 1) PG8_BAR;
        PG8_WAIT_V(4); PG8_BAR;
        PG8_STAGE(PG8_SB(1, 0), cB + kstep, voffB); PG8_STAGE(PG8_SA(1, 0), cA + kstep, voffA); PG8_STAGE(PG8_SB(1, 1), cB + hstepB + kstep, voffB);
        PG8_WAIT_V(6); PG8_BAR;
    }
    for (;;) {
        const bool has_next = S.next(ui + 1, nxt);
        const char* nA = has_next ? (const char*)g.A + (size_t)nxt.pm * tstepA : cA; const char* nB = has_next ? (const char*)g.Bt + (size_t)nxt.pn * tstepB : cB;
        for (int t = 0; t < nt; t += 2) {
            const bool last = (t == nt - 2);
            const char* a1 = cA + (size_t)(t + 1) * kstep;
            const char* a2 = last ? nA : cA + (size_t)(t + 2) * kstep; const char* b2 = last ? nB : cB + (size_t)(t + 2) * kstep;
            const char* a3 = a2 + kstep; const char* b3 = b2 + kstep;
            if (last && has_next) S.a_ready(nxt);
            if constexpr (Epi::HAS_MID) { if (t == 16 || t == 32) E.mid(acc, cur, t, wr, wc, fr, fq); }
            if constexpr (SP2) {
            PG8_LDB(B0, 0, 0); PG8_LDB(B1, 0, 1); PG8_SCHED; PG8_LDA(At, 0, 0); PG8_STAGE(PG8_SA(1, 1), a1 + hstepA, voffA);
            PG8_WAIT_V(8); PG8_WAIT_L(0); PG8_BAR; PG8_MMA(0, 0, At, B0); PG8_MMA(0, 1, At, B1); PG8_BAR; PG8_SCHED;
            PG8_LDA(At, 0, 1); PG8_STAGE(PG8_SB(0, 0), b2, voffB); PG8_STAGE(PG8_SB(0, 1), b2 + hstepB, voffB); PG8_STAGE(PG8_SA(0, 0), a2, voffA);
            PG8_WAIT_V(8); PG8_WAIT_L(0); PG8_BAR; PG8_MMA(1, 0, At, B0); PG8_MMA(1, 1, At, B1); PG8_BAR; PG8_SCHED;
            PG8_LDB(B0, 1, 0); PG8_LDB(B1, 1, 1); PG8_SCHED; PG8_LDA(At, 1, 0); PG8_STAGE(PG8_SA(0, 1), a2 + hstepA, voffA);
            PG8_WAIT_V(8); PG8_WAIT_L(0); PG8_BAR; PG8_MMA(0, 0, At, B0); PG8_MMA(0, 1, At, B1); PG8_BAR; PG8_SCHED;
            PG8_LDA(At, 1, 1); PG8_STAGE(PG8_SB(1, 0), b3, voffB); PG8_STAGE(PG8_SB(1, 1), b3 + hstepB, voffB); PG8_STAGE(PG8_SA(1, 0), a3, voffA);
            PG8_WAIT_V(8); PG8_WAIT_L(0); PG8_BAR; PG8_MMA(1, 0, At, B0); PG8_MMA(1, 1, At, B1); PG8_BAR; PG8_SCHED;
            } else {
            PG8_LDB(B0, 0, 0); PG8_SCHED; PG8_LDA(At, 0, 0); PG8_STAGE(PG8_SA(1, 1), a1 + hstepA, voffA);
            PG8_WAIT_L(8); PG8_BAR; PG8_WAIT_L(0); PG8_MMA(0, 0, At, B0); PG8_BAR; PG8_SCHED;
            PG8_LDB(B1, 0, 1); PG8_STAGE(PG8_SB(0, 0), b2, voffB);
            PG8_BAR; PG8_WAIT_L(0); PG8_MMA(0, 1, At, B1); PG8_BAR;
            PG8_LDA(At, 0, 1); PG8_STAGE(PG8_SA(0, 0), a2, voffA);
            PG8_BAR; PG8_WAIT_L(0); PG8_MMA(1, 0, At, B0); PG8_BAR; PG8_SCHED;
            PG8_STAGE(PG8_SB(0, 1), b2 + hstepB, voffB);
            PG8_WAIT_V(6); PG8_BAR; PG8_MMA(1, 1, At, B1); PG8_BAR;
            PG8_LDB(B0, 1, 0); PG8_SCHED; PG8_LDA(At, 1, 0); PG8_STAGE(PG8_SA(0, 1), a2 + hstepA, voffA);
            PG8_WAIT_L(8); PG8_BAR; PG8_WAIT_L(0); PG8_MMA(0, 0, At, B0); PG8_BAR; PG8_SCHED;
            PG8_LDB(B1, 1, 1); PG8_STAGE(PG8_SB(1, 0), b3, voffB);
            PG8_BAR; PG8_WAIT_L(0); PG8_MMA(0, 1, At, B1); PG8_BAR;
            PG8_LDA(At, 1, 1); PG8_STAGE(PG8_SA(1, 0), a3, voffA);
            PG8_BAR; PG8_WAIT_L(0); PG8_MMA(1, 0, At, B0); PG8_BAR; PG8_SCHED;
            PG8_STAGE(PG8_SB(1, 1), b3 + hstepB, voffB);
            PG8_WAIT_V(6); PG8_BAR; PG8_MMA(1, 1, At, B1); PG8_BAR;
            }
        }
        if constexpr (ALIGN_EPI) { if (wr == 0) PG8_BAR; }
        E(acc, cur, wr, wc, fr, fq); S.done(cur);
        if (!has_next) break;
#pragma unroll
        for (int a = 0; a < 2; ++a)
#pragma unroll
            for (int b = 0; b < 2; ++b)
#pragma unroll
                for (int m = 0; m < 4; ++m)
#pragma unroll
                    for (int n = 0; n < 2; ++n) acc[a][b][m][n] = (f32x4){0.f, 0.f, 0.f, 0.f};
        cur = nxt; cA = nA; cB = nB; ++ui;
        if constexpr (ALIGN_EPI) { if (wr == 1) PG8_BAR; }
    }
    PG8_WAIT_V(0);
    if constexpr (!ALIGN_EPI) { if (wr == 0) PG8_BAR; }
    PG8_BAR;
#undef PG8_SA
#undef PG8_SB
#undef PG8_STAGE
#undef PG8_LDA
#undef PG8_LDB
#undef PG8_MMA
#undef PG8_WAIT_V
#undef PG8_WAIT_L
#undef PG8_BAR
#undef PG8_SCHED
}
}
using pg8::fx_t; using pg8::fx2f; using pg8::f2fx;

constexpr int NWAVES = 8, NTHREADS = 512;
constexpr int LDS_BYTES = 155648;
struct Args { const float* in[18]; float* out; unsigned char* ws; int ph_lo, ph_hi; };

struct Ctx {
    LAS unsigned char* lds; int tid, lane, wave, gw, NGW, G;
    float* out; unsigned char* ws;
    __device__ __forceinline__ e16_t* w16(size_t off) const { return (e16_t*)(ws + off); }
    __device__ __forceinline__ e16_t* wl(int l, size_t off) const { return (e16_t*)(ws + WS_W + (size_t)l * WL_SIZE + off); }
};

#define LDS_WAIT() asm volatile("s_waitcnt lgkmcnt(0)" ::: "memory")
__device__ __forceinline__ int map_win(int n) {
    if (n < 2048) return n;
    if (n < 3072) return 10240 + (n - 2048);
    if (n < 4096) return 2048 + (n - 3072);
    if (n < 5120) return 11264 + (n - 4096);
    if (n < 6144) return 3072 + (n - 5120);
    if (n < 8192) { const int c = n - 6144; return 4096 + (c >> 7) * 256 + (c & 127); }
    if (n < 10240) { const int c = n - 8192; return 4096 + (c >> 7) * 256 + 128 + (c & 127); }
    return n - 2048;
}
__device__ __forceinline__ int map_gu(int n) { return n < DFF ? 256 * (n >> 7) + (n & 127) : 256 * ((n - DFF) >> 7) + 128 + ((n - DFF) & 127); }
struct TD { const float* W; const float* g; e16_t* WT; int K, N, ldo, koff, map; };
__device__ __forceinline__ TD weight_td(const Args& a, const Ctx& C, int id) {
    const int l = id >> 3, m = id & 7; TD t; t.g = nullptr; t.koff = 0; t.map = 0;
    if (m == 0) { t.W = a.in[3] + (size_t)l * D_ * WINC; t.g = a.in[2] + l * D_; t.WT = C.wl(l, WL_IN); t.K = D_; t.N = WINC; t.ldo = D_; t.map = 1; }
    else if (m <= 3) { t.W = a.in[13] + (size_t)(l * 3 + m - 1) * 1024 * D_; t.WT = C.wl(l, WL_B); t.K = 1024; t.N = D_; t.ldo = 3072; t.koff = (m - 1) * 1024; }
    else if (m == 4) { t.W = a.in[14] + (size_t)l * D_ * D_; t.WT = C.wl(l, WL_O); t.K = D_; t.N = D_; t.ldo = D_; }
    else if (m == 5) { t.W = a.in[16] + (size_t)l * D_ * 2 * DFF; t.g = a.in[15] + l * D_; t.WT = C.wl(l, WL_GU); t.K = D_; t.N = 2 * DFF; t.ldo = D_; t.map = 2; }
    else if (m == 6) { t.W = a.in[17] + (size_t)l * DFF * D_; t.WT = C.wl(l, WL_D); t.K = DFF; t.N = D_; t.ldo = DFF; }
    else { t.W = a.in[12] + (size_t)l * D_ * D_; t.WT = C.wl(l, WL_M); t.K = D_; t.N = D_; t.ldo = D_; }
    return t;
}
__device__ __forceinline__ bool job_decode(int job, int i, int& id, int& it) {
    if (job == 0) { if (i < 12288) { id = 0; it = i; } else if (i < 14336) { id = 7; it = i - 12288; } else if (i < 16384) { id = 15; it = i - 14336; } else if (i < 19456) { id = 5; it = i - 16384 + 8192; }
                    else if (i < 22528) { id = 13; it = i - 19456 + 8192; } else return false; }
    else if (job == 4) { if (i < 8192) { id = 5; it = i; } else if (i < 12288) { id = 8; it = i; } else if (i < 20480) { id = 13; it = i - 12288; } else return false; }
    else if (job == 1) { if (i < 3072) { id = 1 + (i >> 10); it = i & 1023; } else if (i < 5120) { id = 4; it = i - 3072; } else if (i < 10752) { id = 6; it = i - 5120; }
                         else if (i < 13824) { id = 9 + ((i - 10752) >> 10); it = (i - 10752) & 1023; } else if (i < 15872) { id = 12; it = i - 13824; } else return false; }
    else if (job == 2) { if (i >= 8192) return false; id = 8; it = i; }
    else { if (i >= 5632) return false; id = 14; it = i; }
    return true;
}
__device__ __forceinline__ void convert_job(const Args& a, const Ctx& C, int job, int slot, int stride, int k_lo, int k_hi, LAS float* scr) {
    const int lane = C.lane, c = lane & 7;
    int k = k_lo, id, it;
    if (k >= k_hi || !job_decode(job, slot + k * stride, id, it)) return;
    TD t = weight_td(a, C, id); int nblk = t.N / 32;
    float r[32];
    { const int k0 = (it / nblk) * 64, n0 = (it % nblk) * 32;
#pragma unroll
      for (int i = 0; i < 32; ++i) r[i] = t.W[(size_t)(k0 + 2 * i + (lane >> 5)) * t.N + n0 + (lane & 31)]; }
#pragma unroll 1
    for (;;) {
        const int k0 = (it / nblk) * 64, n0 = (it % nblk) * 32; const int drow0 = t.map == 1 ? map_win(n0) : (t.map == 2 ? map_gu(n0) : n0);
        f32x4 ga = {1.f, 1.f, 1.f, 1.f}, gb = ga;
        if (t.g) { ga = *(const f32x4*)(t.g + k0 + 8 * c); gb = *(const f32x4*)(t.g + k0 + 8 * c + 4); }
        e16_t* wt = t.WT; const int ldo = t.ldo, koff = t.koff;
#pragma unroll
        for (int i = 0; i < 32; ++i) scr[(2 * i + (lane >> 5)) * 33 + (lane & 31)] = r[i];
        ++k; int id2, it2; const bool more = (k < k_hi) && job_decode(job, slot + k * stride, id2, it2);
        if (more) { t = weight_td(a, C, id2); nblk = t.N / 32; it = it2; const int k1 = (it / nblk) * 64, n1 = (it % nblk) * 32;
#pragma unroll
            for (int i = 0; i < 32; ++i) r[i] = t.W[(size_t)(k1 + 2 * i + (lane >> 5)) * t.N + n1 + (lane & 31)]; }
        LDS_WAIT(); asm volatile("" ::: "memory");
#pragma unroll
        for (int j = 0; j < 4; ++j) { const int n = (lane >> 3) + 8 * j; const LAS float* sp = scr + (8 * c) * 33 + n;
            u32x4 o; o.x = cvt_pk(sp[0 * 33] * ga[0], sp[1 * 33] * ga[1]); o.y = cvt_pk(sp[2 * 33] * ga[2], sp[3 * 33] * ga[3]); o.z = cvt_pk(sp[4 * 33] * gb[0], sp[5 * 33] * gb[1]); o.w = cvt_pk(sp[6 * 33] * gb[2], sp[7 * 33] * gb[3]);
            *(u32x4*)(wt + (size_t)(drow0 + n) * ldo + koff + k0 + 8 * c) = o; }
        LDS_WAIT(); asm volatile("" ::: "memory");
        if (!more) break;
    }
}
__device__ __forceinline__ void rms_rows(const Ctx& C, const float* X, const float* g, e16_t* O, int rows) {
    for (int m = C.gw; m < rows; m += C.NGW) {
        const f32x4* xr = (const f32x4*)(X + (size_t)m * D_) + C.lane; f32x4 v[8]; float s = 0.f;
#pragma unroll
        for (int j = 0; j < 8; ++j) { v[j] = xr[64 * j]; s += (v[j].x * v[j].x + v[j].y * v[j].y) + (v[j].z * v[j].z + v[j].w * v[j].w); }
        const float rstd = rsqrtf(wave_sum(s) * (1.f / D_) + EPS);
        const f32x4* gr = (const f32x4*)g + C.lane; u32x2* o8 = (u32x2*)(O + (size_t)m * D_) + C.lane;
#pragma unroll
        for (int j = 0; j < 8; ++j) { const f32x4 gg = gr[64 * j]; u32x2 w; w.x = cvt_pk(v[j].x * rstd * gg.x, v[j].y * rstd * gg.y); w.y = cvt_pk(v[j].z * rstd * gg.z, v[j].w * rstd * gg.w); o8[64 * j] = w; }
    }
}

__device__ __forceinline__ void xb_rows(const Ctx& C, const float* X, e16_t* O, fx_t* rss, int rows) {
    for (int m = C.gw; m < rows; m += C.NGW) {
        const f32x4* xr = (const f32x4*)(X + (size_t)m * D_) + C.lane; u32x2* o8 = (u32x2*)(O + (size_t)m * D_) + C.lane; f32x4 v[8]; float s = 0.f;
#pragma unroll
        for (int j = 0; j < 8; ++j) { v[j] = xr[64 * j]; s += (v[j].x * v[j].x + v[j].y * v[j].y) + (v[j].z * v[j].z + v[j].w * v[j].w); }
#pragma unroll
        for (int j = 0; j < 8; ++j) { u32x2 w; w.x = cvt_pk(v[j].x, v[j].y); w.y = cvt_pk(v[j].z, v[j].w); o8[64 * j] = w; }
        s = wave_sum(s); if (C.lane == 0) rss[m] = f2fx(s);
    }
}
__device__ __forceinline__ void kmnorm_phase(const Ctx& C, const float* gkm) {
    for (int it = C.gw; it < NLAYER * NMEM * HM; it += C.NGW) { const int l = it >> 10, m = (it >> 2) & 255, hm = it & 3;
        e16_t* p = C.w16(WS_KM) + (size_t)l * NMEM * 1024 + (size_t)m * 1024 + hm * DMH + 4 * C.lane; const h4 raw = *(const h4*)p;
        float v[4]; float ss = 0.f;
#pragma unroll
        for (int i = 0; i < 4; ++i) { v[i] = up16(raw[i]); ss += v[i] * v[i]; }
        const float rstd = rsqrtf(wave_sum(ss) * (1.f / DMH) + EPS); const float* g = gkm + l * DMH + 4 * C.lane;
        u32x2 w; w.x = cvt_pk(v[0] * rstd * g[0], v[1] * rstd * g[1]); w.y = cvt_pk(v[2] * rstd * g[2], v[3] * rstd * g[3]); *(u32x2*)p = w; }
}
__device__ __forceinline__ void gating_phase(const Ctx& C, int l, const float* gq, const float* gk) {
    const e16_t* Z = C.w16(WS_Z); const float* KMEAN = (const float*)(C.ws + WS_KMEAN); unsigned* LIST = (unsigned*)(C.ws + WS_LIST); unsigned* SEL = (unsigned*)(C.ws + WS_SEL);
    unsigned* CNT = (unsigned*)(C.ws + WS_CTL) + CW_CNT + l * 256;
    LAS float* km = (LAS float*)C.lds;
    LAS unsigned* lcnt = (LAS unsigned*)(C.lds + 16384); LAS unsigned* lbase = lcnt + 32;
    for (int it = blockIdx.x; it < HA * NBLK; it += C.G) { const int h = it >> 5, b = it & 31;
        for (int i = C.tid; i < NBLK * DA; i += NTHREADS) km[i] = KMEAN[(size_t)h * NBLK * DA + i];
        if (C.tid < 32) lcnt[C.tid] = 0u;
        if (C.tid < 64) { float a = fmaxf(fabsf(gq[C.tid]), fabsf(gq[C.tid + 64])), bb = fmaxf(fabsf(gk[C.tid]), fabsf(gk[C.tid + 64]));
#pragma unroll
            for (int o = 1; o < 64; o <<= 1) { a = fmaxf(a, __shfl_xor(a, o)); bb = fmaxf(bb, __shfl_xor(bb, o)); }
            if (C.tid == 0) ((LAS float*)lcnt)[96] = 2.f * (16.3222f * 1.02f * a * bb) + 150.f; }
        __syncthreads();
        const float thr = ((LAS float*)lcnt)[96], slope2 = __builtin_amdgcn_exp2f(-(float)(h + 1)) * LOG2E;
        const int q = b * 256 + (C.tid >> 1), half = C.tid & 1; const int nsel = b < 3 ? b : 3;
        int i0 = 0, i1 = 1, i2 = 2;
        if (b > 3) {
            float qv[64]; float ss = 0.f; const e16_t* zr = Z + (size_t)q * ZP + ZQ + h * DA + half * 64;
#pragma unroll
            for (int c8 = 0; c8 < 8; ++c8) { const h8 r = *(const h8*)(zr + 8 * c8);
#pragma unroll
                for (int j = 0; j < 8; ++j) { const float f = up16(r[j]); qv[c8 * 8 + j] = f; ss += f * f; } }
            ss += __shfl_xor(ss, 1);
            const float rstd = rsqrtf(ss * (1.f / DA) + EPS);
#pragma unroll
            for (int d = 0; d < 64; ++d) qv[d] = qv[d] * rstd * gq[half * 64 + d];
            float v0 = -__builtin_inff(), v1 = v0, v2 = v0;
            for (int j = 0; j < b; ++j) { const LAS f32x4* kr = (const LAS f32x4*)(km + j * DA + half * 64); float g0 = 0.f, g1 = 0.f;
#pragma unroll
                for (int d4 = 0; d4 < 16; d4 += 2) { const f32x4 ka = kr[d4], kb = kr[d4 + 1];
                    g0 += (qv[4 * d4] * ka.x + qv[4 * d4 + 1] * ka.y) + (qv[4 * d4 + 2] * ka.z + qv[4 * d4 + 3] * ka.w);
                    g1 += (qv[4 * d4 + 4] * kb.x + qv[4 * d4 + 5] * kb.y) + (qv[4 * d4 + 6] * kb.z + qv[4 * d4 + 7] * kb.w); }
                float gt = g0 + g1; gt += __shfl_xor(gt, 1);
                if (gt > v0) { v2 = v1; i2 = i1; v1 = v0; i1 = i0; v0 = gt; i0 = j; }
                else if (gt > v1) { v2 = v1; i2 = i1; v1 = gt; i1 = j; }
                else if (gt > v2) { v2 = gt; i2 = j; } }
        }
        const bool u0 = nsel > 0 && !(slope2 * (float)(256 * (b - i0 - 1) + 1) > thr), u1 = nsel > 1 && !(slope2 * (float)(256 * (b - i1 - 1) + 1) > thr), u2 = nsel > 2 && !(slope2 * (float)(256 * (b - i2 - 1) + 1) > thr);
        unsigned p0 = 0u, p1 = 0u, p2 = 0u;
        if (half == 0) { if (u0) p0 = atomicAdd((unsigned*)&lcnt[i0], 1u); if (u1) p1 = atomicAdd((unsigned*)&lcnt[i1], 1u); if (u2) p2 = atomicAdd((unsigned*)&lcnt[i2], 1u);
            SEL[(size_t)h * S_ + q] = (u0 ? 0u : 1u) | (u1 ? 0u : 2u) | (u2 ? 0u : 4u); }
        __syncthreads();
        if (C.tid < 32) { const unsigned n = lcnt[C.tid]; lbase[C.tid] = n ? atomicAdd(&CNT[h * 32 + C.tid], n) : 0u; }
        __syncthreads();
        if (half == 0) { unsigned* L = LIST + (size_t)h * 32 * 8192;
            if (u0) L[(size_t)i0 * 8192 + lbase[i0] + p0] = (unsigned)q;
            if (u1) L[(size_t)i1 * 8192 + lbase[i1] + p1] = (unsigned)q | (1u << 16);
            if (u2) L[(size_t)i2 * 8192 + lbase[i2] + p2] = (unsigned)q | (2u << 16); }
        __syncthreads();
    }
}

__device__ __forceinline__ void softmax_step(f32x16& p, float& m, float& l, f32x16 (&acc)[4], h8& pb0, h8& pb1) {
    float mx = p[0];
#pragma unroll
    for (int r = 1; r < 16; ++r) mx = fmaxf(mx, p[r]);
    mx = fmaxf(mx, __shfl_xor(mx, 32));
    if (__any(mx > m)) {
        const float mn = fmaxf(m, mx); const float alpha = __builtin_amdgcn_exp2f(m - mn); m = mn; l *= alpha;
#pragma unroll
        for (int db = 0; db < 4; ++db)
#pragma unroll
            for (int r = 0; r < 16; ++r) acc[db][r] *= alpha; }
    float ps = 0.f;
#pragma unroll
    for (int r = 0; r < 16; ++r) { p[r] = __builtin_amdgcn_exp2f(p[r] - m); ps += p[r]; }
    l += ps;
    float t[8];
#pragma unroll
    for (int r = 0; r < 8; ++r) t[r] = p[r];
    pb0 = pack8(t);
#pragma unroll
    for (int r = 0; r < 8; ++r) t[r] = p[8 + r];
    pb1 = pack8(t);
}
__device__ __forceinline__ void pv_step(f32x16 (&acc)[4], const e16_t* vt, int vp, int hi, h8 pb0, h8 pb1) {
#pragma unroll
    for (int db = 0; db < 4; ++db) { const e16_t* vr = vt + (size_t)db * 32 * vp + 4 * hi;
        { const h4 lo = *(const h4*)(vr), hh = *(const h4*)(vr + 8); const h8 a = {lo[0], lo[1], lo[2], lo[3], hh[0], hh[1], hh[2], hh[3]}; acc[db] = MFMA32(a, pb0, acc[db]); }
        { const h4 lo = *(const h4*)(vr + 16), hh = *(const h4*)(vr + 24); const h8 a = {lo[0], lo[1], lo[2], lo[3], hh[0], hh[1], hh[2], hh[3]}; acc[db] = MFMA32(a, pb1, acc[db]); } }
}
__device__ __forceinline__ float store_o(const f32x16 (&acc)[4], float l, e16_t* yrow, int hi, bool valid = true) {
    l += __shfl_xor(l, 32); const float inv = 1.0f / l; if (!valid) return l;
#pragma unroll
    for (int db = 0; db < 4; ++db)
#pragma unroll
        for (int g = 0; g < 4; ++g) { u32x2 w; w.x = cvt_pk(acc[db][4 * g] * inv, acc[db][4 * g + 1] * inv); w.y = cvt_pk(acc[db][4 * g + 2] * inv, acc[db][4 * g + 3] * inv);
            *(u32x2*)(yrow + db * 32 + g * 8 + hi * 4) = w; }
    return l;
}

constexpr int LV_OFF = 65536, LV_PITCH = 520;
constexpr int LDS_CTL = 135168;
static_assert(LV_OFF + 128 * LV_PITCH <= LDS_CTL, "LDS map");
static_assert(256 * LV_PITCH <= LDS_CTL, "LDS map (memory attention V^T image)");

__device__ __forceinline__ void moba_wg(const Ctx& C, const float* gqa, int h, int j, int t, int ntile, int slot, bool valid, unsigned* q, int& knx) {
    int tid = C.tid; asm volatile("" : "+v"(tid));
    const int c = tid & 31, hi = (tid >> 5) & 1;
    const e16_t* Z = C.w16(WS_Z); const e16_t* ZT = C.w16(WS_ZT);
    LAS unsigned char* LK = C.lds; LAS unsigned char* LV = C.lds + LV_OFF;
    const float slope2 = __builtin_amdgcn_exp2f(-(float)(h + 1)) * LOG2E;
    h8 qf[8];
    { const e16_t* kg = Z + (size_t)(j * 256) * ZP + ZK + h * DA; const e16_t* vg = ZT + (size_t)(h * DA) * ZTP + j * 256;
      const e16_t* zq = Z + (size_t)t * ZP + ZQ + h * DA + hi * 8; h8 raw[8], kr[8], vr[8];
#pragma unroll
      for (int i = 0; i < 8; ++i) { const int row = i * 32 + (tid >> 4), ch = tid & 15; kr[i] = *(const h8*)(kg + (size_t)row * ZP + ch * 8); }
#pragma unroll
      for (int i = 0; i < 8; ++i) { const int idx = i * 512 + tid, d = idx >> 5, cc = idx & 31; vr[i] = *(const h8*)(vg + (size_t)d * ZTP + cc * 8); }
#pragma unroll
      for (int ks = 0; ks < 8; ++ks) raw[ks] = *(const h8*)(zq + ks * 16);
      float ss = 0.f;
#pragma unroll
      for (int ks = 0; ks < 8; ++ks)
#pragma unroll
          for (int jj = 0; jj < 8; ++jj) { const float f = up16(raw[ks][jj]); ss += f * f; }
      ss += __shfl_xor(ss, 32);
      const float sc = rsqrtf(ss * (1.f / DA) + EPS) * 0.08838834764831845f * LOG2E; const float* gq = gqa + hi * 8;
#pragma unroll
      for (int ks = 0; ks < 8; ++ks) { const f32x4 g0 = *(const f32x4*)(gq + ks * 16), g1 = *(const f32x4*)(gq + ks * 16 + 4); float f[8];
#pragma unroll
          for (int jj = 0; jj < 4; ++jj) { f[jj] = up16(raw[ks][jj]) * sc * g0[jj]; f[4 + jj] = up16(raw[ks][4 + jj]) * sc * g1[jj]; }
          qf[ks] = pack8(f); }
#pragma unroll
      for (int i = 0; i < 8; ++i) { const int row = i * 32 + (tid >> 4), ch = tid & 15; *(LAS h8*)(LK + row * 256 + ((ch ^ (row & 15)) << 4)) = kr[i]; }
#pragma unroll
      for (int i = 0; i < 8; ++i) { const int idx = i * 512 + tid, d = idx >> 5, cc = idx & 31; LAS h4* p = (LAS h4*)(LV + d * LV_PITCH + cc * 16);
          p[0] = (h4){vr[i][0], vr[i][1], vr[i][2], vr[i][3]}; p[1] = (h4){vr[i][4], vr[i][5], vr[i][6], vr[i][7]}; } }
    __syncthreads();
    if (tid == 0) knx = (int)atomicAdd(q, 1u);
    float m = -1e30f, lsum = 0.f; f32x16 acc[4];
#pragma unroll
    for (int db = 0; db < 4; ++db)
#pragma unroll
        for (int r = 0; r < 16; ++r) acc[db][r] = 0.f;
    const float NEG = -__builtin_inff();
    float sc[16];
#pragma unroll
    for (int r = 0; r < 16; ++r) sc[r] = slope2 * (float)crow(r, hi);
    for (int kt = 0; kt < ntile; ++kt) { const int kb = j * 256 + kt * 32;
        f32x16 p; const float base = slope2 * (float)(kb - t);
#pragma unroll
        for (int r = 0; r < 16; ++r) p[r] = sc[r] + base;
        const LAS unsigned char* kp = LK + (kt * 32 + c) * 256;
        h8 ka[8];
#pragma unroll
        for (int ks = 0; ks < 8; ++ks) ka[ks] = *(const LAS h8*)(kp + (((2 * ks + hi) ^ (c & 15)) << 4));
        u32x2 va[16];
#pragma unroll
        for (int db = 0; db < 4; ++db) { const LAS unsigned char* vp = LV + (db * 32 + c) * LV_PITCH + (kt * 32 + 4 * hi) * 2;
#pragma unroll
            for (int e = 0; e < 4; ++e) va[db * 4 + e] = *(const LAS u32x2*)(vp + 16 * e); }
        __builtin_amdgcn_sched_barrier(0);
#pragma unroll
        for (int ks = 0; ks < 8; ++ks) p = MFMA32(ka[ks], qf[ks], p);
        if (slot == 3 && kt == ntile - 1) {
#pragma unroll
            for (int r = 0; r < 16; ++r) { const int kpos = kb + crow(r, hi); p[r] = (kpos <= t) ? p[r] : NEG; } }
        h8 pb0, pb1; softmax_step(p, m, lsum, acc, pb0, pb1);
#pragma unroll
        for (int db = 0; db < 4; ++db) { const u32x4 a0 = {va[db * 4][0], va[db * 4][1], va[db * 4 + 1][0], va[db * 4 + 1][1]}, a1 = {va[db * 4 + 2][0], va[db * 4 + 2][1], va[db * 4 + 3][0], va[db * 4 + 3][1]};
            acc[db] = MFMA32(a0, pb0, acc[db]); acc[db] = MFMA32(a1, pb1, acc[db]); } }
    __syncthreads();
    if (ntile > 0) { e16_t* PART = C.w16(WS_PART); f32x2* ML = (f32x2*)(C.ws + WS_ML);
        const float lt = store_o(acc, lsum, PART + ((size_t)slot * S_ + t) * 1024 + h * DA, hi, valid);
        if (valid && hi == 0) ML[(size_t)(slot * HA + h) * S_ + t] = (f32x2){m, lt}; }
}
__device__ __forceinline__ void mem_wg(const Ctx& C, int l, const float* gqm, const float* gkm, int hm, int qb, unsigned* q, int& knx) {
    int tid = C.tid; asm volatile("" : "+v"(tid));
    const int c = tid & 31, hi = (tid >> 5) & 1, t = qb * 256 + C.wave * 32 + c;
    const e16_t* Z = C.w16(WS_Z); e16_t* Y = C.w16(WS_Y);
    const e16_t* KM = C.w16(WS_KM) + (size_t)l * NMEM * 1024 + hm * DMH; const e16_t* VMT = C.w16(WS_VMT) + (size_t)l * 1024 * NMEM + (size_t)(hm * DMH) * NMEM;
    LAS unsigned char* LK = C.lds;
    h8 qf[16]; float sbound;
    { h8 kr[16], raw[16]; const e16_t* zq = Z + (size_t)t * ZP + ZQM + hm * DMH + hi * 8;
#pragma unroll
      for (int i = 0; i < 16; ++i) { const int row = i * 16 + (tid >> 5), ch = tid & 31; kr[i] = *(const h8*)(KM + (size_t)row * 1024 + ch * 8); }
#pragma unroll
      for (int ks = 0; ks < 16; ++ks) raw[ks] = *(const h8*)(zq + ks * 16);
      const f32x4 gqv = *(const f32x4*)(gqm + 4 * (tid & 63)), gkv = *(const f32x4*)(gkm + 4 * (tid & 63));
#pragma unroll
      for (int i = 0; i < 16; ++i) { const int row = i * 16 + (tid >> 5), ch = tid & 31; *(LAS h8*)(LK + row * 512 + ((ch ^ (row & 15)) << 4)) = kr[i]; }
      float ss = 0.f;
#pragma unroll
      for (int ks = 0; ks < 16; ++ks)
#pragma unroll
          for (int j = 0; j < 8; ++j) { const float f = up16(raw[ks][j]); ss += f * f; }
      ss += __shfl_xor(ss, 32);
      { float a = fmaxf(fmaxf(fabsf(gqv.x), fabsf(gqv.y)), fmaxf(fabsf(gqv.z), fabsf(gqv.w))), b = fmaxf(fmaxf(fabsf(gkv.x), fabsf(gkv.y)), fmaxf(fabsf(gkv.z), fabsf(gkv.w)));
#pragma unroll
        for (int o = 1; o < 64; o <<= 1) { a = fmaxf(a, __shfl_xor(a, o)); b = fmaxf(b, __shfl_xor(b, o)); }
        sbound = 23.083f * 1.02f * a * b; }
#pragma unroll
      for (int ks = 0; ks < 16; ++ks) asm volatile("" : "+v"(raw[ks]));
      const float sc = rsqrtf(ss * (1.f / DMH) + EPS) * 0.0625f * LOG2E; const float* gq = gqm + hi * 8;
#pragma unroll
      for (int ks = 0; ks < 16; ++ks) { const f32x4 g0 = *(const f32x4*)(gq + ks * 16), g1 = *(const f32x4*)(gq + ks * 16 + 4); float f[8];
#pragma unroll
          for (int j = 0; j < 4; ++j) { f[j] = up16(raw[ks][j]) * sc * g0[j]; f[4 + j] = up16(raw[ks][4 + j]) * sc * g1[j]; }
          qf[ks] = pack8(f); } }
    __syncthreads();
    if (tid == 0) knx = (int)atomicAdd(q, 1u);
    h8 pb[8][2]; float lsum = 0.f;
    { float mx = -1e30f;
      const bool need_max = __builtin_amdgcn_readfirstlane(sbound > 90.f ? 1 : 0) != 0;
      if (!need_max) mx = 0.f;
#pragma unroll 1
      for (int kt = 0; kt < (need_max ? 8 : 0); ++kt) { f32x16 p;
#pragma unroll
          for (int r = 0; r < 16; ++r) p[r] = 0.f;
          const LAS unsigned char* kp = LK + (kt * 32 + c) * 512;
#pragma unroll
          for (int k8 = 0; k8 < 16; k8 += 8) { h8 ka[8];
#pragma unroll
              for (int ks = 0; ks < 8; ++ks) ka[ks] = *(const LAS h8*)(kp + (((2 * (k8 + ks) + hi) ^ (c & 15)) << 4));
              __builtin_amdgcn_sched_barrier(0);
#pragma unroll
              for (int ks = 0; ks < 8; ++ks) p = MFMA32(ka[ks], qf[k8 + ks], p); }
#pragma unroll
          for (int r = 0; r < 16; ++r) mx = fmaxf(mx, p[r]); }
      mx = fmaxf(mx, __shfl_xor(mx, 32));
#pragma unroll
      for (int kt = 0; kt < 8; ++kt) { f32x16 p; float tv[8];
#pragma unroll
          for (int r = 0; r < 16; ++r) p[r] = 0.f;
          const LAS unsigned char* kp = LK + (kt * 32 + c) * 512;
#pragma unroll
          for (int k8 = 0; k8 < 16; k8 += 8) { h8 ka[8];
#pragma unroll
              for (int ks = 0; ks < 8; ++ks) ka[ks] = *(const LAS h8*)(kp + (((2 * (k8 + ks) + hi) ^ (c & 15)) << 4));
              __builtin_amdgcn_sched_barrier(0);
#pragma unroll
              for (int ks = 0; ks < 8; ++ks) p = MFMA32(ka[ks], qf[k8 + ks], p); }
#pragma unroll
          for (int r = 0; r < 16; ++r) { p[r] = __builtin_amdgcn_exp2f(p[r] - mx); lsum += p[r]; }
#pragma unroll
          for (int r = 0; r < 8; ++r) tv[r] = p[r];
          pb[kt][0] = pack8(tv);
#pragma unroll
          for (int r = 0; r < 8; ++r) tv[r] = p[8 + r];
          pb[kt][1] = pack8(tv); } }
    lsum += __shfl_xor(lsum, 32);
    const float inv = 1.0f / lsum;
    __syncthreads();
    LAS unsigned char* LV = C.lds;
    { h8 vr[16];
#pragma unroll
      for (int i = 0; i < 16; ++i) { const int idx = i * 512 + tid, d = idx >> 5, cc = idx & 31; vr[i] = *(const h8*)(VMT + (size_t)d * NMEM + cc * 8); }
#pragma unroll
      for (int i = 0; i < 16; ++i) { const int idx = i * 512 + tid, d = idx >> 5, cc = idx & 31; LAS h4* pp = (LAS h4*)(LV + d * LV_PITCH + cc * 16);
          pp[0] = (h4){vr[i][0], vr[i][1], vr[i][2], vr[i][3]}; pp[1] = (h4){vr[i][4], vr[i][5], vr[i][6], vr[i][7]}; }
      asm volatile("" ::: "memory"); }
    __syncthreads();
    e16_t* yrow = Y + (size_t)t * YP + 2048 + hm * DMH;
#pragma unroll 1
    for (int dh = 0; dh < 2; ++dh) { f32x16 acc[4];
#pragma unroll
        for (int db = 0; db < 4; ++db)
#pragma unroll
            for (int r = 0; r < 16; ++r) acc[db][r] = 0.f;
#pragma unroll
        for (int kt = 0; kt < 8; ++kt) { u32x2 va[16];
#pragma unroll
            for (int db = 0; db < 4; ++db) { const LAS unsigned char* vp = LV + ((dh * 4 + db) * 32 + c) * LV_PITCH + (kt * 32 + 4 * hi) * 2;
#pragma unroll
                for (int e = 0; e < 4; ++e) va[db * 4 + e] = *(const LAS u32x2*)(vp + 16 * e); }
            __builtin_amdgcn_sched_barrier(0);
#pragma unroll
            for (int db = 0; db < 4; ++db) { const u32x4 a0 = {va[db * 4][0], va[db * 4][1], va[db * 4 + 1][0], va[db * 4 + 1][1]}, a1 = {va[db * 4 + 2][0], va[db * 4 + 2][1], va[db * 4 + 3][0], va[db * 4 + 3][1]};
                acc[db] = MFMA32(a0, pb[kt][0], acc[db]); acc[db] = MFMA32(a1, pb[kt][1], acc[db]); } }
#pragma unroll
        for (int db = 0; db < 4; ++db)
#pragma unroll
            for (int g = 0; g < 4; ++g) { u32x2 w; w.x = cvt_pk(acc[db][4 * g] * inv, acc[db][4 * g + 1] * inv); w.y = cvt_pk(acc[db][4 * g + 2] * inv, acc[db][4 * g + 3] * inv);
                *(u32x2*)(yrow + dh * 128 + db * 32 + g * 8 + hi * 4) = w; } }
    __syncthreads();
}
__device__ __forceinline__ void attn_combine_phase(const Ctx& C) {
    const e16_t* PART = C.w16(WS_PART); const f32x2* ML = (const f32x2*)(C.ws + WS_ML); e16_t* Y = C.w16(WS_Y);
    const int hh = C.lane >> 3, d0 = hh * DA + 16 * (C.lane & 7);
    const unsigned* SEL = (const unsigned*)(C.ws + WS_SEL);
    for (int tb = C.gw; tb < S_; tb += 2 * C.NGW) {
        int tt[2]; unsigned on[2]; f32x2 ml[2][4]; h8 pa[2][4], pb[2][4];
#pragma unroll
        for (int r = 0; r < 2; ++r) { tt[r] = (tb + r * C.NGW < S_) ? tb + r * C.NGW : tb; const int np = (tt[r] >> 8) < 3 ? (tt[r] >> 8) : 3; const unsigned skip = SEL[(size_t)hh * S_ + tt[r]];
            on[r] = 8u | (((1u << np) - 1u) & ~skip); }
#pragma unroll
        for (int r = 0; r < 2; ++r)
#pragma unroll
            for (int sl = 0; sl < 4; ++sl) { const int se = ((on[r] >> sl) & 1u) ? sl : 3; ml[r][sl] = ML[(size_t)(se * HA + hh) * S_ + tt[r]];
                const e16_t* pr = PART + ((size_t)se * S_ + tt[r]) * 1024 + d0; pa[r][sl] = *(const h8*)pr; pb[r][sl] = *(const h8*)(pr + 8); }
#pragma unroll
        for (int r = 0; r < 2; ++r) { float M = -1e30f;
#pragma unroll
            for (int sl = 0; sl < 4; ++sl) if ((on[r] >> sl) & 1u) M = fmaxf(M, ml[r][sl].x);
            float w[4], W = 0.f;
#pragma unroll
            for (int sl = 0; sl < 4; ++sl) { w[sl] = ((on[r] >> sl) & 1u) ? ml[r][sl].y * __builtin_amdgcn_exp2f(ml[r][sl].x - M) : 0.f; W += w[sl]; }
            const float iw = 1.0f / W; float o[16];
#pragma unroll
            for (int i = 0; i < 16; ++i) o[i] = 0.f;
#pragma unroll
            for (int sl = 0; sl < 4; ++sl) { const float ws = w[sl] * iw;
#pragma unroll
                for (int i = 0; i < 8; ++i) { o[i] += ws * up16(pa[r][sl][i]); o[8 + i] += ws * up16(pb[r][sl][i]); } }
            if (r == 0 || tb + C.NGW < S_) { *(h8*)(Y + (size_t)tt[r] * YP + d0) = pack8(o); *(h8*)(Y + (size_t)tt[r] * YP + d0 + 8) = pack8(o + 8); } }
    }
}
__device__ __forceinline__ void sgu_item(const Ctx& C, const float* wsgu, const float* bsgu, const float* gsgu, int n, int g, int w, unsigned* q, int& knx) {
    int ln = C.lane; asm volatile("" : "+v"(ln));
    const int c = ln & 31, hi = ln >> 5, tt = w & 3, cp = w >> 2, tl = 32 * tt + c, t = 128 * n + tl;
    const e16_t* Z = C.w16(WS_Z); const e16_t* ZT = C.w16(WS_ZT); e16_t* Y = C.w16(WS_Y); const float* RSTDV = (const float*)(C.ws + WS_RSTDV);
    const float* wrow = wsgu + ((size_t)g * 128 + tl) * 128;
    f32x16 a0, a1;
#pragma unroll
    for (int r = 0; r < 16; ++r) { a0[r] = 0.f; a1[r] = 0.f; }
    const e16_t* gv0 = ZT + (size_t)(1024 + g * 128 + (2 * cp) * 32 + c) * ZTP + 128 * n + 8 * hi; const e16_t* gv1 = gv0 + (size_t)32 * ZTP;
#pragma unroll
    for (int kh = 0; kh < 2; ++kh) {
        if (kh == 1 && tt < 2) break;
        f32x4 wv[4][2], rv[4][2]; h8 xv[4][2];
#pragma unroll
        for (int k4 = 0; k4 < 4; ++k4) { const int s0 = 16 * (kh * 4 + k4) + 8 * hi;
            wv[k4][0] = *(const f32x4*)(wrow + s0); wv[k4][1] = *(const f32x4*)(wrow + s0 + 4);
            rv[k4][0] = *(const f32x4*)(RSTDV + 128 * n + s0); rv[k4][1] = *(const f32x4*)(RSTDV + 128 * n + s0 + 4);
            xv[k4][0] = *(const h8*)(gv0 + (kh * 4 + k4) * 16); xv[k4][1] = *(const h8*)(gv1 + (kh * 4 + k4) * 16); }
#pragma unroll
        for (int k4 = 0; k4 < 4; ++k4) { const int s0 = 16 * (kh * 4 + k4) + 8 * hi; float f[8];
#pragma unroll
            for (int j = 0; j < 4; ++j) { f[j] = (s0 + j <= tl) ? wv[k4][0][j] * rv[k4][0][j] : 0.f; f[4 + j] = (s0 + 4 + j <= tl) ? wv[k4][1][j] * rv[k4][1][j] : 0.f; }
            const h8 bf = pack8(f); a0 = MFMA32(xv[k4][0], bf, a0); a1 = MFMA32(xv[k4][1], bf, a1); } }
    if (w == 0 && ln == 0) knx = (int)atomicAdd(q, 1u);
    const float bias = bsgu[g * 128 + tl]; const float* gs = gsgu;
    h4 urv[2][4]; f32x4 ggv[2][4];
#pragma unroll
    for (int cbi = 0; cbi < 2; ++cbi)
#pragma unroll
        for (int gq = 0; gq < 4; ++gq) { const int col = g * 128 + (2 * cp + cbi) * 32 + 8 * gq + 4 * hi; urv[cbi][gq] = *(const h4*)(Z + (size_t)t * ZP + ZU + col); ggv[cbi][gq] = *(const f32x4*)(gs + col); }
#pragma unroll
    for (int cbi = 0; cbi < 2; ++cbi)
#pragma unroll
        for (int gq = 0; gq < 4; ++gq) { const int col = g * 128 + (2 * cp + cbi) * 32 + 8 * gq + 4 * hi; const h4 ur = urv[cbi][gq]; const f32x4 gg = ggv[cbi][gq]; float o[4];
#pragma unroll
            for (int i = 0; i < 4; ++i) { const float mix = gg[i] * (cbi == 0 ? a0[4 * gq + i] : a1[4 * gq + i]) + bias; o[i] = gelu_tanh(up16(ur[i])) * mix; }
            u32x2 wv; wv.x = cvt_pk(o[0], o[1]); wv.y = cvt_pk(o[2], o[3]); *(u32x2*)(Y + (size_t)t * YP + 1024 + col) = wv; }
}
#define XB_TMO      128
#define XB_XCNT(j)  (256  + 64 * (j))
#define XB_XSUB(j)  (1280 + 64 * (j))
#define XB_XGEN(j)  (2304 + 64 * (j))
#define XB_TOP      3328
#define XB_TOPGEN   3392
#define XCD_BAR_WORDS 3456
#define XB_SPIN_CAP (1u << 18)
constexpr int CW_BAR = 4096;
__device__ __forceinline__ unsigned xb_ld(unsigned* p)              { return __hip_atomic_load(p, __ATOMIC_RELAXED, __HIP_MEMORY_SCOPE_AGENT); }
__device__ __forceinline__ unsigned xb_add(unsigned* p, unsigned v) { return __hip_atomic_fetch_add(p, v, __ATOMIC_RELAXED, __HIP_MEMORY_SCOPE_AGENT); }
__device__ __forceinline__ unsigned xb_xcc_id() { return (unsigned)__builtin_amdgcn_s_getreg((3 << 11) | 20) & 0xFu; }
#define XB_SPIN(cond, bar) do { unsigned _sp = 0; while (cond) { __builtin_amdgcn_s_sleep(1); \
    if ((++_sp & 255u) == 0u) { if (xb_ld(&(bar)[XB_TMO])) break; if (_sp > XB_SPIN_CAP) { atomicAdd(&(bar)[XB_TMO], 1u); break; } } } } while (0)
struct XcdBarrier { unsigned* bar; unsigned x; volatile LAS unsigned* st; };
__device__ __forceinline__ XcdBarrier xcd_barrier_post(unsigned* bar, volatile LAS unsigned* st) {
    XcdBarrier b; b.bar = bar; b.x = xb_xcc_id(); b.st = st;
    if (threadIdx.x == 0) (void)xb_add(&bar[XB_XCNT(b.x)], 1u);
    return b;
}
__device__ __forceinline__ void xcd_barrier_complete(unsigned* bar, unsigned x, unsigned& nloc, unsigned& nx) {
    const unsigned G = gridDim.x * gridDim.y * gridDim.z;
    unsigned sum, cnt, mine, sp = 0u;
    for (;;) {
        sum = 0u; cnt = 0u; mine = 0u;
#pragma unroll
        for (unsigned j = 0; j < 16; ++j) { const unsigned c = xb_ld(&bar[XB_XCNT(j)]); sum += c; cnt += (c > 0u) ? 1u : 0u; mine = (j == x) ? c : mine; }
        if (sum == G) break;
        __builtin_amdgcn_s_sleep(1);
        if ((++sp & 255u) == 0u) { if (xb_ld(&bar[XB_TMO])) break; if (sp > XB_SPIN_CAP) { atomicAdd(&bar[XB_TMO], 1u); break; } }
    }
    nloc = mine > 0u ? mine : 1u; nx = cnt > 0u ? cnt : 1u;
}
__device__ __forceinline__ void xcd_barrier(const XcdBarrier& b) {
    asm volatile("s_waitcnt vmcnt(0)" ::: "memory");
    __syncthreads();
    if (threadIdx.x == 0) {
        unsigned* bar = b.bar; asm volatile("" : "+s"(bar));
        __builtin_amdgcn_s_waitcnt(0);
        unsigned nloc = b.st[0], nx = b.st[1];
        if (nloc == 0u) { xcd_barrier_complete(bar, b.x, nloc, nx); b.st[0] = nloc; b.st[1] = nx; }
        const unsigned old = xb_add(&bar[XB_XSUB(b.x)], 1u);
        const unsigned gen = old / nloc;
        if (old + 1u == (gen + 1u) * nloc) {
            __builtin_amdgcn_fence(__ATOMIC_RELEASE, "agent");
            asm volatile("s_waitcnt vmcnt(0)" ::: "memory");
            const unsigned og = xb_add(&bar[XB_TOP], 1u);
            const unsigned tg = og / nx;
            if (og + 1u == (tg + 1u) * nx) xb_add(&bar[XB_TOPGEN], 1u);
            else XB_SPIN(xb_ld(&bar[XB_TOPGEN]) == tg, bar);
            __builtin_amdgcn_fence(__ATOMIC_ACQUIRE, "agent");
            xb_add(&bar[XB_XGEN(b.x)], 1u);
            asm volatile("s_waitcnt vmcnt(0)" ::: "memory");
        } else {
            XB_SPIN(xb_ld(&bar[XB_XGEN(b.x)]) == gen, bar);
            __builtin_amdgcn_fence(__ATOMIC_ACQUIRE, "agent");
            asm volatile("s_waitcnt vmcnt(0)" ::: "memory");
        }
    }
    __syncthreads();
}

constexpr int CW_SEAM = 16384;
constexpr int CW_SPLIT = 12288;
struct SplitBar { unsigned* ctr; unsigned* bar; unsigned x; volatile LAS unsigned* st; };
__device__ __forceinline__ void split_arrive(const SplitBar& b) {
    asm volatile("s_waitcnt vmcnt(0)" ::: "memory");
    __syncthreads();
    if (threadIdx.x == 0) { unsigned nloc = b.st[0];
        if (nloc == 0u) { unsigned nx; __builtin_amdgcn_s_waitcnt(0); xcd_barrier_complete(b.bar, b.x, nloc, nx); b.st[0] = nloc; b.st[1] = nx; }
        const unsigned old = xb_add(b.ctr + 32 * b.x, 1u);
        if (old + 1u == nloc) { __builtin_amdgcn_fence(__ATOMIC_RELEASE, "agent"); asm volatile("s_waitcnt vmcnt(0)" ::: "memory"); (void)xb_add(b.ctr + 32 * 16, nloc); } }
}
__device__ __forceinline__ void split_wait(const SplitBar& b) {
    if (threadIdx.x == 0) { const unsigned G = gridDim.x; XB_SPIN(xb_ld(b.ctr + 32 * 16) != G, b.bar); __builtin_amdgcn_fence(__ATOMIC_ACQUIRE, "agent"); asm volatile("s_waitcnt vmcnt(0)" ::: "memory"); }
    __syncthreads();
}
struct MixP { const float *gqa, *gqm, *gkm, *wsgu, *bsgu, *gsgu; };
__device__ __forceinline__ void mixer_phase(const Ctx& C, int l, const MixP& P, const XcdBarrier& xb) {
    unsigned* ctl = (unsigned*)(C.ws + WS_CTL);
    const SplitBar b1{ctl + CW_SPLIT + 544 * (2 * l), ctl + CW_BAR, xb.x, xb.st}, b2{ctl + CW_SPLIT + 544 * (2 * l + 1), ctl + CW_BAR, xb.x, xb.st};
    const unsigned* CNT = (const unsigned*)(C.ws + WS_CTL) + CW_CNT + l * 256; const unsigned* LIST = (const unsigned*)(C.ws + WS_LIST);
    LAS unsigned* pre = (LAS unsigned*)(C.lds + LDS_CTL + 256);
    LAS unsigned* nch = pre + 256; LAS int* bc = (LAS int*)(C.lds + LDS_CTL + 64); LAS unsigned* cntl = (LAS unsigned*)(C.lds + LDS_CTL + 2816);
    const int myq = (int)(__builtin_amdgcn_s_getreg((3 << 11) | 20) & 7u);
    constexpr int N_OWNWG = HA * NBLK, N_MEMWG = HM * NBLK, N_SGUWG = 64 * 8;
    split_arrive(b1);
    int npast = 0;
#pragma unroll 1
    for (int st = 0; st < 3; ++st) {
        if (st == 1) { split_wait(b1);
            int tq = C.tid; asm volatile("" : "+v"(tq));
            if (tq < 256) { const unsigned cn = CNT[tq]; cntl[tq] = cn; nch[tq] = (cn + 255u) >> 8; }
            __syncthreads();
            if (tq < 256) { unsigned sum = 0u; for (int k = 0; k < 256; ++k) { const unsigned v = nch[k]; sum += (k <= tq) ? v : 0u; } pre[tq] = sum; }
            __syncthreads();
            npast = (int)pre[255]; }
        if (st == 2) split_arrive(b2);
        unsigned* qbase = ctl + 8192 + 64 * ((l * 3 + st) * 8);
        const int nA = st == 0 ? N_OWNWG : (st == 1 ? N_MEMWG : N_SGUWG), nB = st == 1 ? npast : 0;
#define QTOT(x_) (((nA * ((x_) + 1)) >> 3) - ((nA * (x_)) >> 3) + (int)(((long)nB * ((x_) + 1)) >> 3) - (int)(((long)nB * (x_)) >> 3))
        int x = myq;
        for (;;) { unsigned* q = qbase + 64 * x;
            const int a_lo = (nA * x) >> 3, a_n = ((nA * (x + 1)) >> 3) - a_lo;
            const int p_lo = (int)(((long)nB * x) >> 3), p_n = (int)(((long)nB * (x + 1)) >> 3) - p_lo;
            const int ntot = a_n + p_n;
            int knx = 0; if (C.tid == 0) knx = (int)atomicAdd(q, 1u);
            for (;;) { if (C.tid == 0) bc[0] = knx;
                __syncthreads(); int k = bc[0]; __syncthreads();
                if (k >= ntot) break;
                if (st == 2) { const int jj = a_lo + k; sgu_item(C, P.wsgu, P.bsgu, P.gsgu, jj >> 3, jj & 7, C.wave, q, knx); continue; }
                if (st == 1 && k < a_n) { const int jj = a_lo + k; mem_wg(C, l, P.gqm, P.gkm, jj >> 5, jj & 31, q, knx); continue; }
                int h_, j_, t_, nt_, sl_; bool va_;
                if (st == 1) { const int it = p_lo + (k - a_n);
                    int lo = 0, hi2 = 255;
                    while (lo < hi2) { const int mid = (lo + hi2) >> 1; if ((int)pre[mid] > it) hi2 = mid; else lo = mid + 1; }
                    const int hj = __builtin_amdgcn_readfirstlane(lo), chunk = it - (hj ? (int)pre[hj - 1] : 0), n = (int)cntl[hj];
                    const int e0 = chunk * 256 + C.wave * 32, e = e0 + (C.lane & 31); va_ = e < n;
                    const unsigned ent = LIST[(size_t)hj * 8192 + (va_ ? e : chunk * 256)];
                    h_ = hj >> 5; j_ = hj & 31; t_ = (int)(ent & 0xffffu); nt_ = e0 < n ? 8 : 0; sl_ = (int)(ent >> 16);
                } else { const int jj = a_lo + k;
                    const int qt = C.wave < 4 ? C.wave : 11 - C.wave;
                    h_ = jj >> 5; j_ = 31 - (jj & 31); t_ = j_ * 256 + qt * 32 + (C.lane & 31); nt_ = qt + 1; sl_ = 3; va_ = true; }
                moba_wg(C, P.gqa, h_, j_, t_, nt_, sl_, va_, q, knx); }
            if (C.tid == 0) { unsigned cv[8];
#pragma unroll
                for (int y = 0; y < 8; ++y) cv[y] = __hip_atomic_load(qbase + 64 * y, __ATOMIC_RELAXED, __HIP_MEMORY_SCOPE_AGENT);
                int nxq = -1;
#pragma unroll
                for (int sq = 7; sq >= 1; --sq) { const int y = (myq + sq) & 7; if ((int)cv[y] < QTOT(y)) nxq = y; }
                bc[1] = nxq; }
            __syncthreads(); x = bc[1]; __syncthreads();
            if (x < 0) break;
        }
#undef QTOT
    }
    split_wait(b2);
}

#define INP(k) ((const float*)(((unsigned long long)(unsigned)__builtin_amdgcn_readfirstlane((int)((volatile LAS unsigned*)(C.lds + LDS_CTL + 2560))[2 * (k) + 1]) << 32) | (unsigned long long)(unsigned)__builtin_amdgcn_readfirstlane((int)((volatile LAS unsigned*)(C.lds + LDS_CTL + 2560))[2 * (k)])))
__global__ void __launch_bounds__(NTHREADS, 2) fwd_kernel(Args args) {
    extern __shared__ __attribute__((aligned(16))) unsigned char lds_raw[];
    cg::grid_group grid = cg::this_grid();
    Ctx C; C.lds = (LAS unsigned char*)lds_raw; C.tid = threadIdx.x; C.lane = C.tid & 63; C.wave = __builtin_amdgcn_readfirstlane(C.tid >> 6);
    C.G = gridDim.x; C.gw = blockIdx.x * NWAVES + C.wave; C.NGW = C.G * NWAVES;
    C.out = args.out; C.ws = args.ws;
    const int lo = args.ph_lo, hi = args.ph_hi;
    const int wave0 = __builtin_amdgcn_readfirstlane(threadIdx.x >> 6);
    volatile LAS unsigned* bst = (volatile LAS unsigned*)(C.lds + LDS_CTL);
    if (threadIdx.x < 2) bst[threadIdx.x] = 0u;
    if (threadIdx.x < 18) ((LAS unsigned long long*)(C.lds + LDS_CTL + 2560))[threadIdx.x] = (unsigned long long)args.in[threadIdx.x];
    __syncthreads();
    const XcdBarrier xbar = xcd_barrier_post((unsigned*)(args.ws + WS_CTL) + CW_BAR, bst);
    LAS unsigned char* ring = C.lds;
#pragma unroll 1
    for (int ph = lo; ph < hi; ++ph) {
#define REFRESH_TID do { int w0_ = wave0; asm volatile("" : "+s"(w0_)); int tid_ = w0_ * 64 + (int)__builtin_amdgcn_mbcnt_hi(~0u, __builtin_amdgcn_mbcnt_lo(~0u, 0u)); asm volatile("" : "+v"(tid_)); C.tid = tid_; C.lane = tid_ & 63; C.wave = w0_; } while (0)
        REFRESH_TID;
        int bx = blockIdx.x; asm volatile("" : "+s"(bx)); C.gw = bx * NWAVES + C.wave; size_t zo_ = 0; asm volatile("" : "+s"(zo_)); C.ws = args.ws + zo_; C.out = args.out + zo_;
        int l = ph == 0 ? 0 : (ph - 1) / 6, kp = ph == 0 ? -1 : (ph - 1) % 6; asm volatile("" : "+s"(l), "+s"(kp));
        int cj = -1, cslot = 0, cstride = 1;
        if (kp < 0) {
            for (int pl = 0; pl < NLAYER; ++pl) rms_rows(C, INP(1), INP(11) + pl * D_, C.w16(WS_MEMN) + (size_t)pl * NMEM * D_, NMEM);
            { fx_t* RSS = (fx_t*)(C.ws + WS_RSS); xb_rows(C, INP(0), C.w16(WS_HN), RSS, S_);
              for (int i = bx * NTHREADS + C.tid; i < 3 * S_; i += C.G * NTHREADS) RSS[S_ + i] = 0ull;
              fx_t* RSSV = (fx_t*)(C.ws + WS_RSSV); for (int i = bx * NTHREADS + C.tid; i < S_; i += C.G * NTHREADS) RSSV[i] = 0ull;
              unsigned* ONES = (unsigned*)(C.ws + WS_ONES);
_Pragma("unroll 1")
              for (int b = bx; b < 64; b += C.G) ONES[b * NTHREADS + C.tid] = 0x3F803F80u; }
            cj = 0; cslot = C.gw; cstride = C.NGW;
        } else if (kp == 0) {
            { pg8::Gemm g{C.w16(WS_HN), C.wl(l, WL_IN), S_, ZN, D_, D_, D_}; pg8::StaticOrder S; S.init(S_, ZN, C.G, bx); pg8::EpiZ E{C.w16(WS_Z), C.w16(WS_GATE), (const pg8::fx_t*)(C.ws + WS_RSS) + (size_t)(2 * l) * S_, C.lds, INP(5) + l * DA, (float*)(C.ws + WS_KMEAN)};
              pg8::gemm_phase<pg8::EpiZ, pg8::StaticOrder>(ring, C.tid, g, S, E); }
            REFRESH_TID;
            { pg8::Gemm g{C.wl(l, WL_IN) + (size_t)ZN * D_, C.w16(WS_HN), 2048, S_, D_, D_, D_}; pg8::StaticOrder S; S.init(2048, S_, C.G, bx); pg8::EpiStore16 E{C.w16(WS_ZT), ZTP, (const pg8::fx_t*)(C.ws + WS_RSS) + (size_t)(2 * l) * S_, 2, (pg8::fx_t*)(C.ws + WS_RSSV)};
              pg8::gemm_phase<pg8::EpiStore16, pg8::StaticOrder>(ring, C.tid, g, S, E); }
            if (l == 0) for (int ll = 0; ll < NLAYER; ++ll) {
                REFRESH_TID;
                { pg8::Gemm g{C.w16(WS_MEMN) + (size_t)ll * NMEM * D_, C.wl(ll, WL_M), NMEM, 1024, D_, D_, D_}; pg8::StaticOrder S; S.init(NMEM, 1024, C.G, (bx + C.G - 8 * ll) % C.G);
                  pg8::EpiStore16 E{C.w16(WS_KM) + (size_t)ll * NMEM * 1024, 1024, nullptr, 0, nullptr}; pg8::gemm_phase<pg8::EpiStore16, pg8::StaticOrder>(ring, C.tid, g, S, E); }
                REFRESH_TID;
                { pg8::Gemm g{C.wl(ll, WL_M) + (size_t)1024 * D_, C.w16(WS_MEMN) + (size_t)ll * NMEM * D_, 1024, NMEM, D_, D_, D_}; pg8::StaticOrder S; S.init(1024, NMEM, C.G, (bx + C.G - 8 * ll - 4) % C.G);
                  pg8::EpiStore16 E{C.w16(WS_VMT) + (size_t)ll * 1024 * NMEM, NMEM, nullptr, 0, nullptr}; pg8::gemm_phase<pg8::EpiStore16, pg8::StaticOrder>(ring, C.tid, g, S, E); } }
            if (l == 0 && bx >= 16) { cj = 1; cslot = (bx - 16) * NWAVES + C.wave; cstride = (C.G - 16) * NWAVES; }
        } else if (kp == 1) {
            if (l == 0) kmnorm_phase(C, INP(10));
            { const fx_t* RSSV = (const fx_t*)(C.ws + WS_RSSV); float* RSTDV = (float*)(C.ws + WS_RSTDV); for (int i = bx * NTHREADS + C.tid; i < S_; i += C.G * NTHREADS) RSTDV[i] = rsqrtf(fx2f(RSSV[i]) * (1.f / 1024.f) + EPS); }
            gating_phase(C, l, INP(4) + l * DA, INP(5) + l * DA);
            { MixP P{INP(4) + l * DA, INP(9) + l * DMH, INP(10) + l * DMH, INP(7) + (size_t)l * 8 * 128 * 128, INP(8) + l * 8 * 128, INP(6) + l * 1024}; mixer_phase(C, l, P, xbar); }
            attn_combine_phase(C);
        } else if (kp == 2) {
            { pg8::Gemm g{C.w16(WS_Y), C.wl(l, WL_B), S_, D_, 3072, YP, 3072}; pg8::StaticOrder S; S.init(S_, D_, C.G, bx); pg8::EpiMerge E{C.w16(WS_GATE), C.w16(WS_MG)};
              pg8::gemm_phase<pg8::EpiMerge, pg8::StaticOrder>(ring, C.tid, g, S, E); }
        } else if (kp == 3) {
            { pg8::Gemm g{C.w16(WS_MG), C.wl(l, WL_O), S_, D_, D_, D_, D_}; pg8::StaticOrder S; S.init(S_, D_, C.G, bx); pg8::EpiRes E{INP(0), l == 0 ? (const e16_t*)nullptr : (const e16_t*)C.w16(WS_HN), nullptr, C.w16(WS_HN), (pg8::fx_t*)(C.ws + WS_RSS) + (size_t)(2 * l + 1) * S_, D_};
              pg8::gemm_phase<pg8::EpiRes, pg8::StaticOrder>(ring, C.tid, g, S, E); }
        } else if (kp == 4) {
            { pg8::Gemm g{C.w16(WS_HN), C.wl(l, WL_GU), S_, 2 * DFF, D_, D_, D_}; pg8::StaticOrder S; S.init(S_, 2 * DFF, C.G, bx); pg8::EpiSwiGLU E{C.w16(WS_GATE), DFF, (const pg8::fx_t*)(C.ws + WS_RSS) + (size_t)(2 * l + 1) * S_};
              pg8::gemm_phase<pg8::EpiSwiGLU, pg8::StaticOrder>(ring, C.tid, g, S, E); }
            if (bx >= C.G / 2) { cj = 2 + l; cslot = (bx - C.G / 2) * NWAVES + C.wave; cstride = (C.G / 2) * NWAVES; }
        } else {
            if (bx == 0 && l + 1 < NLAYER) { fx_t* RSSV = (fx_t*)(C.ws + WS_RSSV); for (int i = C.tid; i < S_; i += NTHREADS) RSSV[i] = 0ull; }
            { pg8::Gemm g{C.w16(WS_GATE), C.wl(l, WL_D), S_, D_, DFF, DFF, DFF}; pg8::StaticOrder S; S.init(S_, D_, C.G, bx); pg8::EpiRes E{nullptr, C.w16(WS_HN), l + 1 < NLAYER ? (float*)nullptr : C.out, l + 1 < NLAYER ? C.w16(WS_HN) : (e16_t*)nullptr, l + 1 < NLAYER ? (pg8::fx_t*)(C.ws + WS_RSS) + (size_t)(2 * l + 2) * S_ : (pg8::fx_t*)nullptr, D_};
              pg8::gemm_phase<pg8::EpiRes, pg8::StaticOrder>(ring, C.tid, g, S, E); }
        }
        REFRESH_TID;
        const bool seam = ph + 1 < hi, fill = seam && ph < 10;
        unsigned* ctl_ = (unsigned*)C.ws; const SplitBar sb_{ctl_ + CW_SEAM + 544 * (ph < 10 ? ph : 0), ctl_ + CW_BAR, xbar.x, xbar.st};
        int chi = 1 << 20;
#pragma unroll 1
        for (int r = 0; r < 2; ++r) {
            if (r == 1) { if (!fill) break; split_arrive(sb_); cj = 4; cslot = ph * 2048 + C.gw; cstride = C.NGW; chi = 1; }
            if (cj >= 0) convert_job(args, C, cj, cslot, cstride, 0, chi, (LAS float*)(C.lds + C.wave * 16384)); }
        if (seam) { if (hi < 0) grid.sync(); if (fill) split_wait(sb_); else xcd_barrier(xbar); }
    }
}
constexpr int N_PHASES = 1 + NLAYER * 6;

extern "C" void kernel_launch(void* const* d_in, const int* in_sizes, int n_in, void* d_out, int out_size, void* d_ws, size_t ws_size, hipStream_t stream) {
    static int grid = 0;
    if (grid == 0) {
        if (n_in != 18 || in_sizes[0] != S_ * D_ || out_size != S_ * D_ || ws_size < WS_END) {
            fprintf(stderr, "kernel_launch: unexpected shapes / workspace (n_in %d, in0 %d, out %d, ws %zu, need %zu); nothing launched\n", n_in, n_in > 0 ? in_sizes[0] : -1, out_size, ws_size, (size_t)WS_END); grid = -1; return; }
        int dev = 0, cus = 0, per_cu = 0;
        if (hipGetDevice(&dev) != hipSuccess || hipDeviceGetAttribute(&cus, hipDeviceAttributeMultiprocessorCount, dev) != hipSuccess) { grid = -1; return; }
        if (hipFuncSetAttribute((const void*)fwd_kernel, hipFuncAttributeMaxDynamicSharedMemorySize, LDS_BYTES) != hipSuccess) { fprintf(stderr, "kernel_launch: hipFuncSetAttribute failed\n"); grid = -1; return; }
        if (hipOccupancyMaxActiveBlocksPerMultiprocessor(&per_cu, (const void*)fwd_kernel, NTHREADS, LDS_BYTES) != hipSuccess || per_cu < 1) { fprintf(stderr, "kernel_launch: occupancy query says %d\n", per_cu); per_cu = 1; }
        (void)hipGetLastError();
        grid = cus * 1;
        fprintf(stderr, "kernel_launch: grid %d (cus %d, per_cu %d), ws %zu\n", grid, cus, per_cu, ws_size);
    }
    if (grid < 0) return;
    (void)hipMemsetAsync((char*)d_ws + WS_CTL, 0, 131072, stream);
    Args a{};
    for (int i = 0; i < 18; ++i) a.in[i] = (const float*)d_in[i];
    a.out = (float*)d_out; a.ws = (unsigned char*)d_ws; a.ph_lo = 0; a.ph_hi = N_PHASES;
    void* kargs[] = {&a};
    hipError_t e = hipLaunchCooperativeKernel((const void*)fwd_kernel, dim3(grid), dim3(NTHREADS), kargs, LDS_BYTES, stream);
    if (e != hipSuccess) fprintf(stderr, "kernel_launch: cooperative launch failed: %s (grid %d)\n", hipGetErrorString(e), grid);
}
```

```cpp
#include <hip/hip_runtime.h>
#include <hip/hip_cooperative_groups.h>
#include <cstdio>
#include <cstdint>
namespace cg = cooperative_groups;

#define LAS __attribute__((address_space(3)))
#define GAS __attribute__((address_space(1)))
typedef unsigned short e16_t;
typedef short h8 __attribute__((ext_vector_type(8)));
typedef short h4 __attribute__((ext_vector_type(4)));
typedef __bf16 mf8 __attribute__((ext_vector_type(8)));
typedef __bf16 mf2 __attribute__((ext_vector_type(2)));
typedef float f32x2 __attribute__((ext_vector_type(2)));
typedef float f32x4 __attribute__((ext_vector_type(4)));
typedef float f32x16 __attribute__((ext_vector_type(16)));
typedef unsigned u32x2 __attribute__((ext_vector_type(2)));
typedef unsigned u32x4 __attribute__((ext_vector_type(4)));

#define MFMA32(a, b, c) __builtin_amdgcn_mfma_f32_32x32x16_bf16(__builtin_bit_cast(mf8, (a)), __builtin_bit_cast(mf8, (b)), (c), 0, 0, 0)
#define MFMA16(a, b, c) __builtin_amdgcn_mfma_f32_16x16x32_bf16(__builtin_bit_cast(mf8, (a)), __builtin_bit_cast(mf8, (b)), (c), 0, 0, 0)

__device__ __forceinline__ unsigned cvt_pk(float lo, float hi) { f32x2 v = {lo, hi}; mf2 b = __builtin_convertvector(v, mf2); return __builtin_bit_cast(unsigned, b); }
__device__ __forceinline__ float up16(short x) { return __uint_as_float(((unsigned)(unsigned short)x) << 16); }
__device__ __forceinline__ float up_lo(unsigned w) { return __uint_as_float(w << 16); }
__device__ __forceinline__ float up_hi(unsigned w) { return __uint_as_float(w & 0xffff0000u); }
__device__ __forceinline__ h8 pack8(const float* f) { u32x4 w = {cvt_pk(f[0], f[1]), cvt_pk(f[2], f[3]), cvt_pk(f[4], f[5]), cvt_pk(f[6], f[7])}; return __builtin_bit_cast(h8, w); }
__device__ __forceinline__ float wave_sum(float v) {
#pragma unroll
    for (int o = 1; o < 64; o <<= 1) v += __shfl_xor(v, o);
    return v;
}
__device__ __forceinline__ float gelu_tanh(float x) {
    const float u = 0.7978845608028654f * (x + 0.044715f * x * x * x);
    return x / (1.0f + __builtin_amdgcn_exp2f(-2.885390081777927f * u));
}
__device__ __forceinline__ float sigmoidf_(float x) { return 1.0f / (1.0f + __builtin_amdgcn_exp2f(-1.4426950408889634f * x)); }
__device__ __forceinline__ int crow(int r, int hi) { return (r & 3) + 8 * (r >> 2) + 4 * hi; }

constexpr int S_ = 8192, D_ = 2048, NLAYER = 2;
constexpr int HA = 8, DA = 128, NBLK = 32;
constexpr int HM = 4, DMH = 256, NMEM = 256;
constexpr int DFF = 5632, WINC = 12288;
constexpr int ZP = 4096, ZN = 10240;
constexpr int ZQ = 0, ZK = 1024, ZU = 2048, ZQM = 3072, ZG = 4096;
constexpr int ZTP = 8192;
constexpr int YP = 3072;
constexpr float EPS = 1e-6f, LOG2E = 1.4426950408889634f;

constexpr size_t MiB = 1u << 20;
constexpr size_t WS_CTL = 0;
constexpr size_t WL_IN = 0, WL_B = 48 * MiB, WL_O = 60 * MiB, WL_GU = 68 * MiB, WL_D = 112 * MiB, WL_M = 134 * MiB, WL_SIZE = 142 * MiB;
constexpr size_t WS_W = 1 * MiB;
constexpr size_t WS_HN = WS_W + 2 * WL_SIZE;
constexpr size_t WS_Z = WS_HN + 32 * MiB;
constexpr size_t WS_GATE = WS_Z + 64 * MiB;
constexpr size_t WS_ZT = WS_GATE + 96 * MiB;
constexpr size_t WS_Y = WS_ZT + 32 * MiB;
constexpr size_t WS_PART = WS_Y + 48 * MiB;
constexpr size_t WS_MG = WS_PART + 64 * MiB;
constexpr size_t WS_MEMN = WS_MG + 32 * MiB;
constexpr size_t WS_KM = WS_MEMN + 2 * MiB;
constexpr size_t WS_VMT = WS_KM + 1 * MiB;
constexpr size_t WS_KMEAN = WS_VMT + 1 * MiB;
constexpr size_t WS_RSSV = WS_KMEAN + 256 * 1024;
constexpr size_t WS_RSS = WS_RSSV + 64 * 1024;
constexpr size_t WS_RSTDV = WS_RSSV + 384 * 1024;
constexpr size_t WS_LIST = WS_RSSV + 512 * 1024;
constexpr size_t WS_ML = WS_LIST + 8 * MiB;
constexpr size_t WS_SEL = WS_ML + 2 * MiB;
constexpr size_t WS_ONES = WS_SEL + 1 * MiB;
constexpr size_t WS_END = WS_ONES + 1 * MiB;
constexpr int CW_CNT = 2048;

namespace pg8 {
constexpr int PRE_OFF = 139264 + 12288;
constexpr int EPI_OFF = 139264;
constexpr int BM = 256, BK = 64, HALF = 128, HTB = HALF * BK * 2, STAGE_BYTES = 8 * HTB, NXCD = 8, WGM = 8;
__host__ __device__ __forceinline__ int lds_byte(int r, int c) { const int st = (r >> 4) * 2 + (c >> 5), rr = r & 15, cc = c & 31, ob = rr * 64 + cc * 2; return st * 1024 + (ob ^ (((ob >> 9) & 1) << 5)); }
__host__ __device__ __forceinline__ void stage_rc(int b, int& R, int& C) { const int st = b / 1024, sb = b % 1024, swz = sb ^ (((sb >> 9) & 1) << 5); R = (st >> 1) * 16 + swz / 64; C = (st & 1) * 32 + (swz % 64) / 2; }
__host__ __device__ __forceinline__ int perm32(int rho) { const int n = rho >> 4, i = rho & 15; return 8 * (i >> 2) + 4 * n + (i & 3); }

struct Unit { int pm, pn; };
struct Gemm { const e16_t* A; const e16_t* Bt; int M, N, K, lda, ldb; };

struct StaticOrder {
    int nM, nN, nwg, G, c;
    __host__ __device__ void init(int M, int N, int G_, int c_) { nM = M / BM; nN = N / BM; nwg = nM * nN; G = G_; c = c_; }
    __host__ __device__ bool next(int i, Unit& u) const {
        const long L = (long)i * G + c; if (L >= nwg) return false;
        int wgid = (int)L; { const int q = nwg / NXCD, r = nwg % NXCD, xcd = wgid % NXCD, off = wgid / NXCD; wgid = (xcd < r ? xcd * (q + 1) : r * (q + 1) + (xcd - r) * q) + off; }
        const int nig = WGM * nN, gid = wgid / nig, fm = gid * WGM, gsz = (nM - fm) < WGM ? (nM - fm) : WGM;
        u.pm = fm + ((wgid % nig) % gsz); u.pn = (wgid % nig) / gsz; return true;
    }
    __device__ __forceinline__ void a_ready(const Unit&) const {}
    __device__ __forceinline__ void done(const Unit&) const {}
};

#ifndef ST_AUX
#define ST_AUX 0
#endif
struct WT {
    __amdgpu_buffer_rsrc_t r;
    __device__ __forceinline__ explicit WT(const void* p) : r(__builtin_amdgcn_make_buffer_rsrc((void*)p, 0, 0x7fffffff, 0x00020000)) {}
    __device__ __forceinline__ void st(unsigned byteoff, u32x4 v) const { __builtin_amdgcn_raw_buffer_store_b128(v, r, byteoff, 0, ST_AUX); }
    __device__ __forceinline__ void stf(unsigned byteoff, f32x4 v) const { __builtin_amdgcn_raw_buffer_store_b128(__builtin_bit_cast(u32x4, v), r, byteoff, 0, ST_AUX); }
};
typedef unsigned long long fx_t;
constexpr float FX_ONE = 1048576.f, FX_INV = 1.f / 1048576.f;
__device__ __forceinline__ float fx2f(fx_t v) { return (float)v * FX_INV; }
__device__ __forceinline__ fx_t f2fx(float v) { return (fx_t)(v * FX_ONE); }
__device__ __forceinline__ float rstd_of(float ss) { return rsqrtf(ss * (1.f / 2048.f) + 1e-6f); }
struct EpiStore16 {
    static constexpr bool PERM = true, HAS_MID = false, HAS_PRE = false;
    e16_t* O; int ldc; const fx_t* rss; int mode; fx_t* rssv;
    __device__ __forceinline__ void operator()(const f32x4 (&acc)[2][2][4][2], const Unit& u, int wr, int wc, int fr, int fq) const {
        const int row0 = u.pm * BM + wr * 64 + fr, col0 = u.pn * BM + wc * 32 + 8 * fq;
        f32x4 cs[2][2];
#pragma unroll
        for (int bj = 0; bj < 2; ++bj)
#pragma unroll
            for (int n = 0; n < 2; ++n) { cs[bj][n] = (f32x4){1.f, 1.f, 1.f, 1.f};
                if (mode == 2) { const fx_t* rp = rss + col0 + bj * HALF + 4 * n; cs[bj][n] = (f32x4){rstd_of(fx2f(rp[0])), rstd_of(fx2f(rp[1])), rstd_of(fx2f(rp[2])), rstd_of(fx2f(rp[3]))}; } }
        const WT wt(O); const bool dogelu = (mode == 2) && rssv != nullptr && u.pm >= 4;
        float sq[2][8];
#pragma unroll
        for (int bj = 0; bj < 2; ++bj)
#pragma unroll
            for (int e = 0; e < 8; ++e) sq[bj][e] = 0.f;
        float rsv[2][4];
#pragma unroll
        for (int ai = 0; ai < 2; ++ai)
#pragma unroll
            for (int m = 0; m < 4; ++m) rsv[ai][m] = (mode == 1) ? fx2f(rss[row0 + ai * HALF + m * 16]) : 0.f;
#pragma unroll
        for (int ai = 0; ai < 2; ++ai)
#pragma unroll
            for (int m = 0; m < 4; ++m) { const int row = row0 + ai * HALF + m * 16; const unsigned rowb = (unsigned)(row * ldc + col0) * 2u;
                const float rs = (mode == 1) ? rstd_of(rsv[ai][m]) : 1.f;
#pragma unroll
                for (int bj = 0; bj < 2; ++bj) { f32x4 v0 = acc[ai][bj][m][0] * cs[bj][0] * rs, v1 = acc[ai][bj][m][1] * cs[bj][1] * rs;
                    if (dogelu) {
#pragma unroll
                        for (int e = 0; e < 4; ++e) { v0[e] = gelu_tanh(v0[e]); v1[e] = gelu_tanh(v1[e]); sq[bj][e] += v0[e] * v0[e]; sq[bj][4 + e] += v1[e] * v1[e]; } }
                    u32x4 w; w.x = cvt_pk(v0[0], v0[1]); w.y = cvt_pk(v0[2], v0[3]); w.z = cvt_pk(v1[0], v1[1]); w.w = cvt_pk(v1[2], v1[3]);
                    wt.st(rowb + bj * HALF * 2, w); } }
        if (dogelu) {
#pragma unroll
            for (int bj = 0; bj < 2; ++bj)
#pragma unroll
                for (int e = 0; e < 8; ++e) { float v = sq[bj][e]; v += __shfl_xor(v, 1); v += __shfl_xor(v, 2); v += __shfl_xor(v, 4); v += __shfl_xor(v, 8);
                    if (fr == 0) atomicAdd(rssv + col0 + bj * HALF + e, f2fx(v)); } }
    }
};
struct EpiSwiGLU {
    static constexpr bool PERM = true, HAS_MID = false, HAS_PRE = true;
    e16_t* O; int ldc; const fx_t* rss; LAS unsigned char* lds;
    __device__ __forceinline__ void operator()(const f32x4 (&acc)[2][2][4][2], const Unit& u, int wr, int wc, int fr, int fq) const {
        const int row0 = u.pm * BM + wr * 64 + fr, col0 = u.pn * HALF + wc * 32 + 8 * fq;
        const WT wt(O);
        float rsv[2][4];
#pragma unroll
        for (int ai = 0; ai < 2; ++ai)
#pragma unroll
            for (int m = 0; m < 4; ++m) rsv[ai][m] = fx2f(*(const LAS fx_t*)(lds + PRE_OFF + (wr * 64 + fr + ai * HALF + m * 16) * 8));
#pragma unroll
        for (int ai = 0; ai < 2; ++ai)
#pragma unroll
            for (int m = 0; m < 4; ++m) { const int row = row0 + ai * HALF + m * 16; const unsigned rowb = (unsigned)(row * ldc + col0) * 2u; const float rs = rstd_of(rsv[ai][m]);
                float hv[8];
#pragma unroll
                for (int n = 0; n < 2; ++n)
#pragma unroll
                    for (int i = 0; i < 4; ++i) { const float g = acc[ai][0][m][n][i] * rs, up = acc[ai][1][m][n][i] * rs; hv[n * 4 + i] = g * sigmoidf_(g) * up; }
                u32x4 w; w.x = cvt_pk(hv[0], hv[1]); w.y = cvt_pk(hv[2], hv[3]); w.z = cvt_pk(hv[4], hv[5]); w.w = cvt_pk(hv[6], hv[7]);
                wt.st(rowb, w); }
    }
};
struct EpiRes {
    static constexpr bool PERM = true, HAS_MID = false, HAS_PRE = false;
    const float* base; const e16_t* base16; float* out; e16_t* xb; fx_t* rss; int ldc;
    __device__ __forceinline__ void operator()(const f32x4 (&acc)[2][2][4][2], const Unit& u, int wr, int wc, int fr, int fq) const {
        const int row0 = u.pm * BM + wr * 64 + fr, col0 = u.pn * BM + wc * 32 + 8 * fq;
        const WT wo(out ? (const void*)out : (const void*)xb), wx(xb ? (const void*)xb : (const void*)out);
        if (base16) {
            h8 raw[2][4][2];
#pragma unroll
            for (int ai = 0; ai < 2; ++ai)
#pragma unroll
                for (int m = 0; m < 4; ++m) { const e16_t* bp = base16 + (size_t)(row0 + ai * HALF + m * 16) * ldc + col0;
#pragma unroll
                    for (int bj = 0; bj < 2; ++bj) raw[ai][m][bj] = *(const h8*)(bp + bj * HALF); }
#pragma unroll
            for (int ai = 0; ai < 2; ++ai)
#pragma unroll
                for (int m = 0; m < 4; ++m) { const int row = row0 + ai * HALF + m * 16; const size_t off = (size_t)row * ldc + col0; float ss = 0.f;
#pragma unroll
                    for (int bj = 0; bj < 2; ++bj) { const h8 r = raw[ai][m][bj];
                        const f32x4 v0 = (f32x4){up16(r[0]), up16(r[1]), up16(r[2]), up16(r[3])} + acc[ai][bj][m][0], v1 = (f32x4){up16(r[4]), up16(r[5]), up16(r[6]), up16(r[7])} + acc[ai][bj][m][1];
                        if (out) { wo.stf((unsigned)(off + bj * HALF) * 4u, v0); wo.stf((unsigned)(off + bj * HALF + 4) * 4u, v1); }
                        ss += (v0[0] * v0[0] + v0[1] * v0[1]) + (v0[2] * v0[2] + v0[3] * v0[3]) + (v1[0] * v1[0] + v1[1] * v1[1]) + (v1[2] * v1[2] + v1[3] * v1[3]);
                        if (xb) { u32x4 w; w.x = cvt_pk(v0[0], v0[1]); w.y = cvt_pk(v0[2], v0[3]); w.z = cvt_pk(v1[0], v1[1]); w.w = cvt_pk(v1[2], v1[3]); wx.st((unsigned)(off + bj * HALF) * 2u, w); } }
                    if (rss) { ss += __shfl_xor(ss, 16); ss += __shfl_xor(ss, 32); if (fq == 0) atomicAdd(rss + row, f2fx(ss)); } }
            return; }
#pragma unroll
        for (int ai = 0; ai < 2; ++ai) {
            f32x4 bv[4][2][2];
#pragma unroll
            for (int m = 0; m < 4; ++m) { const float* bp = base + (size_t)(row0 + ai * HALF + m * 16) * ldc + col0;
#pragma unroll
                for (int bj = 0; bj < 2; ++bj) { bv[m][bj][0] = *(const f32x4*)(bp + bj * HALF); bv[m][bj][1] = *(const f32x4*)(bp + bj * HALF + 4); } }
#pragma unroll
            for (int m = 0; m < 4; ++m) { const int row = row0 + ai * HALF + m * 16; const size_t off = (size_t)row * ldc + col0; float ss = 0.f;
#pragma unroll
                for (int bj = 0; bj < 2; ++bj) { const f32x4 v0 = bv[m][bj][0] + acc[ai][bj][m][0], v1 = bv[m][bj][1] + acc[ai][bj][m][1];
                    if (out) { wo.stf((unsigned)(off + bj * HALF) * 4u, v0); wo.stf((unsigned)(off + bj * HALF + 4) * 4u, v1); }
                    ss += (v0[0] * v0[0] + v0[1] * v0[1]) + (v0[2] * v0[2] + v0[3] * v0[3]) + (v1[0] * v1[0] + v1[1] * v1[1]) + (v1[2] * v1[2] + v1[3] * v1[3]);
                    if (xb) { u32x4 w; w.x = cvt_pk(v0[0], v0[1]); w.y = cvt_pk(v0[2], v0[3]); w.z = cvt_pk(v1[0], v1[1]); w.w = cvt_pk(v1[2], v1[3]); wx.st((unsigned)(off + bj * HALF) * 2u, w); } }
                if (rss) { ss += __shfl_xor(ss, 16); ss += __shfl_xor(ss, 32); if (fq == 0) atomicAdd(rss + row, f2fx(ss)); } }
        }
    }
};

struct EpiZ {
    static constexpr bool PERM = true, HAS_MID = false, HAS_PRE = true;
    e16_t* Z; e16_t* GATE; const fx_t* rss; LAS unsigned char* lds; const float* gk; float* kmean;
    __device__ __forceinline__ void operator()(const f32x4 (&acc)[2][2][4][2], const Unit& u, int wr, int wc, int fr, int fq) const {
        const int row0 = u.pm * BM + wr * 64 + fr, col0 = u.pn * BM + wc * 32 + 8 * fq;
        const WT wz(Z), wg(GATE);
        float rsv[2][4];
#pragma unroll
        for (int ai = 0; ai < 2; ++ai)
#pragma unroll
            for (int m = 0; m < 4; ++m) rsv[ai][m] = fx2f(*(const LAS fx_t*)(lds + PRE_OFF + (wr * 64 + fr + ai * HALF + m * 16) * 8));
        if (u.pn >= 4 && u.pn < 8) {
            LAS float* P = (LAS float*)(lds + EPI_OFF); LAS float* KS = P + 2048;
#pragma unroll
            for (int ai = 0; ai < 2; ++ai)
#pragma unroll
                for (int m = 0; m < 4; ++m) { const float rs = rstd_of(rsv[ai][m]); const int rl = ai * HALF + wr * 64 + m * 16 + fr;
#pragma unroll
                    for (int bj = 0; bj < 2; ++bj) { const f32x4 v0 = acc[ai][bj][m][0] * rs, v1 = acc[ai][bj][m][1] * rs;
                        float ss = (v0[0] * v0[0] + v0[1] * v0[1]) + (v0[2] * v0[2] + v0[3] * v0[3]) + (v1[0] * v1[0] + v1[1] * v1[1]) + (v1[2] * v1[2] + v1[3] * v1[3]);
                        ss += __shfl_xor(ss, 16); ss += __shfl_xor(ss, 32);
                        if (fq == 0) P[(rl * 2 + bj) * 4 + wc] = ss; } }
            asm volatile("s_waitcnt lgkmcnt(0)" ::: "memory"); __builtin_amdgcn_s_barrier(); asm volatile("" ::: "memory");
            const f32x4 g0 = *(const f32x4*)(gk + wc * 32 + 8 * fq), g1 = *(const f32x4*)(gk + wc * 32 + 8 * fq + 4);
            float cs[2][8];
#pragma unroll
            for (int bj = 0; bj < 2; ++bj)
#pragma unroll
                for (int e = 0; e < 8; ++e) cs[bj][e] = 0.f;
#pragma unroll
            for (int ai = 0; ai < 2; ++ai)
#pragma unroll
                for (int m = 0; m < 4; ++m) { const int rl = ai * HALF + wr * 64 + m * 16 + fr; const unsigned rowb = (unsigned)((row0 + ai * HALF + m * 16) * ZP + col0) * 2u; const float rs = rstd_of(rsv[ai][m]);
#pragma unroll
                    for (int bj = 0; bj < 2; ++bj) { const f32x4 pt = *(const LAS f32x4*)(P + (rl * 2 + bj) * 4);
                        const float rk = rsqrtf(((pt[0] + pt[1]) + (pt[2] + pt[3])) * (1.f / 128.f) + 1e-6f) * rs;
                        const f32x4 v0 = acc[ai][bj][m][0] * rk * g0, v1 = acc[ai][bj][m][1] * rk * g1;
#pragma unroll
                        for (int e = 0; e < 4; ++e) { cs[bj][e] += v0[e]; cs[bj][4 + e] += v1[e]; }
                        u32x4 w; w.x = cvt_pk(v0[0], v0[1]); w.y = cvt_pk(v0[2], v0[3]); w.z = cvt_pk(v1[0], v1[1]); w.w = cvt_pk(v1[2], v1[3]);
                        wz.st(rowb + bj * HALF * 2, w); } }
#pragma unroll
            for (int bj = 0; bj < 2; ++bj)
#pragma unroll
                for (int e = 0; e < 8; ++e) { float v = cs[bj][e]; v += __shfl_xor(v, 1); v += __shfl_xor(v, 2); v += __shfl_xor(v, 4); v += __shfl_xor(v, 8); cs[bj][e] = v; }
            if (fr == 0) {
#pragma unroll
                for (int bj = 0; bj < 2; ++bj)
#pragma unroll
                    for (int e = 0; e < 8; ++e) KS[wr * 256 + bj * HALF + wc * 32 + 8 * fq + e] = cs[bj][e]; }
            asm volatile("s_waitcnt lgkmcnt(0)" ::: "memory"); __builtin_amdgcn_s_barrier(); asm volatile("" ::: "memory");
            const int tl = (wr * 4 + wc) * 64 + fq * 16 + fr;
            if (tl < 256) kmean[(size_t)((2 * (u.pn - 4) + (tl >> 7)) * 32 + u.pm) * 128 + (tl & 127)] = (KS[tl] + KS[256 + tl]) * (1.f / 256.f);
        } else if (u.pn < 16) {
#pragma unroll
            for (int ai = 0; ai < 2; ++ai)
#pragma unroll
                for (int m = 0; m < 4; ++m) { const unsigned rowb = (unsigned)((row0 + ai * HALF + m * 16) * ZP + col0) * 2u; const float rs = rstd_of(rsv[ai][m]);
#pragma unroll
                    for (int bj = 0; bj < 2; ++bj) { const f32x4 v0 = acc[ai][bj][m][0] * rs, v1 = acc[ai][bj][m][1] * rs;
                        u32x4 w; w.x = cvt_pk(v0[0], v0[1]); w.y = cvt_pk(v0[2], v0[3]); w.z = cvt_pk(v1[0], v1[1]); w.w = cvt_pk(v1[2], v1[3]);
                        wz.st(rowb + bj * HALF * 2, w); } }
        } else {
            const int gt = u.pn - 16;
            const unsigned lo = (unsigned)((wr * 4 + wc) * 8192 + (fq * 16 + fr) * 8);
            if (gt < 16) {
                const unsigned g0 = (unsigned)(((0 * 32 + u.pm) * 8 + (gt >> 1)) * 65536 + lo) * 2u; const WT wg1(GATE + (size_t)32 * 8 * 65536);
#pragma unroll
                for (int ai = 0; ai < 2; ++ai)
#pragma unroll
                    for (int m = 0; m < 4; ++m) { const float rs = rstd_of(rsv[ai][m]) * -1.4426950408889634f;
                        float r1[8], eb[8];
#pragma unroll
                        for (int n = 0; n < 2; ++n)
#pragma unroll
                            for (int i = 0; i < 4; ++i) { const float ea = __builtin_amdgcn_exp2f(__builtin_amdgcn_fmed3f(acc[ai][0][m][n][i] * rs, -43.28f, 43.28f)); eb[n * 4 + i] = __builtin_amdgcn_exp2f(__builtin_amdgcn_fmed3f(acc[ai][1][m][n][i] * rs, -43.28f, 43.28f));
                                const float sb = __builtin_amdgcn_rcpf(1.f + eb[n * 4 + i]); r1[n * 4 + i] = __builtin_amdgcn_rcpf(sb * (1.f + ea)); eb[n * 4 + i] = sb; }
                        const unsigned o = (unsigned)(((ai * 4 + m) * 2 + (gt & 1)) * 1024);
                        wg.st(g0 + o, __builtin_bit_cast(u32x4, pack8(r1))); wg1.st(g0 + o, __builtin_bit_cast(u32x4, pack8(eb))); }
            } else {
                const unsigned gb = (unsigned)(((2 * 32 + u.pm) * 8 + (gt - 16)) * 65536 + lo) * 2u;
#pragma unroll
                for (int ai = 0; ai < 2; ++ai)
#pragma unroll
                    for (int m = 0; m < 4; ++m) { const float rs = rstd_of(rsv[ai][m]) * -1.4426950408889634f;
#pragma unroll
                        for (int bj = 0; bj < 2; ++bj) { float g[8];
#pragma unroll
                            for (int i = 0; i < 4; ++i) { g[i] = 1.f + __builtin_amdgcn_exp2f(__builtin_amdgcn_fmed3f(acc[ai][bj][m][0][i] * rs, -43.28f, 43.28f)); g[4 + i] = 1.f + __builtin_amdgcn_exp2f(__builtin_amdgcn_fmed3f(acc[ai][bj][m][1][i] * rs, -43.28f, 43.28f)); }
                            wg.st(gb + (unsigned)(((ai * 4 + m) * 2 + bj) * 1024), __builtin_bit_cast(u32x4, pack8(g))); } }
            }
        }
    }
};
struct EpiMerge {
    static constexpr bool PERM = true, HAS_MID = true, HAS_PRE = false;
    const e16_t* GATE; e16_t* MG;
    __device__ __forceinline__ const e16_t* gptr(int b, const Unit& u, int wr, int wc, int fr, int fq) const { return GATE + ((size_t)((b * 32 + u.pm) * 8 + u.pn)) * 65536 + (wr * 4 + wc) * 8192 + (fq * 16 + fr) * 8; }
    __device__ __forceinline__ void mid(f32x4 (&acc)[2][2][4][2], const Unit& u, int t, int wr, int wc, int fr, int fq) const {
        const e16_t* np = gptr(t == 16 ? 0 : 1, u, wr, wc, fr, fq); const e16_t* dp = (t == 16) ? GATE + (WS_ONES - WS_GATE) / 2 + (wr * 4 + wc) * 8192 + (fq * 16 + fr) * 8 : gptr(2, u, wr, wc, fr, fq);
#pragma unroll
        for (int ai = 0; ai < 2; ++ai)
#pragma unroll
            for (int m = 0; m < 4; ++m) {
#pragma unroll
                for (int bj = 0; bj < 2; ++bj) { const int o = ((ai * 4 + m) * 2 + bj) * 512; const h8 nn = *(const h8*)(np + o), dd = *(const h8*)(dp + o);
#pragma unroll
                    for (int i = 0; i < 4; ++i) { acc[ai][bj][m][0][i] *= up16(dd[i]) * up16(nn[i]); acc[ai][bj][m][1][i] *= up16(dd[4 + i]) * up16(nn[4 + i]); } }
                if (m == 3) asm volatile("" ::: "memory"); }
    }
    __device__ __forceinline__ void operator()(const f32x4 (&acc)[2][2][4][2], const Unit& u, int wr, int wc, int fr, int fq) const {
        const int row0 = u.pm * BM + wr * 64 + fr, col0 = u.pn * BM + wc * 32 + 8 * fq; const e16_t* sp = gptr(2, u, wr, wc, fr, fq); const WT wm(MG);
        h8 sg[2][4][2];
#pragma unroll
        for (int ai = 0; ai < 2; ++ai)
#pragma unroll
            for (int m = 0; m < 4; ++m)
#pragma unroll
                for (int bj = 0; bj < 2; ++bj) sg[ai][m][bj] = *(const h8*)(sp + ((ai * 4 + m) * 2 + bj) * 512);
#pragma unroll
        for (int ai = 0; ai < 2; ++ai)
#pragma unroll
            for (int m = 0; m < 4; ++m) { const unsigned rowb = (unsigned)((row0 + ai * HALF + m * 16) * 2048 + col0) * 2u;
#pragma unroll
                for (int bj = 0; bj < 2; ++bj) { float v[8];
#pragma unroll
                    for (int i = 0; i < 4; ++i) { v[i] = acc[ai][bj][m][0][i] * __builtin_amdgcn_rcpf(up16(sg[ai][m][bj][i])); v[4 + i] = acc[ai][bj][m][1][i] * __builtin_amdgcn_rcpf(up16(sg[ai][m][bj][4 + i])); }
                    wm.st(rowb + bj * HALF * 2, __builtin_bit_cast(u32x4, pack8(v))); } }
    }
};

template <class Epi, class Sched, bool ALIGN_EPI = true, bool SP2 = true>
__device__ __forceinline__ void gemm_phase(LAS unsigned char* lds, const int tid, const Gemm g, const Sched& S, const Epi& E) {
    const int wid = __builtin_amdgcn_readfirstlane(tid >> 6), lane = tid & 63, wr = wid >> 2, wc = wid & 3, fr = lane & 15, fq = lane >> 4;
    const int K = g.K, nt = K / BK;
    unsigned voffA[2], voffB[2];
#pragma unroll
    for (int i = 0; i < 2; ++i) { int R, C; stage_rc(tid * 16 + i * 8192, R, C); const int Rb = Epi::PERM ? ((R & ~31) + perm32(R & 31)) : R;
        voffA[i] = (unsigned)(R * g.lda + C) * 2u; voffB[i] = (unsigned)(Rb * g.ldb + C) * 2u; }
    const size_t kstep = (size_t)(BK * 2);
    const size_t hstepA = (size_t)HALF * g.lda * 2, hstepB = (size_t)HALF * g.ldb * 2;
    const size_t tstepA = 2 * hstepA, tstepB = 2 * hstepB;
    const unsigned ldsw = (unsigned)wid * 1024u;
    const int aoff = lds_byte(wr * 64 + fr, fq * 8), boff = lds_byte(wc * 32 + fr, fq * 8);
#define PG8_SA(b, h) (((b) * 2 + (h)) * HTB)
#define PG8_SB(b, h) ((4 + (b) * 2 + (h)) * HTB)
#define PG8_STAGE(bufoff, gbase, voff) do { _Pragma("unroll") for (int _i = 0; _i < 2; ++_i) \
        __builtin_amdgcn_global_load_lds((const unsigned*)((const char*)(gbase) + (voff)[_i]), (LAS unsigned*)(lds + (bufoff) + ldsw + _i * 8192), 16, 0, 0); } while (0)
#define PG8_LDA(dst, b, h) do { _Pragma("unroll") for (int m = 0; m < 4; ++m) _Pragma("unroll") for (int k = 0; k < 2; ++k) dst[m][k] = *(const LAS h8*)(lds + PG8_SA(b, h) + aoff + m * 2048 + k * 1024); } while (0)
#define PG8_LDB(dst, b, h) do { _Pragma("unroll") for (int n = 0; n < 2; ++n) _Pragma("unroll") for (int k = 0; k < 2; ++k) dst[n][k] = *(const LAS h8*)(lds + PG8_SB(b, h) + boff + n * 2048 + k * 1024); } while (0)
#define PG8_MMA(ai, bj, At, Bt) do { __builtin_amdgcn_s_setprio(1); _Pragma("unroll") for (int m = 0; m < 4; ++m) _Pragma("unroll") for (int n = 0; n < 2; ++n) _Pragma("unroll") for (int k = 0; k < 2; ++k) \
        acc[ai][bj][m][n] = MFMA16(Bt[n][k], At[m][k], acc[ai][bj][m][n]); __builtin_amdgcn_s_setprio(0); } while (0)
#define PG8_WAIT_V(n) asm volatile("s_waitcnt vmcnt(" #n ")" ::: "memory")
#define PG8_WAIT_L(n) asm volatile("s_waitcnt lgkmcnt(" #n ")" ::: "memory")
#define PG8_BAR __builtin_amdgcn_s_barrier()
#define PG8_SCHED __builtin_amdgcn_sched_barrier(0)
    Unit cur, nxt; int ui = 0;
    if (!S.next(0, cur)) return;
    f32x4 acc[2][2][4][2];
#pragma unroll
    for (int a = 0; a < 2; ++a)
#pragma unroll
        for (int b = 0; b < 2; ++b)
#pragma unroll
            for (int m = 0; m < 4; ++m)
#pragma unroll
                for (int n = 0; n < 2; ++n) acc[a][b][m][n] = (f32x4){0.f, 0.f, 0.f, 0.f};
    h8 At[4][2], B0[2][2], B1[2][2];
    const char* cA = (const char*)g.A + (size_t)cur.pm * tstepA; const char* cB = (const char*)g.Bt + (size_t)cur.pn * tstepB;
    S.a_ready(cur);
    if constexpr (SP2) {
        PG8_STAGE(PG8_SB(0, 0), cB, voffB); PG8_STAGE(PG8_SB(0, 1), cB + hstepB, voffB); PG8_STAGE(PG8_SA(0, 0), cA, voffA); PG8_STAGE(PG8_SA(0, 1), cA + hstepA, voffA);
        if (wr == 1) PG8_BAR;
        PG8_WAIT_V(2); PG8_BAR;
        PG8_STAGE(PG8_SB(1, 0), cB + kstep, voffB); PG8_STAGE(PG8_SA(1, 0), cA + kstep, voffA); PG8_STAGE(PG8_SB(1, 1), cB + hstepB + kstep, voffB);
        PG8_WAIT_V(6); PG8_BAR;
    } else {
        PG8_STAGE(PG8_SB(0, 0), cB, voffB); PG8_STAGE(PG8_SA(0, 0), cA, voffA); PG8_STAGE(PG8_SB(0, 1), cB + hstepB, voffB); PG8_STAGE(PG8_SA(0, 1), cA + hstepA, voffA);
        if (wr == 1) PG8_BAR;
        PG8_WAIT_V(4); PG8_BAR;
        PG8_STAGE(PG8_SB(1, 0), cB + kstep, voffB); PG8_STAGE(PG8_SA(1, 0), cA + kstep, voffA); PG8_STAGE(PG8_SB(1, 1), cB + hstepB + kstep, voffB);
        PG8_WAIT_V(6); PG8_BAR;
    }
    for (;;) {
        const bool has_next = S.next(ui + 1, nxt);
        const char* nA = has_next ? (const char*)g.A + (size_t)nxt.pm * tstepA : cA; const char* nB = has_next ? (const char*)g.Bt + (size_t)nxt.pn * tstepB : cB;
        for (int t = 0; t < nt; t += 2) {
            const bool last = (t == nt - 2);
            const char* a1 = cA + (size_t)(t + 1) * kstep;
            const char* a2 = last ? nA : cA + (size_t)(t + 2) * kstep; const char* b2 = last ? nB : cB + (size_t)(t + 2) * kstep;
            const char* a3 = a2 + kstep; const char* b3 = b2 + kstep;
            if (last && has_next) S.a_ready(nxt);
            if constexpr (Epi::HAS_PRE) { if (last) __builtin_amdgcn_global_load_lds((const unsigned*)(E.rss + (size_t)cur.pm * BM) + tid, (LAS unsigned*)(lds + PRE_OFF + wid * 256), 4, 0, 0); }
            if constexpr (Epi::HAS_MID) { if (t == 16 || t == 32) E.mid(acc, cur, t, wr, wc, fr, fq); }
            if constexpr (SP2) {
            PG8_LDB(B0, 0, 0); PG8_LDB(B1, 0, 1); PG8_SCHED; PG8_LDA(At, 0, 0); PG8_STAGE(PG8_SA(1, 1), a1 + hstepA, voffA);
            PG8_WAIT_V(8); PG8_WAIT_L(0); PG8_BAR; PG8_MMA(0, 0, At, B0); PG8_MMA(0, 1, At, B1); PG8_BAR; PG8_SCHED;
            PG8_LDA(At, 0, 1); PG8_STAGE(PG8_SB(0, 0), b2, voffB); PG8_STAGE(PG8_SB(0, 1), b2 + hstepB, voffB); PG8_STAGE(PG8_SA(0, 0), a2, voffA);
            PG8_WAIT_V(8); PG8_WAIT_L(0); PG8_BAR; PG8_MMA(1, 0, At, B0); PG8_MMA(1, 1, At, B1); PG8_BAR; PG8_SCHED;
            PG8_LDB(B0, 1, 0); PG8_LDB(B1, 1, 1); PG8_SCHED; PG8_LDA(At, 1, 0); PG8_STAGE(PG8_SA(0, 1), a2 + hstepA, voffA);
            PG8_WAIT_V(8); PG8_WAIT_L(0); PG8_BAR; PG8_MMA(0, 0, At, B0); PG8_MMA(0, 1, At, B1); PG8_BAR; PG8_SCHED;
            PG8_LDA(At, 1, 1); PG8_STAGE(PG8_SB(1, 0), b3, voffB); PG8_STAGE(PG8_SB(1, 1), b3 + hstepB, voffB); PG8_STAGE(PG8_SA(1, 0), a3, voffA);
            PG8_WAIT_V(8); PG8_WAIT_L(0); PG8_BAR; PG8_MMA(1, 0, At, B0); PG8_MMA(1, 1, At, B1); PG8_BAR; PG8_SCHED;
            } else {
            PG8_LDB(B0, 0, 0); PG8_SCHED; PG8_LDA(At, 0, 0); PG8_STAGE(PG8_SA(1, 1), a1 + hstepA, voffA);
            PG8_WAIT_L(8); PG8_BAR; PG8_WAIT_L(0); PG8_MMA(0, 0, At, B0); PG8_BAR; PG8_SCHED;
            PG8_LDB(B1, 0, 1); PG8_STAGE(PG8_SB(0, 0), b2, voffB);
            PG8_BAR; PG8_WAIT_L(0); PG8_MMA(0, 1, At, B1); PG8_BAR;
            PG8_LDA(At, 0, 1); PG8_STAGE(PG8_SA(0, 0), a2, voffA);
            PG8_BAR; PG8_WAIT_L(0); PG8_MMA(1, 0, At, B0); PG8_BAR; PG8_SCHED;
            PG8_STAGE(PG8_SB(0, 1), b2 + hstepB, voffB);
            PG8_WAIT_V(6); PG8_BAR; PG8_MMA(1, 1, At, B1); PG8_BAR;
            PG8_LDB(B0, 1, 0); PG8_SCHED; PG8_LDA(At, 1, 0); PG8_STAGE(PG8_SA(0, 1), a2 + hstepA, voffA);
            PG8_WAIT_L(8); PG8_BAR; PG8_WAIT_L(0); PG8_MMA(0, 0, At, B0); PG8_BAR; PG8_SCHED;
            PG8_LDB(B1, 1, 1); PG8_STAGE(PG8_SB(1, 0), b3, voffB);
            PG8_BAR; PG8_WAIT_L(0); PG8_MMA(0, 1, At, B1); PG8_BAR;
            PG8_LDA(At, 1, 1); PG8_STAGE(PG8_SA(1, 0), a3, voffA);
            PG8_BAR; PG8_WAIT_L(0); PG8_MMA(1, 0, At, B0); PG8_BAR; PG8_SCHED;
            PG8_STAGE(PG8_SB(1, 1), b3 + hstepB, voffB);
            PG8_WAIT_V(6); PG8_BAR; PG8_MMA(1, 1, At, B1); PG8_BAR;
            }
        }
        if constexpr (ALIGN_EPI) { if (wr == 0) PG8_BAR; }
        E(acc, cur, wr, wc, fr, fq); S.done(cur);
        if (!has_next) break;
#pragma unroll
        for (int a = 0; a < 2; ++a)
#pragma unroll
            for (int b = 0; b < 2; ++b)
#pragma unroll
                for (int m = 0; m < 4; ++m)
#pragma unroll
                    for (int n = 0; n < 2; ++n) acc[a][b][m][n] = (f32x4){0.f, 0.f, 0.f, 0.f};
        cur = nxt; cA = nA; cB = nB; ++ui;
        if constexpr (ALIGN_EPI) { if (wr == 1) PG8_BAR; }
    }
    PG8_WAIT_V(0);
    if constexpr (!ALIGN_EPI) { if (wr == 0) PG8_BAR; }
    PG8_BAR;
#undef PG8_SA
#undef PG8_SB
#undef PG8_STAGE
#undef PG8_LDA
#undef PG8_LDB
#undef PG8_MMA
#undef PG8_WAIT_V
#undef PG8_WAIT_L
#undef PG8_BAR
#undef PG8_SCHED
}
}
using pg8::fx_t; using pg8::fx2f; using pg8::f2fx;

constexpr int NWAVES = 8, NTHREADS = 512;
constexpr int LDS_BYTES = 155648;
struct Args { const float* in[18]; float* out; unsigned char* ws; int ph_lo, ph_hi; };

struct Ctx {
    LAS unsigned char* lds; int tid, lane, wave, gw, NGW, G;
    float* out; unsigned char* ws;
    __device__ __forceinline__ e16_t* w16(size_t off) const { return (e16_t*)(ws + off); }
    __device__ __forceinline__ e16_t* wl(int l, size_t off) const { return (e16_t*)(ws + WS_W + (size_t)l * WL_SIZE + off); }
};

#define LDS_WAIT() asm volatile("s_waitcnt lgkmcnt(0)" ::: "memory")
__device__ __forceinline__ int map_win(int n) {
    if (n < 2048) return n;
    if (n < 3072) return 10240 + (n - 2048);
    if (n < 4096) return 2048 + (n - 3072);
    if (n < 5120) return 11264 + (n - 4096);
    if (n < 6144) return 3072 + (n - 5120);
    if (n < 8192) { const int c = n - 6144; return 4096 + (c >> 7) * 256 + (c & 127); }
    if (n < 10240) { const int c = n - 8192; return 4096 + (c >> 7) * 256 + 128 + (c & 127); }
    return n - 2048;
}
__device__ __forceinline__ int map_gu(int n) { return n < DFF ? 256 * (n >> 7) + (n & 127) : 256 * ((n - DFF) >> 7) + 128 + ((n - DFF) & 127); }
struct TD { const float* W; const float* g; e16_t* WT; int K, N, ldo, koff, map; };
__device__ __forceinline__ TD weight_td(const Args& a, const Ctx& C, int id) {
    const int l = id >> 3, m = id & 7; TD t; t.g = nullptr; t.koff = 0; t.map = 0;
    if (m == 0) { t.W = a.in[3] + (size_t)l * D_ * WINC; t.g = a.in[2] + l * D_; t.WT = C.wl(l, WL_IN); t.K = D_; t.N = WINC; t.ldo = D_; t.map = 1; }
    else if (m <= 3) { t.W = a.in[13] + (size_t)(l * 3 + m - 1) * 1024 * D_; t.WT = C.wl(l, WL_B); t.K = 1024; t.N = D_; t.ldo = 3072; t.koff = (m - 1) * 1024; }
    else if (m == 4) { t.W = a.in[14] + (size_t)l * D_ * D_; t.WT = C.wl(l, WL_O); t.K = D_; t.N = D_; t.ldo = D_; }
    else if (m == 5) { t.W = a.in[16] + (size_t)l * D_ * 2 * DFF; t.g = a.in[15] + l * D_; t.WT = C.wl(l, WL_GU); t.K = D_; t.N = 2 * DFF; t.ldo = D_; t.map = 2; }
    else if (m == 6) { t.W = a.in[17] + (size_t)l * DFF * D_; t.WT = C.wl(l, WL_D); t.K = DFF; t.N = D_; t.ldo = DFF; }
    else { t.W = a.in[12] + (size_t)l * D_ * D_; t.WT = C.wl(l, WL_M); t.K = D_; t.N = D_; t.ldo = D_; }
    return t;
}
__device__ __forceinline__ bool job_decode(int job, int i, int& id, int& it) {
    if (job == 0) { if (i < 12288) { id = 0; it = i; } else if (i < 14336) { id = 7; it = i - 12288; } else if (i < 16384) { id = 15; it = i - 14336; } else if (i < 19456) { id = 5; it = i - 16384 + 8192; }
                    else if (i < 22528) { id = 13; it = i - 19456 + 8192; } else return false; }
    else if (job == 4) { if (i < 8192) { id = 5; it = i; } else if (i < 12288) { id = 8; it = i; } else if (i < 20480) { id = 13; it = i - 12288; } else return false; }
    else if (job == 1) { if (i < 3072) { id = 1 + (i >> 10); it = i & 1023; } else if (i < 5120) { id = 4; it = i - 3072; } else if (i < 10752) { id = 6; it = i - 5120; }
                         else if (i < 13824) { id = 9 + ((i - 10752) >> 10); it = (i - 10752) & 1023; } else if (i < 15872) { id = 12; it = i - 13824; } else return false; }
    else if (job == 2) { if (i >= 8192) return false; id = 8; it = i; }
    else { if (i >= 5632) return false; id = 14; it = i; }
    return true;
}
__device__ __forceinline__ void convert_job(const Args& a, const Ctx& C, int job, int slot, int stride, int k_lo, int k_hi, LAS float* scr) {
    const int lane = C.lane, c = lane & 7;
    int k = k_lo, id, it;
    if (k >= k_hi || !job_decode(job, slot + k * stride, id, it)) return;
    TD t = weight_td(a, C, id); int nblk = t.N / 32;
    float r[32];
    { const int k0 = (it / nblk) * 64, n0 = (it % nblk) * 32;
#pragma unroll
      for (int i = 0; i < 32; ++i) r[i] = t.W[(size_t)(k0 + 2 * i + (lane >> 5)) * t.N + n0 + (lane & 31)]; }
#pragma unroll 1
    for (;;) {
        const int k0 = (it / nblk) * 64, n0 = (it % nblk) * 32; const int drow0 = t.map == 1 ? map_win(n0) : (t.map == 2 ? map_gu(n0) : n0);
        f32x4 ga = {1.f, 1.f, 1.f, 1.f}, gb = ga;
        if (t.g) { ga = *(const f32x4*)(t.g + k0 + 8 * c); gb = *(const f32x4*)(t.g + k0 + 8 * c + 4); }
        e16_t* wt = t.WT; const int ldo = t.ldo, koff = t.koff;
#pragma unroll
        for (int i = 0; i < 32; ++i) scr[(2 * i + (lane >> 5)) * 33 + (lane & 31)] = r[i];
        ++k; int id2, it2; const bool more = (k < k_hi) && job_decode(job, slot + k * stride, id2, it2);
        if (more) { t = weight_td(a, C, id2); nblk = t.N / 32; it = it2; const int k1 = (it / nblk) * 64, n1 = (it % nblk) * 32;
#pragma unroll
            for (int i = 0; i < 32; ++i) r[i] = t.W[(size_t)(k1 + 2 * i + (lane >> 5)) * t.N + n1 + (lane & 31)]; }
        LDS_WAIT(); asm volatile("" ::: "memory");
#pragma unroll
        for (int j = 0; j < 4; ++j) { const int n = (lane >> 3) + 8 * j; const LAS float* sp = scr + (8 * c) * 33 + n;
            u32x4 o; o.x = cvt_pk(sp[0 * 33] * ga[0], sp[1 * 33] * ga[1]); o.y = cvt_pk(sp[2 * 33] * ga[2], sp[3 * 33] * ga[3]); o.z = cvt_pk(sp[4 * 33] * gb[0], sp[5 * 33] * gb[1]); o.w = cvt_pk(sp[6 * 33] * gb[2], sp[7 * 33] * gb[3]);
            *(u32x4*)(wt + (size_t)(drow0 + n) * ldo + koff + k0 + 8 * c) = o; }
        LDS_WAIT(); asm volatile("" ::: "memory");
        if (!more) break;
    }
}
__device__ __forceinline__ void rms_rows(const Ctx& C, const float* X, const float* g, e16_t* O, int rows) {
    for (int m = C.gw; m < rows; m += C.NGW) {
        const f32x4* xr = (const f32x4*)(X + (size_t)m * D_) + C.lane; f32x4 v[8]; float s = 0.f;
#pragma unroll
        for (int j = 0; j < 8; ++j) { v[j] = xr[64 * j]; s += (v[j].x * v[j].x + v[j].y * v[j].y) + (v[j].z * v[j].z + v[j].w * v[j].w); }
        const float rstd = rsqrtf(wave_sum(s) * (1.f / D_) + EPS);
        const f32x4* gr = (const f32x4*)g + C.lane; u32x2* o8 = (u32x2*)(O + (size_t)m * D_) + C.lane;
#pragma unroll
        for (int j = 0; j < 8; ++j) { const f32x4 gg = gr[64 * j]; u32x2 w; w.x = cvt_pk(v[j].x * rstd * gg.x, v[j].y * rstd * gg.y); w.y = cvt_pk(v[j].z * rstd * gg.z, v[j].w * rstd * gg.w); o8[64 * j] = w; }
    }
}

__device__ __forceinline__ void xb_rows(const Ctx& C, const float* X, e16_t* O, fx_t* rss, int rows) {
    for (int m = C.gw; m < rows; m += C.NGW) {
        const f32x4* xr = (const f32x4*)(X + (size_t)m * D_) + C.lane; u32x2* o8 = (u32x2*)(O + (size_t)m * D_) + C.lane; f32x4 v[8]; float s = 0.f;
#pragma unroll
        for (int j = 0; j < 8; ++j) { v[j] = xr[64 * j]; s += (v[j].x * v[j].x + v[j].y * v[j].y) + (v[j].z * v[j].z + v[j].w * v[j].w); }
#pragma unroll
        for (int j = 0; j < 8; ++j) { u32x2 w; w.x = cvt_pk(v[j].x, v[j].y); w.y = cvt_pk(v[j].z, v[j].w); o8[64 * j] = w; }
        s = wave_sum(s); if (C.lane == 0) rss[m] = f2fx(s);
    }
}
__device__ __forceinline__ void kmnorm_phase(const Ctx& C, const float* gkm) {
    for (int it = C.gw; it < NLAYER * NMEM * HM; it += C.NGW) { const int l = it >> 10, m = (it >> 2) & 255, hm = it & 3;
        e16_t* p = C.w16(WS_KM) + (size_t)l * NMEM * 1024 + (size_t)m * 1024 + hm * DMH + 4 * C.lane; const h4 raw = *(const h4*)p;
        float v[4]; float ss = 0.f;
#pragma unroll
        for (int i = 0; i < 4; ++i) { v[i] = up16(raw[i]); ss += v[i] * v[i]; }
        const float rstd = rsqrtf(wave_sum(ss) * (1.f / DMH) + EPS); const float* g = gkm + l * DMH + 4 * C.lane;
        u32x2 w; w.x = cvt_pk(v[0] * rstd * g[0], v[1] * rstd * g[1]); w.y = cvt_pk(v[2] * rstd * g[2], v[3] * rstd * g[3]); *(u32x2*)p = w; }
}
__device__ __forceinline__ void gating_phase(const Ctx& C, int l, const float* gq, const float* gk) {
    const e16_t* Z = C.w16(WS_Z); const float* KMEAN = (const float*)(C.ws + WS_KMEAN); unsigned* LIST = (unsigned*)(C.ws + WS_LIST); unsigned* SEL = (unsigned*)(C.ws + WS_SEL);
    unsigned* CNT = (unsigned*)(C.ws + WS_CTL) + CW_CNT + l * 256;
    LAS float* km = (LAS float*)C.lds;
    LAS unsigned* lcnt = (LAS unsigned*)(C.lds + 16384); LAS unsigned* lbase = lcnt + 32;
    for (int it = blockIdx.x; it < HA * NBLK; it += C.G) { const int h = it >> 5, b = it & 31;
        for (int i = C.tid; i < NBLK * DA; i += NTHREADS) km[i] = KMEAN[(size_t)h * NBLK * DA + i];
        if (C.tid < 32) lcnt[C.tid] = 0u;
        if (C.tid < 64) { float a = fmaxf(fabsf(gq[C.tid]), fabsf(gq[C.tid + 64])), bb = fmaxf(fabsf(gk[C.tid]), fabsf(gk[C.tid + 64]));
#pragma unroll
            for (int o = 1; o < 64; o <<= 1) { a = fmaxf(a, __shfl_xor(a, o)); bb = fmaxf(bb, __shfl_xor(bb, o)); }
            if (C.tid == 0) ((LAS float*)lcnt)[96] = 2.f * (16.3222f * 1.02f * a * bb) + 150.f; }
        __syncthreads();
        const float thr = ((LAS float*)lcnt)[96], slope2 = __builtin_amdgcn_exp2f(-(float)(h + 1)) * LOG2E;
        const int q = b * 256 + (C.tid >> 1), half = C.tid & 1; const int nsel = b < 3 ? b : 3;
        int i0 = 0, i1 = 1, i2 = 2;
        if (b > 3) {
            float qv[64]; float ss = 0.f; const e16_t* zr = Z + (size_t)q * ZP + ZQ + h * DA + half * 64;
#pragma unroll
            for (int c8 = 0; c8 < 8; ++c8) { const h8 r = *(const h8*)(zr + 8 * c8);
#pragma unroll
                for (int j = 0; j < 8; ++j) { const float f = up16(r[j]); qv[c8 * 8 + j] = f; ss += f * f; } }
            ss += __shfl_xor(ss, 1);
            const float rstd = rsqrtf(ss * (1.f / DA) + EPS);
#pragma unroll
            for (int d = 0; d < 64; ++d) qv[d] = qv[d] * rstd * gq[half * 64 + d];
            float v0 = -__builtin_inff(), v1 = v0, v2 = v0;
            for (int j = 0; j < b; ++j) { const LAS f32x4* kr = (const LAS f32x4*)(km + j * DA + half * 64); float g0 = 0.f, g1 = 0.f;
#pragma unroll
                for (int d4 = 0; d4 < 16; d4 += 2) { const f32x4 ka = kr[d4], kb = kr[d4 + 1];
                    g0 += (qv[4 * d4] * ka.x + qv[4 * d4 + 1] * ka.y) + (qv[4 * d4 + 2] * ka.z + qv[4 * d4 + 3] * ka.w);
                    g1 += (qv[4 * d4 + 4] * kb.x + qv[4 * d4 + 5] * kb.y) + (qv[4 * d4 + 6] * kb.z + qv[4 * d4 + 7] * kb.w); }
                float gt = g0 + g1; gt += __shfl_xor(gt, 1);
                if (gt > v0) { v2 = v1; i2 = i1; v1 = v0; i1 = i0; v0 = gt; i0 = j; }
                else if (gt > v1) { v2 = v1; i2 = i1; v1 = gt; i1 = j; }
                else if (gt > v2) { v2 = gt; i2 = j; } }
        }
        const bool u0 = nsel > 0 && !(slope2 * (float)(256 * (b - i0 - 1) + 1) > thr), u1 = nsel > 1 && !(slope2 * (float)(256 * (b - i1 - 1) + 1) > thr), u2 = nsel > 2 && !(slope2 * (float)(256 * (b - i2 - 1) + 1) > thr);
        unsigned p0 = 0u, p1 = 0u, p2 = 0u;
        if (half == 0) { if (u0) p0 = atomicAdd((unsigned*)&lcnt[i0], 1u); if (u1) p1 = atomicAdd((unsigned*)&lcnt[i1], 1u); if (u2) p2 = atomicAdd((unsigned*)&lcnt[i2], 1u);
            SEL[(size_t)h * S_ + q] = (u0 ? 0u : 1u) | (u1 ? 0u : 2u) | (u2 ? 0u : 4u); }
        __syncthreads();
        if (C.tid < 32) { const unsigned n = lcnt[C.tid]; lbase[C.tid] = n ? atomicAdd(&CNT[h * 32 + C.tid], n) : 0u; }
        __syncthreads();
        if (half == 0) { unsigned* L = LIST + (size_t)h * 32 * 8192;
            if (u0) L[(size_t)i0 * 8192 + lbase[i0] + p0] = (unsigned)q;
            if (u1) L[(size_t)i1 * 8192 + lbase[i1] + p1] = (unsigned)q | (1u << 16);
            if (u2) L[(size_t)i2 * 8192 + lbase[i2] + p2] = (unsigned)q | (2u << 16); }
        __syncthreads();
    }
}

__device__ __forceinline__ void softmax_step(f32x16& p, float& m, float& l, f32x16 (&acc)[4], h8& pb0, h8& pb1) {
    float mx = p[0];
#pragma unroll
    for (int r = 1; r < 16; ++r) mx = fmaxf(mx, p[r]);
    mx = fmaxf(mx, __shfl_xor(mx, 32));
    if (__any(mx > m)) {
        const float mn = fmaxf(m, mx); const float alpha = __builtin_amdgcn_exp2f(m - mn); m = mn; l *= alpha;
#pragma unroll
        for (int db = 0; db < 4; ++db)
#pragma unroll
            for (int r = 0; r < 16; ++r) acc[db][r] *= alpha; }
    float ps = 0.f;
#pragma unroll
    for (int r = 0; r < 16; ++r) { p[r] = __builtin_amdgcn_exp2f(p[r] - m); ps += p[r]; }
    l += ps;
    float t[8];
#pragma unroll
    for (int r = 0; r < 8; ++r) t[r] = p[r];
    pb0 = pack8(t);
#pragma unroll
    for (int r = 0; r < 8; ++r) t[r] = p[8 + r];
    pb1 = pack8(t);
}
__device__ __forceinline__ void pv_step(f32x16 (&acc)[4], const e16_t* vt, int vp, int hi, h8 pb0, h8 pb1) {
#pragma unroll
    for (int db = 0; db < 4; ++db) { const e16_t* vr = vt + (size_t)db * 32 * vp + 4 * hi;
        { const h4 lo = *(const h4*)(vr), hh = *(const h4*)(vr + 8); const h8 a = {lo[0], lo[1], lo[2], lo[3], hh[0], hh[1], hh[2], hh[3]}; acc[db] = MFMA32(a, pb0, acc[db]); }
        { const h4 lo = *(const h4*)(vr + 16), hh = *(const h4*)(vr + 24); const h8 a = {lo[0], lo[1], lo[2], lo[3], hh[0], hh[1], hh[2], hh[3]}; acc[db] = MFMA32(a, pb1, acc[db]); } }
}
__device__ __forceinline__ float store_o(const f32x16 (&acc)[4], float l, e16_t* yrow, int hi, bool valid = true) {
    l += __shfl_xor(l, 32); const float inv = 1.0f / l; if (!valid) return l;
#pragma unroll
    for (int db = 0; db < 4; ++db)
#pragma unroll
        for (int g = 0; g < 4; ++g) { u32x2 w; w.x = cvt_pk(acc[db][4 * g] * inv, acc[db][4 * g + 1] * inv); w.y = cvt_pk(acc[db][4 * g + 2] * inv, acc[db][4 * g + 3] * inv);
            *(u32x2*)(yrow + db * 32 + g * 8 + hi * 4) = w; }
    return l;
}

constexpr int LV_OFF = 65536, LV_PITCH = 520;
constexpr int LDS_CTL = 135168;
static_assert(LV_OFF + 128 * LV_PITCH <= LDS_CTL, "LDS map");
static_assert(256 * LV_PITCH <= LDS_CTL, "LDS map (memory attention V^T image)");

__device__ __forceinline__ void moba_wg(const Ctx& C, const float* gqa, int h, int j, int t, int ntile, int slot, bool valid, unsigned* q, int& knx) {
    int tid = C.tid; asm volatile("" : "+v"(tid));
    const int c = tid & 31, hi = (tid >> 5) & 1;
    const e16_t* Z = C.w16(WS_Z); const e16_t* ZT = C.w16(WS_ZT);
    LAS unsigned char* LK = C.lds; LAS unsigned char* LV = C.lds + LV_OFF;
    const float slope2 = __builtin_amdgcn_exp2f(-(float)(h + 1)) * LOG2E;
    h8 qf[8];
    { const e16_t* kg = Z + (size_t)(j * 256) * ZP + ZK + h * DA; const e16_t* vg = ZT + (size_t)(h * DA) * ZTP + j * 256;
      const e16_t* zq = Z + (size_t)t * ZP + ZQ + h * DA + hi * 8; h8 raw[8], kr[8], vr[8];
#pragma unroll
      for (int i = 0; i < 8; ++i) { const int row = i * 32 + (tid >> 4), ch = tid & 15; kr[i] = *(const h8*)(kg + (size_t)row * ZP + ch * 8); }
#pragma unroll
      for (int i = 0; i < 8; ++i) { const int idx = i * 512 + tid, d = idx >> 5, cc = idx & 31; vr[i] = *(const h8*)(vg + (size_t)d * ZTP + cc * 8); }
#pragma unroll
      for (int ks = 0; ks < 8; ++ks) raw[ks] = *(const h8*)(zq + ks * 16);
      float ss = 0.f;
#pragma unroll
      for (int ks = 0; ks < 8; ++ks)
#pragma unroll
          for (int jj = 0; jj < 8; ++jj) { const float f = up16(raw[ks][jj]); ss += f * f; }
      ss += __shfl_xor(ss, 32);
      const float sc = rsqrtf(ss * (1.f / DA) + EPS) * 0.08838834764831845f * LOG2E; const float* gq = gqa + hi * 8;
#pragma unroll
      for (int ks = 0; ks < 8; ++ks) { const f32x4 g0 = *(const f32x4*)(gq + ks * 16), g1 = *(const f32x4*)(gq + ks * 16 + 4); float f[8];
#pragma unroll
          for (int jj = 0; jj < 4; ++jj) { f[jj] = up16(raw[ks][jj]) * sc * g0[jj]; f[4 + jj] = up16(raw[ks][4 + jj]) * sc * g1[jj]; }
          qf[ks] = pack8(f); }
#pragma unroll
      for (int i = 0; i < 8; ++i) { const int row = i * 32 + (tid >> 4), ch = tid & 15; *(LAS h8*)(LK + row * 256 + ((ch ^ (row & 15)) << 4)) = kr[i]; }
#pragma unroll
      for (int i = 0; i < 8; ++i) { const int idx = i * 512 + tid, d = idx >> 5, cc = idx & 31; LAS h4* p = (LAS h4*)(LV + d * LV_PITCH + cc * 16);
          p[0] = (h4){vr[i][0], vr[i][1], vr[i][2], vr[i][3]}; p[1] = (h4){vr[i][4], vr[i][5], vr[i][6], vr[i][7]}; } }
    __syncthreads();
    if (tid == 0) knx = (int)atomicAdd(q, 1u);
    float m = -1e30f, lsum = 0.f; f32x16 acc[4];
#pragma unroll
    for (int db = 0; db < 4; ++db)
#pragma unroll
        for (int r = 0; r < 16; ++r) acc[db][r] = 0.f;
    const float NEG = -__builtin_inff();
    float sc[16];
#pragma unroll
    for (int r = 0; r < 16; ++r) sc[r] = slope2 * (float)crow(r, hi);
    for (int kt = 0; kt < ntile; ++kt) { const int kb = j * 256 + kt * 32;
        f32x16 p; const float base = slope2 * (float)(kb - t);
#pragma unroll
        for (int r = 0; r < 16; ++r) p[r] = sc[r] + base;
        const LAS unsigned char* kp = LK + (kt * 32 + c) * 256;
        h8 ka[8];
#pragma unroll
        for (int ks = 0; ks < 8; ++ks) ka[ks] = *(const LAS h8*)(kp + (((2 * ks + hi) ^ (c & 15)) << 4));
        u32x2 va[16];
#pragma unroll
        for (int db = 0; db < 4; ++db) { const LAS unsigned char* vp = LV + (db * 32 + c) * LV_PITCH + (kt * 32 + 4 * hi) * 2;
#pragma unroll
            for (int e = 0; e < 4; ++e) va[db * 4 + e] = *(const LAS u32x2*)(vp + 16 * e); }
        __builtin_amdgcn_sched_barrier(0);
#pragma unroll
        for (int ks = 0; ks < 8; ++ks) p = MFMA32(ka[ks], qf[ks], p);
        if (slot == 3 && kt == ntile - 1) {
#pragma unroll
            for (int r = 0; r < 16; ++r) { const int kpos = kb + crow(r, hi); p[r] = (kpos <= t) ? p[r] : NEG; } }
        h8 pb0, pb1; softmax_step(p, m, lsum, acc, pb0, pb1);
#pragma unroll
        for (int db = 0; db < 4; ++db) { const u32x4 a0 = {va[db * 4][0], va[db * 4][1], va[db * 4 + 1][0], va[db * 4 + 1][1]}, a1 = {va[db * 4 + 2][0], va[db * 4 + 2][1], va[db * 4 + 3][0], va[db * 4 + 3][1]};
            acc[db] = MFMA32(a0, pb0, acc[db]); acc[db] = MFMA32(a1, pb1, acc[db]); } }
    __syncthreads();
    if (ntile > 0) { e16_t* PART = C.w16(WS_PART); f32x2* ML = (f32x2*)(C.ws + WS_ML);
        const float lt = store_o(acc, lsum, PART + ((size_t)slot * S_ + t) * 1024 + h * DA, hi, valid);
        if (valid && hi == 0) ML[(size_t)(slot * HA + h) * S_ + t] = (f32x2){m, lt}; }
}
__device__ __forceinline__ void mem_wg(const Ctx& C, int l, const float* gqm, const float* gkm, int hm, int qb, unsigned* q, int& knx) {
    int tid = C.tid; asm volatile("" : "+v"(tid));
    const int c = tid & 31, hi = (tid >> 5) & 1, t = qb * 256 + C.wave * 32 + c;
    const e16_t* Z = C.w16(WS_Z); e16_t* Y = C.w16(WS_Y);
    const e16_t* KM = C.w16(WS_KM) + (size_t)l * NMEM * 1024 + hm * DMH; const e16_t* VMT = C.w16(WS_VMT) + (size_t)l * 1024 * NMEM + (size_t)(hm * DMH) * NMEM;
    LAS unsigned char* LK = C.lds;
    h8 qf[16]; float sbound;
    { h8 kr[16], raw[16]; const e16_t* zq = Z + (size_t)t * ZP + ZQM + hm * DMH + hi * 8;
#pragma unroll
      for (int i = 0; i < 16; ++i) { const int row = i * 16 + (tid >> 5), ch = tid & 31; kr[i] = *(const h8*)(KM + (size_t)row * 1024 + ch * 8); }
#pragma unroll
      for (int ks = 0; ks < 16; ++ks) raw[ks] = *(const h8*)(zq + ks * 16);
      const f32x4 gqv = *(const f32x4*)(gqm + 4 * (tid & 63)), gkv = *(const f32x4*)(gkm + 4 * (tid & 63));
#pragma unroll
      for (int i = 0; i < 16; ++i) { const int row = i * 16 + (tid >> 5), ch = tid & 31; *(LAS h8*)(LK + row * 512 + ((ch ^ (row & 15)) << 4)) = kr[i]; }
      float ss = 0.f;
#pragma unroll
      for (int ks = 0; ks < 16; ++ks)
#pragma unroll
          for (int j = 0; j < 8; ++j) { const float f = up16(raw[ks][j]); ss += f * f; }
      ss += __shfl_xor(ss, 32);
      { float a = fmaxf(fmaxf(fabsf(gqv.x), fabsf(gqv.y)), fmaxf(fabsf(gqv.z), fabsf(gqv.w))), b = fmaxf(fmaxf(fabsf(gkv.x), fabsf(gkv.y)), fmaxf(fabsf(gkv.z), fabsf(gkv.w)));
#pragma unroll
        for (int o = 1; o < 64; o <<= 1) { a = fmaxf(a, __shfl_xor(a, o)); b = fmaxf(b, __shfl_xor(b, o)); }
        sbound = 23.083f * 1.02f * a * b; }
#pragma unroll
      for (int ks = 0; ks < 16; ++ks) asm volatile("" : "+v"(raw[ks]));
      const float sc = rsqrtf(ss * (1.f / DMH) + EPS) * 0.0625f * LOG2E; const float* gq = gqm + hi * 8;
#pragma unroll
      for (int ks = 0; ks < 16; ++ks) { const f32x4 g0 = *(const f32x4*)(gq + ks * 16), g1 = *(const f32x4*)(gq + ks * 16 + 4); float f[8];
#pragma unroll
          for (int j = 0; j < 4; ++j) { f[j] = up16(raw[ks][j]) * sc * g0[j]; f[4 + j] = up16(raw[ks][4 + j]) * sc * g1[j]; }
          qf[ks] = pack8(f); } }
    __syncthreads();
    if (tid == 0) knx = (int)atomicAdd(q, 1u);
    h8 pb[8][2]; float lsum = 0.f;
    { float mx = -1e30f;
      const bool need_max = __builtin_amdgcn_readfirstlane(sbound > 90.f ? 1 : 0) != 0;
      if (!need_max) mx = 0.f;
#pragma unroll 1
      for (int kt = 0; kt < (need_max ? 8 : 0); ++kt) { f32x16 p;
#pragma unroll
          for (int r = 0; r < 16; ++r) p[r] = 0.f;
          const LAS unsigned char* kp = LK + (kt * 32 + c) * 512;
#pragma unroll
          for (int k8 = 0; k8 < 16; k8 += 8) { h8 ka[8];
#pragma unroll
              for (int ks = 0; ks < 8; ++ks) ka[ks] = *(const LAS h8*)(kp + (((2 * (k8 + ks) + hi) ^ (c & 15)) << 4));
              __builtin_amdgcn_sched_barrier(0);
#pragma unroll
              for (int ks = 0; ks < 8; ++ks) p = MFMA32(ka[ks], qf[k8 + ks], p); }
#pragma unroll
          for (int r = 0; r < 16; ++r) mx = fmaxf(mx, p[r]); }
      mx = fmaxf(mx, __shfl_xor(mx, 32));
#pragma unroll
      for (int kt = 0; kt < 8; ++kt) { f32x16 p; float tv[8];
#pragma unroll
          for (int r = 0; r < 16; ++r) p[r] = 0.f;
          const LAS unsigned char* kp = LK + (kt * 32 + c) * 512;
#pragma unroll
          for (int k8 = 0; k8 < 16; k8 += 8) { h8 ka[8];
#pragma unroll
              for (int ks = 0; ks < 8; ++ks) ka[ks] = *(const LAS h8*)(kp + (((2 * (k8 + ks) + hi) ^ (c & 15)) << 4));
              __builtin_amdgcn_sched_barrier(0);
#pragma unroll
              for (int ks = 0; ks < 8; ++ks) p = MFMA32(ka[ks], qf[k8 + ks], p); }
#pragma unroll
          for (int r = 0; r < 16; ++r) { p[r] = __builtin_amdgcn_exp2f(p[r] - mx); lsum += p[r]; }
#pragma unroll
          for (int r = 0; r < 8; ++r) tv[r] = p[r];
          pb[kt][0] = pack8(tv);
#pragma unroll
          for (int r = 0; r < 8; ++r) tv[r] = p[8 + r];
          pb[kt][1] = pack8(tv); } }
    lsum += __shfl_xor(lsum, 32);
    const float inv = 1.0f / lsum;
    __syncthreads();
    LAS unsigned char* LV = C.lds;
    { h8 vr[16];
#pragma unroll
      for (int i = 0; i < 16; ++i) { const int idx = i * 512 + tid, d = idx >> 5, cc = idx & 31; vr[i] = *(const h8*)(VMT + (size_t)d * NMEM + cc * 8); }
#pragma unroll
      for (int i = 0; i < 16; ++i) { const int idx = i * 512 + tid, d = idx >> 5, cc = idx & 31; LAS h4* pp = (LAS h4*)(LV + d * LV_PITCH + cc * 16);
          pp[0] = (h4){vr[i][0], vr[i][1], vr[i][2], vr[i][3]}; pp[1] = (h4){vr[i][4], vr[i][5], vr[i][6], vr[i][7]}; }
      asm volatile("" ::: "memory"); }
    __syncthreads();
    e16_t* yrow = Y + (size_t)t * YP + 2048 + hm * DMH;
#pragma unroll 1
    for (int dh = 0; dh < 2; ++dh) { f32x16 acc[4];
#pragma unroll
        for (int db = 0; db < 4; ++db)
#pragma unroll
            for (int r = 0; r < 16; ++r) acc[db][r] = 0.f;
#pragma unroll
        for (int kt = 0; kt < 8; ++kt) { u32x2 va[16];
#pragma unroll
            for (int db = 0; db < 4; ++db) { const LAS unsigned char* vp = LV + ((dh * 4 + db) * 32 + c) * LV_PITCH + (kt * 32 + 4 * hi) * 2;
#pragma unroll
                for (int e = 0; e < 4; ++e) va[db * 4 + e] = *(const LAS u32x2*)(vp + 16 * e); }
            __builtin_amdgcn_sched_barrier(0);
#pragma unroll
            for (int db = 0; db < 4; ++db) { const u32x4 a0 = {va[db * 4][0], va[db * 4][1], va[db * 4 + 1][0], va[db * 4 + 1][1]}, a1 = {va[db * 4 + 2][0], va[db * 4 + 2][1], va[db * 4 + 3][0], va[db * 4 + 3][1]};
                acc[db] = MFMA32(a0, pb[kt][0], acc[db]); acc[db] = MFMA32(a1, pb[kt][1], acc[db]); } }
#pragma unroll
        for (int db = 0; db < 4; ++db)
#pragma unroll
            for (int g = 0; g < 4; ++g) { u32x2 w; w.x = cvt_pk(acc[db][4 * g] * inv, acc[db][4 * g + 1] * inv); w.y = cvt_pk(acc[db][4 * g + 2] * inv, acc[db][4 * g + 3] * inv);
                *(u32x2*)(yrow + dh * 128 + db * 32 + g * 8 + hi * 4) = w; } }
    __syncthreads();
}
__device__ __forceinline__ void attn_combine_phase(const Ctx& C) {
    const e16_t* PART = C.w16(WS_PART); const f32x2* ML = (const f32x2*)(C.ws + WS_ML); e16_t* Y = C.w16(WS_Y);
    const int hh = C.lane >> 3, d0 = hh * DA + 16 * (C.lane & 7);
    const unsigned* SEL = (const unsigned*)(C.ws + WS_SEL);
    for (int tb = C.gw; tb < S_; tb += 2 * C.NGW) {
        int tt[2]; unsigned on[2]; f32x2 ml[2][4]; h8 pa[2][4], pb[2][4];
#pragma unroll
        for (int r = 0; r < 2; ++r) { tt[r] = (tb + r * C.NGW < S_) ? tb + r * C.NGW : tb; const int np = (tt[r] >> 8) < 3 ? (tt[r] >> 8) : 3; const unsigned skip = SEL[(size_t)hh * S_ + tt[r]];
            on[r] = 8u | (((1u << np) - 1u) & ~skip); }
#pragma unroll
        for (int r = 0; r < 2; ++r)
#pragma unroll
            for (int sl = 0; sl < 4; ++sl) { const int se = ((on[r] >> sl) & 1u) ? sl : 3; ml[r][sl] = ML[(size_t)(se * HA + hh) * S_ + tt[r]];
                const e16_t* pr = PART + ((size_t)se * S_ + tt[r]) * 1024 + d0; pa[r][sl] = *(const h8*)pr; pb[r][sl] = *(const h8*)(pr + 8); }
#pragma unroll
        for (int r = 0; r < 2; ++r) { float M = -1e30f;
#pragma unroll
            for (int sl = 0; sl < 4; ++sl) if ((on[r] >> sl) & 1u) M = fmaxf(M, ml[r][sl].x);
            float w[4], W = 0.f;
#pragma unroll
            for (int sl = 0; sl < 4; ++sl) { w[sl] = ((on[r] >> sl) & 1u) ? ml[r][sl].y * __builtin_amdgcn_exp2f(ml[r][sl].x - M) : 0.f; W += w[sl]; }
            const float iw = 1.0f / W; float o[16];
#pragma unroll
            for (int i = 0; i < 16; ++i) o[i] = 0.f;
#pragma unroll
            for (int sl = 0; sl < 4; ++sl) { const float ws = w[sl] * iw;
#pragma unroll
                for (int i = 0; i < 8; ++i) { o[i] += ws * up16(pa[r][sl][i]); o[8 + i] += ws * up16(pb[r][sl][i]); } }
            if (r == 0 || tb + C.NGW < S_) { *(h8*)(Y + (size_t)tt[r] * YP + d0) = pack8(o); *(h8*)(Y + (size_t)tt[r] * YP + d0 + 8) = pack8(o + 8); } }
    }
}
__device__ __forceinline__ void sgu_item(const Ctx& C, const float* wsgu, const float* bsgu, const float* gsgu, int n, int g, int w, unsigned* q, int& knx) {
    int ln = C.lane; asm volatile("" : "+v"(ln));
    const int c = ln & 31, hi = ln >> 5, tt = w & 3, cp = w >> 2, tl = 32 * tt + c, t = 128 * n + tl;
    const e16_t* Z = C.w16(WS_Z); const e16_t* ZT = C.w16(WS_ZT); e16_t* Y = C.w16(WS_Y); const float* RSTDV = (const float*)(C.ws + WS_RSTDV);
    const float* wrow = wsgu + ((size_t)g * 128 + tl) * 128;
    f32x16 a0, a1;
#pragma unroll
    for (int r = 0; r < 16; ++r) { a0[r] = 0.f; a1[r] = 0.f; }
    const e16_t* gv0 = ZT + (size_t)(1024 + g * 128 + (2 * cp) * 32 + c) * ZTP + 128 * n + 8 * hi; const e16_t* gv1 = gv0 + (size_t)32 * ZTP;
#pragma unroll
    for (int kh = 0; kh < 2; ++kh) {
        if (kh == 1 && tt < 2) break;
        f32x4 wv[4][2], rv[4][2]; h8 xv[4][2];
#pragma unroll
        for (int k4 = 0; k4 < 4; ++k4) { const int s0 = 16 * (kh * 4 + k4) + 8 * hi;
            wv[k4][0] = *(const f32x4*)(wrow + s0); wv[k4][1] = *(const f32x4*)(wrow + s0 + 4);
            rv[k4][0] = *(const f32x4*)(RSTDV + 128 * n + s0); rv[k4][1] = *(const f32x4*)(RSTDV + 128 * n + s0 + 4);
            xv[k4][0] = *(const h8*)(gv0 + (kh * 4 + k4) * 16); xv[k4][1] = *(const h8*)(gv1 + (kh * 4 + k4) * 16); }
#pragma unroll
        for (int k4 = 0; k4 < 4; ++k4) { const int s0 = 16 * (kh * 4 + k4) + 8 * hi; float f[8];
#pragma unroll
            for (int j = 0; j < 4; ++j) { f[j] = (s0 + j <= tl) ? wv[k4][0][j] * rv[k4][0][j] : 0.f; f[4 + j] = (s0 + 4 + j <= tl) ? wv[k4][1][j] * rv[k4][1][j] : 0.f; }
            const h8 bf = pack8(f); a0 = MFMA32(xv[k4][0], bf, a0); a1 = MFMA32(xv[k4][1], bf, a1); } }
    const float bias = bsgu[g * 128 + tl]; const float* gs = gsgu;
    h4 urv[2][4]; f32x4 ggv[2][4];
#pragma unroll
    for (int cbi = 0; cbi < 2; ++cbi)
#pragma unroll
        for (int gq = 0; gq < 4; ++gq) { const int col = g * 128 + (2 * cp + cbi) * 32 + 8 * gq + 4 * hi; urv[cbi][gq] = *(const h4*)(Z + (size_t)t * ZP + ZU + col); ggv[cbi][gq] = *(const f32x4*)(gs + col); }
    if (w == 0 && ln == 0) knx = (int)atomicAdd(q, 1u);
#pragma unroll
    for (int cbi = 0; cbi < 2; ++cbi)
#pragma unroll
        for (int gq = 0; gq < 4; ++gq) { const int col = g * 128 + (2 * cp + cbi) * 32 + 8 * gq + 4 * hi; const h4 ur = urv[cbi][gq]; const f32x4 gg = ggv[cbi][gq]; float o[4];
#pragma unroll
            for (int i = 0; i < 4; ++i) { const float mix = gg[i] * (cbi == 0 ? a0[4 * gq + i] : a1[4 * gq + i]) + bias; o[i] = gelu_tanh(up16(ur[i])) * mix; }
            u32x2 wv; wv.x = cvt_pk(o[0], o[1]); wv.y = cvt_pk(o[2], o[3]); *(u32x2*)(Y + (size_t)t * YP + 1024 + col) = wv; }
}
#define XB_TMO      128
#define XB_XCNT(j)  (256  + 64 * (j))
#define XB_XSUB(j)  (1280 + 64 * (j))
#define XB_XGEN(j)  (2304 + 64 * (j))
#define XB_TOP      3328
#define XB_TOPGEN   3392
#define XCD_BAR_WORDS 3456
#define XB_SPIN_CAP (1u << 18)
constexpr int CW_BAR = 4096;
__device__ __forceinline__ unsigned xb_ld(unsigned* p)              { return __hip_atomic_load(p, __ATOMIC_RELAXED, __HIP_MEMORY_SCOPE_AGENT); }
__device__ __forceinline__ unsigned xb_add(unsigned* p, unsigned v) { return __hip_atomic_fetch_add(p, v, __ATOMIC_RELAXED, __HIP_MEMORY_SCOPE_AGENT); }
__device__ __forceinline__ unsigned xb_xcc_id() { return (unsigned)__builtin_amdgcn_s_getreg((3 << 11) | 20) & 0xFu; }
#define XB_SPIN(cond, bar) do { unsigned _sp = 0; while (cond) { __builtin_amdgcn_s_sleep(1); \
    if ((++_sp & 255u) == 0u) { if (xb_ld(&(bar)[XB_TMO])) break; if (_sp > XB_SPIN_CAP) { atomicAdd(&(bar)[XB_TMO], 1u); break; } } } } while (0)
struct XcdBarrier { unsigned* bar; unsigned x; volatile LAS unsigned* st; };
__device__ __forceinline__ XcdBarrier xcd_barrier_post(unsigned* bar, volatile LAS unsigned* st) {
    XcdBarrier b; b.bar = bar; b.x = xb_xcc_id(); b.st = st;
    if (threadIdx.x == 0) (void)xb_add(&bar[XB_XCNT(b.x)], 1u);
    return b;
}
__device__ __forceinline__ void xcd_barrier_complete(unsigned* bar, unsigned x, unsigned& nloc, unsigned& nx) {
    const unsigned G = gridDim.x * gridDim.y * gridDim.z;
    unsigned sum, cnt, mine, sp = 0u;
    for (;;) {
        sum = 0u; cnt = 0u; mine = 0u;
#pragma unroll
        for (unsigned j = 0; j < 16; ++j) { const unsigned c = xb_ld(&bar[XB_XCNT(j)]); sum += c; cnt += (c > 0u) ? 1u : 0u; mine = (j == x) ? c : mine; }
        if (sum == G) break;
        __builtin_amdgcn_s_sleep(1);
        if ((++sp & 255u) == 0u) { if (xb_ld(&bar[XB_TMO])) break; if (sp > XB_SPIN_CAP) { atomicAdd(&bar[XB_TMO], 1u); break; } }
    }
    nloc = mine > 0u ? mine : 1u; nx = cnt > 0u ? cnt : 1u;
}
__device__ __forceinline__ void xcd_barrier(const XcdBarrier& b) {
    asm volatile("s_waitcnt vmcnt(0)" ::: "memory");
    __syncthreads();
    if (threadIdx.x == 0) {
        unsigned* bar = b.bar; asm volatile("" : "+s"(bar));
        __builtin_amdgcn_s_waitcnt(0);
        unsigned nloc = b.st[0], nx = b.st[1];
        if (nloc == 0u) { xcd_barrier_complete(bar, b.x, nloc, nx); b.st[0] = nloc; b.st[1] = nx; }
        const unsigned old = xb_add(&bar[XB_XSUB(b.x)], 1u);
        const unsigned gen = old / nloc;
        if (old + 1u == (gen + 1u) * nloc) {
            __builtin_amdgcn_fence(__ATOMIC_RELEASE, "agent");
            asm volatile("s_waitcnt vmcnt(0)" ::: "memory");
            const unsigned og = xb_add(&bar[XB_TOP], 1u);
            const unsigned tg = og / nx;
            if (og + 1u == (tg + 1u) * nx) xb_add(&bar[XB_TOPGEN], 1u);
            else XB_SPIN(xb_ld(&bar[XB_TOPGEN]) == tg, bar);
            __builtin_amdgcn_fence(__ATOMIC_ACQUIRE, "agent");
            xb_add(&bar[XB_XGEN(b.x)], 1u);
            asm volatile("s_waitcnt vmcnt(0)" ::: "memory");
        } else {
            XB_SPIN(xb_ld(&bar[XB_XGEN(b.x)]) == gen, bar);
            __builtin_amdgcn_fence(__ATOMIC_ACQUIRE, "agent");
            asm volatile("s_waitcnt vmcnt(0)" ::: "memory");
        }
    }
    __syncthreads();
}

constexpr int CW_SEAM = 16384;
constexpr int CW_SPLIT = 12288;
struct SplitBar { unsigned* ctr; unsigned* bar; unsigned x; volatile LAS unsigned* st; };
__device__ __forceinline__ void split_arrive(const SplitBar& b) {
    asm volatile("s_waitcnt vmcnt(0)" ::: "memory");
    __syncthreads();
    if (threadIdx.x == 0) { unsigned nloc = b.st[0];
        if (nloc == 0u) { unsigned nx; __builtin_amdgcn_s_waitcnt(0); xcd_barrier_complete(b.bar, b.x, nloc, nx); b.st[0] = nloc; b.st[1] = nx; }
        const unsigned old = xb_add(b.ctr + 32 * b.x, 1u);
        if (old + 1u == nloc) { __builtin_amdgcn_fence(__ATOMIC_RELEASE, "agent"); asm volatile("s_waitcnt vmcnt(0)" ::: "memory"); (void)xb_add(b.ctr + 32 * 16, nloc); } }
}
__device__ __forceinline__ void split_wait(const SplitBar& b) {
    if (threadIdx.x == 0) { const unsigned G = gridDim.x; XB_SPIN(xb_ld(b.ctr + 32 * 16) != G, b.bar); __builtin_amdgcn_fence(__ATOMIC_ACQUIRE, "agent"); asm volatile("s_waitcnt vmcnt(0)" ::: "memory"); }
    __syncthreads();
}
struct MixP { const float *gqa, *gqm, *gkm, *wsgu, *bsgu, *gsgu; };
__device__ __forceinline__ void mixer_phase(const Ctx& C, int l, const MixP& P, const XcdBarrier& xb) {
    unsigned* ctl = (unsigned*)(C.ws + WS_CTL);
    const SplitBar b1{ctl + CW_SPLIT + 544 * (2 * l), ctl + CW_BAR, xb.x, xb.st}, b2{ctl + CW_SPLIT + 544 * (2 * l + 1), ctl + CW_BAR, xb.x, xb.st};
    const unsigned* CNT = (const unsigned*)(C.ws + WS_CTL) + CW_CNT + l * 256; const unsigned* LIST = (const unsigned*)(C.ws + WS_LIST);
    LAS unsigned* pre = (LAS unsigned*)(C.lds + LDS_CTL + 256);
    LAS unsigned* nch = pre + 256; LAS int* bc = (LAS int*)(C.lds + LDS_CTL + 64); LAS unsigned* cntl = (LAS unsigned*)(C.lds + LDS_CTL + 2816);
    const int myq = (int)(__builtin_amdgcn_s_getreg((3 << 11) | 20) & 7u);
    constexpr int N_OWNWG = HA * NBLK, N_MEMWG = HM * NBLK, N_SGUWG = 64 * 8;
    split_arrive(b1);
    int npast = 0;
#pragma unroll 1
    for (int st = 0; st < 3; ++st) {
        int kfirst = 0; if (C.tid == 0) kfirst = (int)atomicAdd(ctl + 8192 + 64 * ((l * 3 + st) * 8) + 64 * myq, 1u);
        if (st == 1) { split_wait(b1);
            int tq = C.tid; asm volatile("" : "+v"(tq));
            if (tq < 256) { const unsigned cn = CNT[tq]; cntl[tq] = cn; nch[tq] = (cn + 255u) >> 8; }
            __syncthreads();
            if (tq < 256) { unsigned sum = 0u; for (int k = 0; k < 256; ++k) { const unsigned v = nch[k]; sum += (k <= tq) ? v : 0u; } pre[tq] = sum; }
            __syncthreads();
            npast = (int)pre[255]; }
        if (st == 2) split_arrive(b2);
        unsigned* qbase = ctl + 8192 + 64 * ((l * 3 + st) * 8);
        const int nA = st == 0 ? N_OWNWG : (st == 1 ? N_MEMWG : N_SGUWG), nB = st == 1 ? npast : 0;
#define QTOT(x_) (((nA * ((x_) + 1)) >> 3) - ((nA * (x_)) >> 3) + (int)(((long)nB * ((x_) + 1)) >> 3) - (int)(((long)nB * (x_)) >> 3))
        int x = myq;
        for (;;) { unsigned* q = qbase + 64 * x;
            const int a_lo = (nA * x) >> 3, a_n = ((nA * (x + 1)) >> 3) - a_lo;
            const int p_lo = (int)(((long)nB * x) >> 3), p_n = (int)(((long)nB * (x + 1)) >> 3) - p_lo;
            const int ntot = a_n + p_n;
            int knx = kfirst; if (C.tid == 0 && x != myq) knx = (int)atomicAdd(q, 1u);
            for (;;) { if (C.tid == 0) bc[0] = knx;
                __syncthreads(); int k = bc[0]; __syncthreads();
                if (k >= ntot) break;
                if (st == 2) { const int jj = a_lo + k; sgu_item(C, P.wsgu, P.bsgu, P.gsgu, jj >> 3, jj & 7, C.wave, q, knx); continue; }
                if (st == 1 && k < a_n) { const int jj = a_lo + k; mem_wg(C, l, P.gqm, P.gkm, jj >> 5, jj & 31, q, knx); continue; }
                int h_, j_, t_, nt_, sl_; bool va_;
                if (st == 1) { const int it = p_lo + (k - a_n);
                    int lo = 0, hi2 = 255;
                    while (lo < hi2) { const int mid = (lo + hi2) >> 1; if ((int)pre[mid] > it) hi2 = mid; else lo = mid + 1; }
                    const int hj = __builtin_amdgcn_readfirstlane(lo), chunk = it - (hj ? (int)pre[hj - 1] : 0), n = (int)cntl[hj];
                    const int e0 = chunk * 256 + C.wave * 32, e = e0 + (C.lane & 31); va_ = e < n;
                    const unsigned ent = LIST[(size_t)hj * 8192 + (va_ ? e : chunk * 256)];
                    h_ = hj >> 5; j_ = hj & 31; t_ = (int)(ent & 0xffffu); nt_ = e0 < n ? 8 : 0; sl_ = (int)(ent >> 16);
                } else { const int jj = a_lo + k;
                    const int qt = C.wave < 4 ? C.wave : 11 - C.wave;
                    h_ = jj >> 5; j_ = 31 - (jj & 31); t_ = j_ * 256 + qt * 32 + (C.lane & 31); nt_ = qt + 1; sl_ = 3; va_ = true; }
                moba_wg(C, P.gqa, h_, j_, t_, nt_, sl_, va_, q, knx); }
            if (C.tid == 0) { unsigned cv[8];
#pragma unroll
                for (int y = 0; y < 8; ++y) cv[y] = __hip_atomic_load(qbase + 64 * y, __ATOMIC_RELAXED, __HIP_MEMORY_SCOPE_AGENT);
                int nxq = -1;
#pragma unroll
                for (int sq = 7; sq >= 1; --sq) { const int y = (myq + sq) & 7; if ((int)cv[y] < QTOT(y)) nxq = y; }
                bc[1] = nxq; }
            __syncthreads(); x = bc[1]; __syncthreads();
            if (x < 0) break;
        }
#undef QTOT
    }
    split_wait(b2);
}

#define INP(k) ((const float*)(((unsigned long long)(unsigned)__builtin_amdgcn_readfirstlane((int)((volatile LAS unsigned*)(C.lds + LDS_CTL + 2560))[2 * (k) + 1]) << 32) | (unsigned long long)(unsigned)__builtin_amdgcn_readfirstlane((int)((volatile LAS unsigned*)(C.lds + LDS_CTL + 2560))[2 * (k)])))
__global__ void __launch_bounds__(NTHREADS, 2) fwd_kernel(Args args) {
    extern __shared__ __attribute__((aligned(16))) unsigned char lds_raw[];
    cg::grid_group grid = cg::this_grid();
    Ctx C; C.lds = (LAS unsigned char*)lds_raw; C.tid = threadIdx.x; C.lane = C.tid & 63; C.wave = __builtin_amdgcn_readfirstlane(C.tid >> 6);
    C.G = gridDim.x; C.gw = blockIdx.x * NWAVES + C.wave; C.NGW = C.G * NWAVES;
    C.out = args.out; C.ws = args.ws;
    const int lo = args.ph_lo, hi = args.ph_hi;
    const int wave0 = __builtin_amdgcn_readfirstlane(threadIdx.x >> 6);
    volatile LAS unsigned* bst = (volatile LAS unsigned*)(C.lds + LDS_CTL);
    if (threadIdx.x < 2) bst[threadIdx.x] = 0u;
    if (threadIdx.x < 18) ((LAS unsigned long long*)(C.lds + LDS_CTL + 2560))[threadIdx.x] = (unsigned long long)args.in[threadIdx.x];
    __syncthreads();
    const XcdBarrier xbar = xcd_barrier_post((unsigned*)(args.ws + WS_CTL) + CW_BAR, bst);
    LAS unsigned char* ring = C.lds;
#pragma unroll 1
    for (int ph = lo; ph < hi; ++ph) {
#define REFRESH_TID do { int w0_ = wave0; asm volatile("" : "+s"(w0_)); int tid_ = w0_ * 64 + (int)__builtin_amdgcn_mbcnt_hi(~0u, __builtin_amdgcn_mbcnt_lo(~0u, 0u)); asm volatile("" : "+v"(tid_)); C.tid = tid_; C.lane = tid_ & 63; C.wave = w0_; } while (0)
        REFRESH_TID;
        int bx = blockIdx.x; asm volatile("" : "+s"(bx)); C.gw = bx * NWAVES + C.wave; size_t zo_ = 0; asm volatile("" : "+s"(zo_)); C.ws = args.ws + zo_; C.out = args.out + zo_;
        int l = ph == 0 ? 0 : (ph - 1) / 6, kp = ph == 0 ? -1 : (ph - 1) % 6; asm volatile("" : "+s"(l), "+s"(kp));
        int cj = -1, cslot = 0, cstride = 1;
        if (kp < 0) {
            for (int pl = 0; pl < NLAYER; ++pl) rms_rows(C, INP(1), INP(11) + pl * D_, C.w16(WS_MEMN) + (size_t)pl * NMEM * D_, NMEM);
            { fx_t* RSS = (fx_t*)(C.ws + WS_RSS); xb_rows(C, INP(0), C.w16(WS_HN), RSS, S_);
              for (int i = bx * NTHREADS + C.tid; i < 3 * S_; i += C.G * NTHREADS) RSS[S_ + i] = 0ull;
              fx_t* RSSV = (fx_t*)(C.ws + WS_RSSV); for (int i = bx * NTHREADS + C.tid; i < S_; i += C.G * NTHREADS) RSSV[i] = 0ull;
              unsigned* ONES = (unsigned*)(C.ws + WS_ONES);
_Pragma("unroll 1")
              for (int b = bx; b < 64; b += C.G) ONES[b * NTHREADS + C.tid] = 0x3F803F80u; }
            cj = 0; cslot = C.gw; cstride = C.NGW;
        } else if (kp == 0) {
            { pg8::Gemm g{C.w16(WS_HN), C.wl(l, WL_IN), S_, ZN, D_, D_, D_}; pg8::StaticOrder S; S.init(S_, ZN, C.G, bx); pg8::EpiZ E{C.w16(WS_Z), C.w16(WS_GATE), (const pg8::fx_t*)(C.ws + WS_RSS) + (size_t)(2 * l) * S_, C.lds, INP(5) + l * DA, (float*)(C.ws + WS_KMEAN)};
              pg8::gemm_phase<pg8::EpiZ, pg8::StaticOrder>(ring, C.tid, g, S, E); }
            REFRESH_TID;
            { pg8::Gemm g{C.wl(l, WL_IN) + (size_t)ZN * D_, C.w16(WS_HN), 2048, S_, D_, D_, D_}; pg8::StaticOrder S; S.init(2048, S_, C.G, bx); pg8::EpiStore16 E{C.w16(WS_ZT), ZTP, (const pg8::fx_t*)(C.ws + WS_RSS) + (size_t)(2 * l) * S_, 2, (pg8::fx_t*)(C.ws + WS_RSSV)};
              pg8::gemm_phase<pg8::EpiStore16, pg8::StaticOrder>(ring, C.tid, g, S, E); }
            if (l == 0) for (int ll = 0; ll < NLAYER; ++ll) {
                REFRESH_TID;
                { pg8::Gemm g{C.w16(WS_MEMN) + (size_t)ll * NMEM * D_, C.wl(ll, WL_M), NMEM, 1024, D_, D_, D_}; pg8::StaticOrder S; S.init(NMEM, 1024, C.G, (bx + C.G - 8 * ll) % C.G);
                  pg8::EpiStore16 E{C.w16(WS_KM) + (size_t)ll * NMEM * 1024, 1024, nullptr, 0, nullptr}; pg8::gemm_phase<pg8::EpiStore16, pg8::StaticOrder>(ring, C.tid, g, S, E); }
                REFRESH_TID;
                { pg8::Gemm g{C.wl(ll, WL_M) + (size_t)1024 * D_, C.w16(WS_MEMN) + (size_t)ll * NMEM * D_, 1024, NMEM, D_, D_, D_}; pg8::StaticOrder S; S.init(1024, NMEM, C.G, (bx + C.G - 8 * ll - 4) % C.G);
                  pg8::EpiStore16 E{C.w16(WS_VMT) + (size_t)ll * 1024 * NMEM, NMEM, nullptr, 0, nullptr}; pg8::gemm_phase<pg8::EpiStore16, pg8::StaticOrder>(ring, C.tid, g, S, E); } }
            if (l == 0 && bx >= 16) { cj = 1; cslot = (bx - 16) * NWAVES + C.wave; cstride = (C.G - 16) * NWAVES; }
        } else if (kp == 1) {
            if (l == 0) kmnorm_phase(C, INP(10));
            { const fx_t* RSSV = (const fx_t*)(C.ws + WS_RSSV); float* RSTDV = (float*)(C.ws + WS_RSTDV); for (int i = bx * NTHREADS + C.tid; i < S_; i += C.G * NTHREADS) RSTDV[i] = rsqrtf(fx2f(RSSV[i]) * (1.f / 1024.f) + EPS); }
            gating_phase(C, l, INP(4) + l * DA, INP(5) + l * DA);
            { MixP P{INP(4) + l * DA, INP(9) + l * DMH, INP(10) + l * DMH, INP(7) + (size_t)l * 8 * 128 * 128, INP(8) + l * 8 * 128, INP(6) + l * 1024}; mixer_phase(C, l, P, xbar); }
            attn_combine_phase(C);
        } else if (kp == 2) {
            { pg8::Gemm g{C.w16(WS_Y), C.wl(l, WL_B), S_, D_, 3072, YP, 3072}; pg8::StaticOrder S; S.init(S_, D_, C.G, bx); pg8::EpiMerge E{C.w16(WS_GATE), C.w16(WS_MG)};
              pg8::gemm_phase<pg8::EpiMerge, pg8::StaticOrder>(ring, C.tid, g, S, E); }
        } else if (kp == 3) {
            { pg8::Gemm g{C.w16(WS_MG), C.wl(l, WL_O), S_, D_, D_, D_, D_}; pg8::StaticOrder S; S.init(S_, D_, C.G, bx); pg8::EpiRes E{INP(0), l == 0 ? (const e16_t*)nullptr : (const e16_t*)C.w16(WS_HN), nullptr, C.w16(WS_HN), (pg8::fx_t*)(C.ws + WS_RSS) + (size_t)(2 * l + 1) * S_, D_};
              pg8::gemm_phase<pg8::EpiRes, pg8::StaticOrder>(ring, C.tid, g, S, E); }
        } else if (kp == 4) {
            { pg8::Gemm g{C.w16(WS_HN), C.wl(l, WL_GU), S_, 2 * DFF, D_, D_, D_}; pg8::StaticOrder S; S.init(S_, 2 * DFF, C.G, bx); pg8::EpiSwiGLU E{C.w16(WS_GATE), DFF, (const pg8::fx_t*)(C.ws + WS_RSS) + (size_t)(2 * l + 1) * S_, C.lds};
              pg8::gemm_phase<pg8::EpiSwiGLU, pg8::StaticOrder>(ring, C.tid, g, S, E); }
            if (bx >= C.G / 2) { cj = 2 + l; cslot = (bx - C.G / 2) * NWAVES + C.wave; cstride = (C.G / 2) * NWAVES; }
        } else {
            if (bx == 0 && l + 1 < NLAYER) { fx_t* RSSV = (fx_t*)(C.ws + WS_RSSV); for (int i = C.tid; i < S_; i += NTHREADS) RSSV[i] = 0ull; }
            { pg8::Gemm g{C.w16(WS_GATE), C.wl(l, WL_D), S_, D_, DFF, DFF, DFF}; pg8::StaticOrder S; S.init(S_, D_, C.G, bx); pg8::EpiRes E{nullptr, C.w16(WS_HN), l + 1 < NLAYER ? (float*)nullptr : C.out, l + 1 < NLAYER ? C.w16(WS_HN) : (e16_t*)nullptr, l + 1 < NLAYER ? (pg8::fx_t*)(C.ws + WS_RSS) + (size_t)(2 * l + 2) * S_ : (pg8::fx_t*)nullptr, D_};
              pg8::gemm_phase<pg8::EpiRes, pg8::StaticOrder>(ring, C.tid, g, S, E); }
        }
        REFRESH_TID;
        const bool seam = ph + 1 < hi, fill = seam && ph < 10;
        unsigned* ctl_ = (unsigned*)C.ws; const SplitBar sb_{ctl_ + CW_SEAM + 544 * (ph < 10 ? ph : 0), ctl_ + CW_BAR, xbar.x, xbar.st};
        int chi = 1 << 20;
#pragma unroll 1
        for (int r = 0; r < 2; ++r) {
            if (r == 1) { if (!fill) break; split_arrive(sb_); cj = 4; cslot = ph * 2048 + C.gw; cstride = C.NGW; chi = 1; }
            if (cj >= 0) convert_job(args, C, cj, cslot, cstride, 0, chi, (LAS float*)(C.lds + C.wave * 16384)); }
        if (seam) { if (hi < 0) grid.sync(); if (fill) split_wait(sb_); else xcd_barrier(xbar); }
    }
}
constexpr int N_PHASES = 1 + NLAYER * 6;

extern "C" void kernel_launch(void* const* d_in, const int* in_sizes, int n_in, void* d_out, int out_size, void* d_ws, size_t ws_size, hipStream_t stream) {
    static int grid = 0;
    if (grid == 0) {
        if (n_in != 18 || in_sizes[0] != S_ * D_ || out_size != S_ * D_ || ws_size < WS_END) {
            fprintf(stderr, "kernel_launch: unexpected shapes / workspace (n_in %d, in0 %d, out %d, ws %zu, need %zu); nothing launched\n", n_in, n_in > 0 ? in_sizes[0] : -1, out_size, ws_size, (size_t)WS_END); grid = -1; return; }
        int dev = 0, cus = 0, per_cu = 0;
        if (hipGetDevice(&dev) != hipSuccess || hipDeviceGetAttribute(&cus, hipDeviceAttributeMultiprocessorCount, dev) != hipSuccess) { grid = -1; return; }
        if (hipFuncSetAttribute((const void*)fwd_kernel, hipFuncAttributeMaxDynamicSharedMemorySize, LDS_BYTES) != hipSuccess) { fprintf(stderr, "kernel_launch: hipFuncSetAttribute failed\n"); grid = -1; return; }
        if (hipOccupancyMaxActiveBlocksPerMultiprocessor(&per_cu, (const void*)fwd_kernel, NTHREADS, LDS_BYTES) != hipSuccess || per_cu < 1) { fprintf(stderr, "kernel_launch: occupancy query says %d\n", per_cu); per_cu = 1; }
        (void)hipGetLastError();
        grid = cus * 1;
        fprintf(stderr, "kernel_launch: grid %d (cus %d, per_cu %d), ws %zu\n", grid, cus, per_cu, ws_size);
    }
    if (grid < 0) return;
    (void)hipMemsetAsync((char*)d_ws + WS_CTL, 0, 131072, stream);
    Args a{};
    for (int i = 0; i < 18; ++i) a.in[i] = (const float*)d_in[i];
    a.out = (float*)d_out; a.ws = (unsigned char*)d_ws; a.ph_lo = 0; a.ph_hi = N_PHASES;
    void* kargs[] = {&a};
    hipError_t e = hipLaunchCooperativeKernel((const void*)fwd_kernel, dim3(grid), dim3(NTHREADS), kargs, LDS_BYTES, stream);
    if (e != hipSuccess) fprintf(stderr, "kernel_launch: cooperative launch failed: %s (grid %d)\n", hipGetErrorString(e), grid);
}
```

```cpp
#include <hip/hip_runtime.h>
#include <hip/hip_cooperative_groups.h>
#include <cstdio>
#include <cstdint>
namespace cg = cooperative_groups;

#define LAS __attribute__((address_space(3)))
#define GAS __attribute__((address_space(1)))
typedef unsigned short e16_t;
typedef short h8 __attribute__((ext_vector_type(8)));
typedef short h4 __attribute__((ext_vector_type(4)));
typedef __bf16 mf8 __attribute__((ext_vector_type(8)));
typedef __bf16 mf2 __attribute__((ext_vector_type(2)));
typedef float f32x2 __attribute__((ext_vector_type(2)));
typedef float f32x4 __attribute__((ext_vector_type(4)));
typedef float f32x16 __attribute__((ext_vector_type(16)));
typedef unsigned u32x2 __attribute__((ext_vector_type(2)));
typedef unsigned u32x4 __attribute__((ext_vector_type(4)));
typedef int i32x8 __attribute__((ext_vector_type(8)));

#define MFMA32(a, b, c) __builtin_amdgcn_mfma_f32_32x32x16_bf16(__builtin_bit_cast(mf8, (a)), __builtin_bit_cast(mf8, (b)), (c), 0, 0, 0)
#define MFMA16(a, b, c) __builtin_amdgcn_mfma_f32_16x16x32_bf16(__builtin_bit_cast(mf8, (a)), __builtin_bit_cast(mf8, (b)), (c), 0, 0, 0)

__device__ __forceinline__ unsigned cvt_pk(float lo, float hi) { f32x2 v = {lo, hi}; mf2 b = __builtin_convertvector(v, mf2); return __builtin_bit_cast(unsigned, b); }
__device__ __forceinline__ void fp8rt2(float& a, float& b) { const int p = __builtin_amdgcn_cvt_pk_fp8_f32(a, b, 0, false); a = __builtin_amdgcn_cvt_f32_fp8(p, 0); b = __builtin_amdgcn_cvt_f32_fp8(p, 1); }
__device__ __forceinline__ unsigned cvt_pk8(float a, float b) { fp8rt2(a, b); return cvt_pk(a, b); }
__device__ __forceinline__ float up16(short x) { return __uint_as_float(((unsigned)(unsigned short)x) << 16); }
__device__ __forceinline__ float up_lo(unsigned w) { return __uint_as_float(w << 16); }
__device__ __forceinline__ float up_hi(unsigned w) { return __uint_as_float(w & 0xffff0000u); }
__device__ __forceinline__ h8 pack8(const float* f) { u32x4 w = {cvt_pk(f[0], f[1]), cvt_pk(f[2], f[3]), cvt_pk(f[4], f[5]), cvt_pk(f[6], f[7])}; return __builtin_bit_cast(h8, w); }
__device__ __forceinline__ float wave_sum(float v) {
#pragma unroll
    for (int o = 1; o < 64; o <<= 1) v += __shfl_xor(v, o);
    return v;
}
__device__ __forceinline__ float gelu_tanh(float x) {
    const float u = 0.7978845608028654f * (x + 0.044715f * x * x * x);
    return x / (1.0f + __builtin_amdgcn_exp2f(-2.885390081777927f * u));
}
__device__ __forceinline__ float sigmoidf_(float x) { return 1.0f / (1.0f + __builtin_amdgcn_exp2f(-1.4426950408889634f * x)); }
__device__ __forceinline__ int crow(int r, int hi) { return (r & 3) + 8 * (r >> 2) + 4 * hi; }

constexpr int S_ = 8192, D_ = 2048, NLAYER = 2;
constexpr int HA = 8, DA = 128, NBLK = 32;
constexpr int HM = 4, DMH = 256, NMEM = 256;
constexpr int DFF = 5632, WINC = 12288;
constexpr int ZP = 4096, ZN = 10240;
constexpr int ZQ = 0, ZK = 1024, ZU = 2048, ZQM = 3072, ZG = 4096;
constexpr int ZTP = 8192;
constexpr int YP = 3072;
constexpr float EPS = 1e-6f, LOG2E = 1.4426950408889634f;

constexpr size_t MiB = 1u << 20;
constexpr size_t WS_CTL = 0;
constexpr size_t WL_IN = 0, WL_B = 48 * MiB, WL_O = 60 * MiB, WL_GU = 68 * MiB, WL_D = 112 * MiB, WL_M = 134 * MiB, WL_SIZE = 142 * MiB;
constexpr size_t WS_W = 1 * MiB;
constexpr size_t WS_HN = WS_W + 2 * WL_SIZE;
constexpr size_t WS_Z = WS_HN + 32 * MiB;
constexpr size_t WS_GATE = WS_Z + 64 * MiB;
constexpr size_t WS_ZT = WS_GATE + 96 * MiB;
constexpr size_t WS_Y = WS_ZT + 32 * MiB;
constexpr size_t WS_PART = WS_Y + 48 * MiB;
constexpr size_t WS_MG = WS_PART + 64 * MiB;
constexpr size_t WS_MEMN = WS_MG + 32 * MiB;
constexpr size_t WS_KM = WS_MEMN + 2 * MiB;
constexpr size_t WS_VMT = WS_KM + 1 * MiB;
constexpr size_t WS_KMEAN = WS_VMT + 1 * MiB;
constexpr size_t WS_RSSV = WS_KMEAN + 256 * 1024;
constexpr size_t WS_RSS = WS_RSSV + 64 * 1024;
constexpr size_t WS_RSTDV = WS_RSSV + 384 * 1024;
constexpr size_t WS_LIST = WS_RSSV + 512 * 1024;
constexpr size_t WS_ML = WS_LIST + 8 * MiB;
constexpr size_t WS_SEL = WS_ML + 2 * MiB;
constexpr size_t WS_ONES = WS_SEL + 1 * MiB;
constexpr size_t WS_X8 = WS_ONES + 1 * MiB;
constexpr size_t WS_END = WS_X8 + 16 * MiB;
constexpr int CW_CNT = 2048;

namespace pg8 {
constexpr int PRE_OFF = 139264 + 12288;
constexpr int EPI_OFF = 139264;
constexpr int BM = 256, BK = 64, HALF = 128, HTB = HALF * BK * 2, STAGE_BYTES = 8 * HTB, NXCD = 8, WGM = 8;
__host__ __device__ __forceinline__ int lds_byte(int r, int c) { const int st = (r >> 4) * 2 + (c >> 5), rr = r & 15, cc = c & 31, ob = rr * 64 + cc * 2; return st * 1024 + (ob ^ (((ob >> 9) & 1) << 5)); }
__host__ __device__ __forceinline__ void stage_rc(int b, int& R, int& C) { const int st = b / 1024, sb = b % 1024, swz = sb ^ (((sb >> 9) & 1) << 5); R = (st >> 1) * 16 + swz / 64; C = (st & 1) * 32 + (swz % 64) / 2; }
__host__ __device__ __forceinline__ int perm32(int rho) { const int n = rho >> 4, i = rho & 15; return 8 * (i >> 2) + 4 * n + (i & 3); }

struct Unit { int pm, pn; };
struct Gemm { const e16_t* A; const e16_t* Bt; int M, N, K, lda, ldb; };

struct StaticOrder {
    int nM, nN, nwg, G, c;
    __host__ __device__ void init(int M, int N, int G_, int c_) { nM = M / BM; nN = N / BM; nwg = nM * nN; G = G_; c = c_; }
    __host__ __device__ bool next(int i, Unit& u) const {
        const long L = (long)i * G + c; if (L >= nwg) return false;
        int wgid = (int)L; { const int q = nwg / NXCD, r = nwg % NXCD, xcd = wgid % NXCD, off = wgid / NXCD; wgid = (xcd < r ? xcd * (q + 1) : r * (q + 1) + (xcd - r) * q) + off; }
        const int nig = WGM * nN, gid = wgid / nig, fm = gid * WGM, gsz = (nM - fm) < WGM ? (nM - fm) : WGM;
        u.pm = fm + ((wgid % nig) % gsz); u.pn = (wgid % nig) / gsz; return true;
    }
    __device__ __forceinline__ void a_ready(const Unit&) const {}
    __device__ __forceinline__ void done(const Unit&) const {}
};

#ifndef ST_AUX
#define ST_AUX 0
#endif
struct WT {
    __amdgpu_buffer_rsrc_t r;
    __device__ __forceinline__ explicit WT(const void* p) : r(__builtin_amdgcn_make_buffer_rsrc((void*)p, 0, 0x7fffffff, 0x00020000)) {}
    __device__ __forceinline__ void st(unsigned byteoff, u32x4 v) const { __builtin_amdgcn_raw_buffer_store_b128(v, r, byteoff, 0, ST_AUX); }
    __device__ __forceinline__ void stf(unsigned byteoff, f32x4 v) const { __builtin_amdgcn_raw_buffer_store_b128(__builtin_bit_cast(u32x4, v), r, byteoff, 0, ST_AUX); }
};
typedef unsigned long long fx_t;
constexpr float FX_ONE = 1048576.f, FX_INV = 1.f / 1048576.f;
__device__ __forceinline__ float fx2f(fx_t v) { return (float)v * FX_INV; }
__device__ __forceinline__ fx_t f2fx(float v) { return (fx_t)(v * FX_ONE); }
__device__ __forceinline__ float rstd_of(float ss) { return rsqrtf(ss * (1.f / 2048.f) + 1e-6f); }
struct EpiStore16 {
    static constexpr bool PERM = true, HAS_MID = false, HAS_PRE = false;
    e16_t* O; int ldc; const fx_t* rss; int mode; fx_t* rssv;
    __device__ __forceinline__ void operator()(const f32x4 (&acc)[2][2][4][2], const Unit& u, int wr, int wc, int fr, int fq) const {
        const int row0 = u.pm * BM + wr * 64 + fr, col0 = u.pn * BM + wc * 32 + 8 * fq;
        f32x4 cs[2][2];
#pragma unroll
        for (int bj = 0; bj < 2; ++bj)
#pragma unroll
            for (int n = 0; n < 2; ++n) { cs[bj][n] = (f32x4){1.f, 1.f, 1.f, 1.f};
                if (mode == 2) { const fx_t* rp = rss + col0 + bj * HALF + 4 * n; cs[bj][n] = (f32x4){rstd_of(fx2f(rp[0])), rstd_of(fx2f(rp[1])), rstd_of(fx2f(rp[2])), rstd_of(fx2f(rp[3]))}; } }
        const WT wt(O); const bool dogelu = (mode == 2) && rssv != nullptr && u.pm >= 4;
        float sq[2][8];
#pragma unroll
        for (int bj = 0; bj < 2; ++bj)
#pragma unroll
            for (int e = 0; e < 8; ++e) sq[bj][e] = 0.f;
        float rsv[2][4];
#pragma unroll
        for (int ai = 0; ai < 2; ++ai)
#pragma unroll
            for (int m = 0; m < 4; ++m) rsv[ai][m] = (mode == 1) ? fx2f(rss[row0 + ai * HALF + m * 16]) : 0.f;
#pragma unroll
        for (int ai = 0; ai < 2; ++ai)
#pragma unroll
            for (int m = 0; m < 4; ++m) { const int row = row0 + ai * HALF + m * 16; const unsigned rowb = (unsigned)(row * ldc + col0) * 2u;
                const float rs = (mode == 1) ? rstd_of(rsv[ai][m]) : 1.f;
#pragma unroll
                for (int bj = 0; bj < 2; ++bj) { f32x4 v0 = acc[ai][bj][m][0] * cs[bj][0] * rs, v1 = acc[ai][bj][m][1] * cs[bj][1] * rs;
                    if (dogelu) {
#pragma unroll
                        for (int e = 0; e < 4; ++e) { v0[e] = gelu_tanh(v0[e]); v1[e] = gelu_tanh(v1[e]); sq[bj][e] += v0[e] * v0[e]; sq[bj][4 + e] += v1[e] * v1[e]; } }
                    u32x4 w; w.x = cvt_pk(v0[0], v0[1]); w.y = cvt_pk(v0[2], v0[3]); w.z = cvt_pk(v1[0], v1[1]); w.w = cvt_pk(v1[2], v1[3]);
                    wt.st(rowb + bj * HALF * 2, w); } }
        if (dogelu) {
#pragma unroll
            for (int bj = 0; bj < 2; ++bj)
#pragma unroll
                for (int e = 0; e < 8; ++e) { float v = sq[bj][e]; v += __shfl_xor(v, 1); v += __shfl_xor(v, 2); v += __shfl_xor(v, 4); v += __shfl_xor(v, 8);
                    if (fr == 0) atomicAdd(rssv + col0 + bj * HALF + e, f2fx(v)); } }
    }
};
struct EpiSwiGLU {
    static constexpr bool PERM = true, HAS_MID = false, HAS_PRE = true;
    e16_t* O; int ldc; const fx_t* rss; LAS unsigned char* lds;
    __device__ __forceinline__ void operator()(const f32x4 (&acc)[2][2][4][2], const Unit& u, int wr, int wc, int fr, int fq) const {
        const int row0 = u.pm * BM + wr * 64 + fr, col0 = u.pn * HALF + wc * 32 + 8 * fq;
        const WT wt(O);
        float rsv[2][4];
#pragma unroll
        for (int ai = 0; ai < 2; ++ai)
#pragma unroll
            for (int m = 0; m < 4; ++m) rsv[ai][m] = fx2f(*(const LAS fx_t*)(lds + PRE_OFF + (wr * 64 + fr + ai * HALF + m * 16) * 8));
#pragma unroll
        for (int ai = 0; ai < 2; ++ai)
#pragma unroll
            for (int m = 0; m < 4; ++m) { const int row = row0 + ai * HALF + m * 16; const unsigned rowb = (unsigned)(row * ldc + col0) * 2u; const float rs = rstd_of(rsv[ai][m]);
                float hv[8];
#pragma unroll
                for (int n = 0; n < 2; ++n)
#pragma unroll
                    for (int i = 0; i < 4; ++i) { const float g = acc[ai][0][m][n][i] * rs, up = acc[ai][1][m][n][i] * rs; hv[n * 4 + i] = g * sigmoidf_(g) * up; }
                u32x4 w; w.x = cvt_pk(hv[0], hv[1]); w.y = cvt_pk(hv[2], hv[3]); w.z = cvt_pk(hv[4], hv[5]); w.w = cvt_pk(hv[6], hv[7]);
                wt.st(rowb, w); }
    }
};
struct EpiRes {
    static constexpr bool PERM = true, HAS_MID = false, HAS_PRE = false;
    const float* base; const e16_t* base16; float* out; e16_t* xb; fx_t* rss; int ldc; e16_t* x8;
    __device__ __forceinline__ void operator()(const f32x4 (&acc)[2][2][4][2], const Unit& u, int wr, int wc, int fr, int fq) const {
        const int row0 = u.pm * BM + wr * 64 + fr, col0 = u.pn * BM + wc * 32 + 8 * fq;
        const WT wo(out ? (const void*)out : (const void*)xb), wx(xb ? (const void*)xb : (const void*)out);
        if (base16) {
            h8 raw[2][4][2];
#pragma unroll
            for (int ai = 0; ai < 2; ++ai)
#pragma unroll
                for (int m = 0; m < 4; ++m) { const e16_t* bp = base16 + (size_t)(row0 + ai * HALF + m * 16) * ldc + col0;
#pragma unroll
                    for (int bj = 0; bj < 2; ++bj) raw[ai][m][bj] = *(const h8*)(bp + bj * HALF); }
#pragma unroll
            for (int ai = 0; ai < 2; ++ai)
#pragma unroll
                for (int m = 0; m < 4; ++m) { const int row = row0 + ai * HALF + m * 16; const size_t off = (size_t)row * ldc + col0; float ss = 0.f;
#pragma unroll
                    for (int bj = 0; bj < 2; ++bj) { const h8 r = raw[ai][m][bj];
                        const f32x4 v0 = (f32x4){up16(r[0]), up16(r[1]), up16(r[2]), up16(r[3])} + acc[ai][bj][m][0], v1 = (f32x4){up16(r[4]), up16(r[5]), up16(r[6]), up16(r[7])} + acc[ai][bj][m][1];
                        if (out) { wo.stf((unsigned)(off + bj * HALF) * 4u, v0); wo.stf((unsigned)(off + bj * HALF + 4) * 4u, v1); }
                        ss += (v0[0] * v0[0] + v0[1] * v0[1]) + (v0[2] * v0[2] + v0[3] * v0[3]) + (v1[0] * v1[0] + v1[1] * v1[1]) + (v1[2] * v1[2] + v1[3] * v1[3]);
                        if (xb) { u32x4 w; w.x = cvt_pk(v0[0], v0[1]); w.y = cvt_pk(v0[2], v0[3]); w.z = cvt_pk(v1[0], v1[1]); w.w = cvt_pk(v1[2], v1[3]); wx.st((unsigned)(off + bj * HALF) * 2u, w); }
                        if (x8) { u32x2 w; w.x = (unsigned)__builtin_amdgcn_cvt_pk_fp8_f32(v0[2], v0[3], __builtin_amdgcn_cvt_pk_fp8_f32(v0[0], v0[1], 0, false), true); w.y = (unsigned)__builtin_amdgcn_cvt_pk_fp8_f32(v1[2], v1[3], __builtin_amdgcn_cvt_pk_fp8_f32(v1[0], v1[1], 0, false), true);
                            *(u32x2*)((unsigned char*)x8 + off + bj * HALF) = w; } }
                    if (rss) { ss += __shfl_xor(ss, 16); ss += __shfl_xor(ss, 32); if (fq == 0) atomicAdd(rss + row, f2fx(ss)); } }
            return; }
#pragma unroll
        for (int ai = 0; ai < 2; ++ai) {
            f32x4 bv[4][2][2];
#pragma unroll
            for (int m = 0; m < 4; ++m) { const float* bp = base + (size_t)(row0 + ai * HALF + m * 16) * ldc + col0;
#pragma unroll
                for (int bj = 0; bj < 2; ++bj) { bv[m][bj][0] = *(const f32x4*)(bp + bj * HALF); bv[m][bj][1] = *(const f32x4*)(bp + bj * HALF + 4); } }
#pragma unroll
            for (int m = 0; m < 4; ++m) { const int row = row0 + ai * HALF + m * 16; const size_t off = (size_t)row * ldc + col0; float ss = 0.f;
#pragma unroll
                for (int bj = 0; bj < 2; ++bj) { const f32x4 v0 = bv[m][bj][0] + acc[ai][bj][m][0], v1 = bv[m][bj][1] + acc[ai][bj][m][1];
                    if (out) { wo.stf((unsigned)(off + bj * HALF) * 4u, v0); wo.stf((unsigned)(off + bj * HALF + 4) * 4u, v1); }
                    ss += (v0[0] * v0[0] + v0[1] * v0[1]) + (v0[2] * v0[2] + v0[3] * v0[3]) + (v1[0] * v1[0] + v1[1] * v1[1]) + (v1[2] * v1[2] + v1[3] * v1[3]);
                    if (xb) { u32x4 w; w.x = cvt_pk(v0[0], v0[1]); w.y = cvt_pk(v0[2], v0[3]); w.z = cvt_pk(v1[0], v1[1]); w.w = cvt_pk(v1[2], v1[3]); wx.st((unsigned)(off + bj * HALF) * 2u, w); } }
                if (rss) { ss += __shfl_xor(ss, 16); ss += __shfl_xor(ss, 32); if (fq == 0) atomicAdd(rss + row, f2fx(ss)); } }
        }
    }
};

struct EpiZ {
    static constexpr bool PERM = true, HAS_MID = false, HAS_PRE = true;
    e16_t* Z; e16_t* GATE; const fx_t* rss; LAS unsigned char* lds; const float* gk; float* kmean; int pn0;
    __device__ __forceinline__ void operator()(const f32x4 (&acc)[2][2][4][2], const Unit& u_, int wr, int wc, int fr, int fq) const {
        Unit u = u_; u.pn += pn0;
        const int row0 = u.pm * BM + wr * 64 + fr, col0 = u.pn * BM + wc * 32 + 8 * fq;
        const WT wz(Z), wg(GATE);
        float rsv[2][4];
#pragma unroll
        for (int ai = 0; ai < 2; ++ai)
#pragma unroll
            for (int m = 0; m < 4; ++m) rsv[ai][m] = fx2f(*(const LAS fx_t*)(lds + PRE_OFF + (wr * 64 + fr + ai * HALF + m * 16) * 8));
        if (u.pn >= 4 && u.pn < 8) {
            LAS float* P = (LAS float*)(lds + EPI_OFF); LAS float* KS = P + 2048;
#pragma unroll
            for (int ai = 0; ai < 2; ++ai)
#pragma unroll
                for (int m = 0; m < 4; ++m) { const float rs = rstd_of(rsv[ai][m]); const int rl = ai * HALF + wr * 64 + m * 16 + fr;
#pragma unroll
                    for (int bj = 0; bj < 2; ++bj) { const f32x4 v0 = acc[ai][bj][m][0] * rs, v1 = acc[ai][bj][m][1] * rs;
                        float ss = (v0[0] * v0[0] + v0[1] * v0[1]) + (v0[2] * v0[2] + v0[3] * v0[3]) + (v1[0] * v1[0] + v1[1] * v1[1]) + (v1[2] * v1[2] + v1[3] * v1[3]);
                        ss += __shfl_xor(ss, 16); ss += __shfl_xor(ss, 32);
                        if (fq == 0) P[(rl * 2 + bj) * 4 + wc] = ss; } }
            asm volatile("s_waitcnt lgkmcnt(0)" ::: "memory"); __builtin_amdgcn_s_barrier(); asm volatile("" ::: "memory");
            const f32x4 g0 = *(const f32x4*)(gk + wc * 32 + 8 * fq), g1 = *(const f32x4*)(gk + wc * 32 + 8 * fq + 4);
            float cs[2][8];
#pragma unroll
            for (int bj = 0; bj < 2; ++bj)
#pragma unroll
                for (int e = 0; e < 8; ++e) cs[bj][e] = 0.f;
#pragma unroll
            for (int ai = 0; ai < 2; ++ai)
#pragma unroll
                for (int m = 0; m < 4; ++m) { const int rl = ai * HALF + wr * 64 + m * 16 + fr; const unsigned rowb = (unsigned)((row0 + ai * HALF + m * 16) * ZP + col0) * 2u; const float rs = rstd_of(rsv[ai][m]);
#pragma unroll
                    for (int bj = 0; bj < 2; ++bj) { const f32x4 pt = *(const LAS f32x4*)(P + (rl * 2 + bj) * 4);
                        const float rk = rsqrtf(((pt[0] + pt[1]) + (pt[2] + pt[3])) * (1.f / 128.f) + 1e-6f) * rs;
                        const f32x4 v0 = acc[ai][bj][m][0] * rk * g0, v1 = acc[ai][bj][m][1] * rk * g1;
#pragma unroll
                        for (int e = 0; e < 4; ++e) { cs[bj][e] += v0[e]; cs[bj][4 + e] += v1[e]; }
                        u32x4 w; w.x = cvt_pk(v0[0], v0[1]); w.y = cvt_pk(v0[2], v0[3]); w.z = cvt_pk(v1[0], v1[1]); w.w = cvt_pk(v1[2], v1[3]);
                        wz.st(rowb + bj * HALF * 2, w); } }
#pragma unroll
            for (int bj = 0; bj < 2; ++bj)
#pragma unroll
                for (int e = 0; e < 8; ++e) { float v = cs[bj][e]; v += __shfl_xor(v, 1); v += __shfl_xor(v, 2); v += __shfl_xor(v, 4); v += __shfl_xor(v, 8); cs[bj][e] = v; }
            if (fr == 0) {
#pragma unroll
                for (int bj = 0; bj < 2; ++bj)
#pragma unroll
                    for (int e = 0; e < 8; ++e) KS[wr * 256 + bj * HALF + wc * 32 + 8 * fq + e] = cs[bj][e]; }
            asm volatile("s_waitcnt lgkmcnt(0)" ::: "memory"); __builtin_amdgcn_s_barrier(); asm volatile("" ::: "memory");
            const int tl = (wr * 4 + wc) * 64 + fq * 16 + fr;
            if (tl < 256) kmean[(size_t)((2 * (u.pn - 4) + (tl >> 7)) * 32 + u.pm) * 128 + (tl & 127)] = (KS[tl] + KS[256 + tl]) * (1.f / 256.f);
        } else if (u.pn < 16) {
#pragma unroll
            for (int ai = 0; ai < 2; ++ai)
#pragma unroll
                for (int m = 0; m < 4; ++m) { const unsigned rowb = (unsigned)((row0 + ai * HALF + m * 16) * ZP + col0) * 2u; const float rs = rstd_of(rsv[ai][m]);
#pragma unroll
                    for (int bj = 0; bj < 2; ++bj) { const f32x4 v0 = acc[ai][bj][m][0] * rs, v1 = acc[ai][bj][m][1] * rs;
                        u32x4 w; w.x = cvt_pk(v0[0], v0[1]); w.y = cvt_pk(v0[2], v0[3]); w.z = cvt_pk(v1[0], v1[1]); w.w = cvt_pk(v1[2], v1[3]);
                        wz.st(rowb + bj * HALF * 2, w); } }
        } else {
            const int gt = u.pn - 16;
            const unsigned lo = (unsigned)((wr * 4 + wc) * 8192 + (fq * 16 + fr) * 8);
            if (gt < 16) {
                const unsigned g0 = (unsigned)(((0 * 32 + u.pm) * 8 + (gt >> 1)) * 65536 + lo) * 2u; const WT wg1(GATE + (size_t)32 * 8 * 65536);
#pragma unroll
                for (int ai = 0; ai < 2; ++ai)
#pragma unroll
                    for (int m = 0; m < 4; ++m) { const float rs = rstd_of(rsv[ai][m]) * (-1.4426950408889634f / 64.f);
                        float r1[8], eb[8];
#pragma unroll
                        for (int n = 0; n < 2; ++n)
#pragma unroll
                            for (int i = 0; i < 4; ++i) { const float ea = __builtin_amdgcn_exp2f(__builtin_amdgcn_fmed3f(acc[ai][0][m][n][i] * rs, -43.28f, 43.28f)); eb[n * 4 + i] = __builtin_amdgcn_exp2f(__builtin_amdgcn_fmed3f(acc[ai][1][m][n][i] * rs, -43.28f, 43.28f));
                                const float sb = __builtin_amdgcn_rcpf(1.f + eb[n * 4 + i]); r1[n * 4 + i] = __builtin_amdgcn_rcpf(sb * (1.f + ea)); eb[n * 4 + i] = sb; }
                        const unsigned o = (unsigned)(((ai * 4 + m) * 2 + (gt & 1)) * 1024);
                        wg.st(g0 + o, __builtin_bit_cast(u32x4, pack8(r1))); wg1.st(g0 + o, __builtin_bit_cast(u32x4, pack8(eb))); }
            } else {
                const unsigned gb = (unsigned)(((2 * 32 + u.pm) * 8 + (gt - 16)) * 65536 + lo) * 2u;
#pragma unroll
                for (int ai = 0; ai < 2; ++ai)
#pragma unroll
                    for (int m = 0; m < 4; ++m) { const float rs = rstd_of(rsv[ai][m]) * (-1.4426950408889634f / 64.f);
#pragma unroll
                        for (int bj = 0; bj < 2; ++bj) { float g[8];
#pragma unroll
                            for (int i = 0; i < 4; ++i) { g[i] = 1.f + __builtin_amdgcn_exp2f(__builtin_amdgcn_fmed3f(acc[ai][bj][m][0][i] * rs, -43.28f, 43.28f)); g[4 + i] = 1.f + __builtin_amdgcn_exp2f(__builtin_amdgcn_fmed3f(acc[ai][bj][m][1][i] * rs, -43.28f, 43.28f)); }
                            wg.st(gb + (unsigned)(((ai * 4 + m) * 2 + bj) * 1024), __builtin_bit_cast(u32x4, pack8(g))); } }
            }
        }
    }
};
struct EpiGate {
    static constexpr bool PERM = true, HAS_MID = false, HAS_PRE = true;
    e16_t* GATE; const fx_t* rss; LAS unsigned char* lds;
    __device__ __forceinline__ void operator()(const f32x4 (&acc)[2][2][4][2], const Unit& u, int wr, int wc, int fr, int fq) const {
        const WT wg(GATE);
        float rsv[2][4];
#pragma unroll
        for (int ai = 0; ai < 2; ++ai)
#pragma unroll
            for (int m = 0; m < 4; ++m) rsv[ai][m] = rstd_of(fx2f(*(const LAS fx_t*)(lds + PRE_OFF + (wr * 64 + fr + ai * HALF + m * 16) * 8))) * (-1.4426950408889634f / 64.f);
        const int gt = u.pn;
        const unsigned lo = (unsigned)((wr * 4 + wc) * 8192 + (fq * 16 + fr) * 8);
        if (gt < 16) {
            const unsigned g0 = (unsigned)(((0 * 32 + u.pm) * 8 + (gt >> 1)) * 65536 + lo) * 2u; const WT wg1(GATE + (size_t)32 * 8 * 65536);
#pragma unroll
            for (int ai = 0; ai < 2; ++ai)
#pragma unroll
                for (int m = 0; m < 4; ++m) { const float rs = rsv[ai][m]; float r1[8], eb[8];
#pragma unroll
                    for (int n = 0; n < 2; ++n)
#pragma unroll
                        for (int i = 0; i < 4; ++i) { const float ea = __builtin_amdgcn_exp2f(__builtin_amdgcn_fmed3f(acc[ai][0][m][n][i] * rs, -43.28f, 43.28f)); eb[n * 4 + i] = __builtin_amdgcn_exp2f(__builtin_amdgcn_fmed3f(acc[ai][1][m][n][i] * rs, -43.28f, 43.28f));
                            const float sb = __builtin_amdgcn_rcpf(1.f + eb[n * 4 + i]); r1[n * 4 + i] = __builtin_amdgcn_rcpf(sb * (1.f + ea)); eb[n * 4 + i] = sb; }
                    const unsigned o = (unsigned)(((ai * 4 + m) * 2 + (gt & 1)) * 1024);
                    wg.st(g0 + o, __builtin_bit_cast(u32x4, pack8(r1))); wg1.st(g0 + o, __builtin_bit_cast(u32x4, pack8(eb))); }
        } else {
            const unsigned gb = (unsigned)(((2 * 32 + u.pm) * 8 + (gt - 16)) * 65536 + lo) * 2u;
#pragma unroll
            for (int ai = 0; ai < 2; ++ai)
#pragma unroll
                for (int m = 0; m < 4; ++m) { const float rs = rsv[ai][m];
#pragma unroll
                    for (int bj = 0; bj < 2; ++bj) { float g[8];
#pragma unroll
                        for (int i = 0; i < 4; ++i) { g[i] = 1.f + __builtin_amdgcn_exp2f(__builtin_amdgcn_fmed3f(acc[ai][bj][m][0][i] * rs, -43.28f, 43.28f)); g[4 + i] = 1.f + __builtin_amdgcn_exp2f(__builtin_amdgcn_fmed3f(acc[ai][bj][m][1][i] * rs, -43.28f, 43.28f)); }
                        wg.st(gb + (unsigned)(((ai * 4 + m) * 2 + bj) * 1024), __builtin_bit_cast(u32x4, pack8(g))); } }
        }
    }
};
struct EpiMerge {
    static constexpr bool PERM = true, HAS_MID = true, HAS_PRE = false;
    const e16_t* GATE; e16_t* MG;
    __device__ __forceinline__ const e16_t* gptr(int b, const Unit& u, int wr, int wc, int fr, int fq) const { return GATE + ((size_t)((b * 32 + u.pm) * 8 + u.pn)) * 65536 + (wr * 4 + wc) * 8192 + (fq * 16 + fr) * 8; }
    __device__ __forceinline__ void mid(f32x4 (&acc)[2][2][4][2], const Unit& u, int t, int wr, int wc, int fr, int fq) const {
        const e16_t* np = gptr(t == 16 ? 0 : 1, u, wr, wc, fr, fq); const e16_t* dp = (t == 16) ? GATE + (WS_ONES - WS_GATE) / 2 + (wr * 4 + wc) * 8192 + (fq * 16 + fr) * 8 : gptr(2, u, wr, wc, fr, fq);
#pragma unroll
        for (int ai = 0; ai < 2; ++ai)
#pragma unroll
            for (int m = 0; m < 4; ++m) {
#pragma unroll
                for (int bj = 0; bj < 2; ++bj) { const int o = ((ai * 4 + m) * 2 + bj) * 512; const h8 nn = *(const h8*)(np + o), dd = *(const h8*)(dp + o);
#pragma unroll
                    for (int i = 0; i < 4; ++i) { acc[ai][bj][m][0][i] *= up16(dd[i]) * up16(nn[i]); acc[ai][bj][m][1][i] *= up16(dd[4 + i]) * up16(nn[4 + i]); } }
                if (m == 3) asm volatile("" ::: "memory"); }
    }
    __device__ __forceinline__ void operator()(const f32x4 (&acc)[2][2][4][2], const Unit& u, int wr, int wc, int fr, int fq) const {
        const int row0 = u.pm * BM + wr * 64 + fr, col0 = u.pn * BM + wc * 32 + 8 * fq; const e16_t* sp = gptr(2, u, wr, wc, fr, fq); const WT wm(MG);
        h8 sg[2][4][2];
#pragma unroll
        for (int ai = 0; ai < 2; ++ai)
#pragma unroll
            for (int m = 0; m < 4; ++m)
#pragma unroll
                for (int bj = 0; bj < 2; ++bj) sg[ai][m][bj] = *(const h8*)(sp + ((ai * 4 + m) * 2 + bj) * 512);
#pragma unroll
        for (int ai = 0; ai < 2; ++ai)
#pragma unroll
            for (int m = 0; m < 4; ++m) { const unsigned rowb = (unsigned)((row0 + ai * HALF + m * 16) * 2048 + col0) * 2u;
#pragma unroll
                for (int bj = 0; bj < 2; ++bj) { float v[8];
#pragma unroll
                    for (int i = 0; i < 4; ++i) { v[i] = acc[ai][bj][m][0][i] * __builtin_amdgcn_rcpf(up16(sg[ai][m][bj][i])); v[4 + i] = acc[ai][bj][m][1][i] * __builtin_amdgcn_rcpf(up16(sg[ai][m][bj][4 + i])); }
                    wm.st(rowb + bj * HALF * 2, __builtin_bit_cast(u32x4, pack8(v))); } }
    }
};

template <class Epi, class Sched, bool ALIGN_EPI = true, bool SP2 = true, bool F8 = false>
__device__ __forceinline__ void gemm_phase(LAS unsigned char* lds, const int tid, const Gemm g, const Sched& S, const Epi& E) {
    const int wid = __builtin_amdgcn_readfirstlane(tid >> 6), lane = tid & 63, wr = wid >> 2, wc = wid & 3, fr = lane & 15, fq = lane >> 4;
    const int K = g.K, nt = K / BK;
    unsigned voffA[2], voffB[2];
#pragma unroll
    for (int i = 0; i < 2; ++i) { int R, C; stage_rc(tid * 16 + i * 8192, R, C); const int Rb = Epi::PERM ? ((R & ~31) + perm32(R & 31)) : R;
        voffA[i] = (unsigned)(R * g.lda + C) * 2u; voffB[i] = (unsigned)(Rb * g.ldb + C) * 2u; }
    const size_t kstep = (size_t)(BK * 2);
    const size_t hstepA = (size_t)HALF * g.lda * 2, hstepB = (size_t)HALF * g.ldb * 2;
    const size_t tstepA = 2 * hstepA, tstepB = 2 * hstepB;
    const unsigned ldsw = (unsigned)wid * 1024u;
    const int aoff = lds_byte(wr * 64 + fr, fq * 8), boff = lds_byte(wc * 32 + fr, fq * 8);
#define PG8_SA(b, h) (((b) * 2 + (h)) * HTB)
#define PG8_SB(b, h) ((4 + (b) * 2 + (h)) * HTB)
#define PG8_STAGE(bufoff, gbase, voff) do { _Pragma("unroll") for (int _i = 0; _i < 2; ++_i) \
        __builtin_amdgcn_global_load_lds((const unsigned*)((const char*)(gbase) + (voff)[_i]), (LAS unsigned*)(lds + (bufoff) + ldsw + _i * 8192), 16, 0, 0); } while (0)
#define PG8_LDA(dst, b, h) do { if constexpr (F8) { _Pragma("unroll") for (int m = 0; m < 4; ++m) { const u32x4 lo_ = *(const LAS u32x4*)(lds + PG8_SA(b, h) + aoff + m * 2048), hi_ = *(const LAS u32x4*)(lds + PG8_SA(b, h) + aoff + m * 2048 + 1024); \
            dst##8[m] = __builtin_bit_cast(i32x8, __builtin_shufflevector(lo_, hi_, 0, 1, 2, 3, 4, 5, 6, 7)); } } \
        else { _Pragma("unroll") for (int m = 0; m < 4; ++m) _Pragma("unroll") for (int k = 0; k < 2; ++k) dst[m][k] = *(const LAS h8*)(lds + PG8_SA(b, h) + aoff + m * 2048 + k * 1024); } } while (0)
#define PG8_LDB(dst, b, h) do { if constexpr (F8) { _Pragma("unroll") for (int n = 0; n < 2; ++n) { const u32x4 lo_ = *(const LAS u32x4*)(lds + PG8_SB(b, h) + boff + n * 2048), hi_ = *(const LAS u32x4*)(lds + PG8_SB(b, h) + boff + n * 2048 + 1024); \
            dst##8[n] = __builtin_bit_cast(i32x8, __builtin_shufflevector(lo_, hi_, 0, 1, 2, 3, 4, 5, 6, 7)); } } \
        else { _Pragma("unroll") for (int n = 0; n < 2; ++n) _Pragma("unroll") for (int k = 0; k < 2; ++k) dst[n][k] = *(const LAS h8*)(lds + PG8_SB(b, h) + boff + n * 2048 + k * 1024); } } while (0)
#define PG8_MMA(ai, bj, At, Bt) do { __builtin_amdgcn_s_setprio(1); \
        if constexpr (F8) { _Pragma("unroll") for (int m = 0; m < 4; ++m) _Pragma("unroll") for (int n = 0; n < 2; ++n) \
            asm volatile("v_mfma_scale_f32_16x16x128_f8f6f4 %0, %1, %2, %0, %3, %3 op_sel_hi:[0,0,0]" : "+v"(acc[ai][bj][m][n]) : "v"(Bt##8[n]), "v"(At##8[m]), "v"(sc8)); } \
        else { _Pragma("unroll") for (int m = 0; m < 4; ++m) _Pragma("unroll") for (int n = 0; n < 2; ++n) _Pragma("unroll") for (int k = 0; k < 2; ++k) \
            acc[ai][bj][m][n] = MFMA16(Bt[n][k], At[m][k], acc[ai][bj][m][n]); } \
        __builtin_amdgcn_s_setprio(0); } while (0)
#define PG8_WAIT_V(n) asm volatile("s_waitcnt vmcnt(" #n ")" ::: "memory")
#define PG8_WAIT_L(n) asm volatile("s_waitcnt lgkmcnt(" #n ")" ::: "memory")
#define PG8_BAR __builtin_amdgcn_s_barrier()
#define PG8_SCHED __builtin_amdgcn_sched_barrier(0)
    Unit cur, nxt; int ui = 0;
    if (!S.next(0, cur)) return;
    f32x4 acc[2][2][4][2];
#pragma unroll
    for (int a = 0; a < 2; ++a)
#pragma unroll
        for (int b = 0; b < 2; ++b)
#pragma unroll
            for (int m = 0; m < 4; ++m)
#pragma unroll
                for (int n = 0; n < 2; ++n) acc[a][b][m][n] = (f32x4){0.f, 0.f, 0.f, 0.f};
    h8 At[4][2], B0[2][2], B1[2][2]; i32x8 At8[4], B08[2], B18[2];
    int sc8 = 0x7f7f7f7f; asm volatile("" : "+v"(sc8));
    const char* cA = (const char*)g.A + (size_t)cur.pm * tstepA; const char* cB = (const char*)g.Bt + (size_t)cur.pn * tstepB;
    S.a_ready(cur);
    if constexpr (SP2) {
        PG8_STAGE(PG8_SB(0, 0), cB, voffB); PG8_STAGE(PG8_SB(0, 1), cB + hstepB, voffB); PG8_STAGE(PG8_SA(0, 0), cA, voffA); PG8_STAGE(PG8_SA(0, 1), cA + hstepA, voffA);
        if (wr == 1) PG8_BAR;
        PG8_WAIT_V(2); PG8_BAR;
        PG8_STAGE(PG8_SB(1, 0), cB + kstep, voffB); PG8_STAGE(PG8_SA(1, 0), cA + kstep, voffA); PG8_STAGE(PG8_SB(1, 1), cB + hstepB + kstep, voffB);
        PG8_WAIT_V(6); PG8_BAR;
    } else {
        PG8_STAGE(PG8_SB(0, 0), cB, voffB); PG8_STAGE(PG8_SA(0, 0), cA, voffA); PG8_STAGE(PG8_SB(0, 1), cB + hstepB, voffB); PG8_STAGE(PG8_SA(0, 1), cA + hstepA, voffA);
        if (wr == 1) PG8_BAR;
        PG8_WAIT_V(4); PG8_BAR;
        PG8_STAGE(PG8_SB(1, 0), cB + kstep, voffB); PG8_STAGE(PG8_SA(1, 0), cA + kstep, voffA); PG8_STAGE(PG8_SB(1, 1), cB + hstepB + kstep, voffB);
        PG8_WAIT_V(6); PG8_BAR;
    }
    for (;;) {
        const bool has_next = S.next(ui + 1, nxt);
        const char* nA = has_next ? (const char*)g.A + (size_t)nxt.pm * tstepA : cA; const char* nB = has_next ? (const char*)g.Bt + (size_t)nxt.pn * tstepB : cB;
        for (int t = 0; t < nt; t += 2) {
            const bool last = (t == nt - 2);
            const char* a1 = cA + (size_t)(t + 1) * kstep;
            const char* a2 = last ? nA : cA + (size_t)(t + 2) * kstep; const char* b2 = last ? nB : cB + (size_t)(t + 2) * kstep;
            const char* a3 = a2 + kstep; const char* b3 = b2 + kstep;
            if (last && has_next) S.a_ready(nxt);
            if constexpr (Epi::HAS_PRE) { if (last) __builtin_amdgcn_global_load_lds((const unsigned*)(E.rss + (size_t)cur.pm * BM) + tid, (LAS unsigned*)(lds + PRE_OFF + wid * 256), 4, 0, 0); }
            if constexpr (Epi::HAS_MID) { if (t == 16 || t == 32) E.mid(acc, cur, t, wr, wc, fr, fq); }
            if constexpr (SP2) {
            PG8_LDB(B0, 0, 0); PG8_LDB(B1, 0, 1); PG8_SCHED; PG8_LDA(At, 0, 0); PG8_STAGE(PG8_SA(1, 1), a1 + hstepA, voffA);
            PG8_WAIT_V(8); PG8_WAIT_L(0); PG8_BAR; PG8_MMA(0, 0, At, B0); PG8_MMA(0, 1, At, B1); PG8_BAR; PG8_SCHED;
            PG8_LDA(At, 0, 1); PG8_STAGE(PG8_SB(0, 0), b2, voffB); PG8_STAGE(PG8_SB(0, 1), b2 + hstepB, voffB); PG8_STAGE(PG8_SA(0, 0), a2, voffA);
            PG8_WAIT_V(8); PG8_WAIT_L(0); PG8_BAR; PG8_MMA(1, 0, At, B0); PG8_MMA(1, 1, At, B1); PG8_BAR; PG8_SCHED;
            PG8_LDB(B0, 1, 0); PG8_LDB(B1, 1, 1); PG8_SCHED; PG8_LDA(At, 1, 0); PG8_STAGE(PG8_SA(0, 1), a2 + hstepA, voffA);
            PG8_WAIT_V(8); PG8_WAIT_L(0); PG8_BAR; PG8_MMA(0, 0, At, B0); PG8_MMA(0, 1, At, B1); PG8_BAR; PG8_SCHED;
            PG8_LDA(At, 1, 1); PG8_STAGE(PG8_SB(1, 0), b3, voffB); PG8_STAGE(PG8_SB(1, 1), b3 + hstepB, voffB); PG8_STAGE(PG8_SA(1, 0), a3, voffA);
            PG8_WAIT_V(8); PG8_WAIT_L(0); PG8_BAR; PG8_MMA(1, 0, At, B0); PG8_MMA(1, 1, At, B1); PG8_BAR; PG8_SCHED;
            } else {
            PG8_LDB(B0, 0, 0); PG8_SCHED; PG8_LDA(At, 0, 0); PG8_STAGE(PG8_SA(1, 1), a1 + hstepA, voffA);
            PG8_WAIT_L(8); PG8_BAR; PG8_WAIT_L(0); PG8_MMA(0, 0, At, B0); PG8_BAR; PG8_SCHED;
            PG8_LDB(B1, 0, 1); PG8_STAGE(PG8_SB(0, 0), b2, voffB);
            PG8_BAR; PG8_WAIT_L(0); PG8_MMA(0, 1, At, B1); PG8_BAR;
            PG8_LDA(At, 0, 1); PG8_STAGE(PG8_SA(0, 0), a2, voffA);
            PG8_BAR; PG8_WAIT_L(0); PG8_MMA(1, 0, At, B0); PG8_BAR; PG8_SCHED;
            PG8_STAGE(PG8_SB(0, 1), b2 + hstepB, voffB);
            PG8_WAIT_V(6); PG8_BAR; PG8_MMA(1, 1, At, B1); PG8_BAR;
            PG8_LDB(B0, 1, 0); PG8_SCHED; PG8_LDA(At, 1, 0); PG8_STAGE(PG8_SA(0, 1), a2 + hstepA, voffA);
            PG8_WAIT_L(8); PG8_BAR; PG8_WAIT_L(0); PG8_MMA(0, 0, At, B0); PG8_BAR; PG8_SCHED;
            PG8_LDB(B1, 1, 1); PG8_STAGE(PG8_SB(1, 0), b3, voffB);
            PG8_BAR; PG8_WAIT_L(0); PG8_MMA(0, 1, At, B1); PG8_BAR;
            PG8_LDA(At, 1, 1); PG8_STAGE(PG8_SA(1, 0), a3, voffA);
            PG8_BAR; PG8_WAIT_L(0); PG8_MMA(1, 0, At, B0); PG8_BAR; PG8_SCHED;
            PG8_STAGE(PG8_SB(1, 1), b3 + hstepB, voffB);
            PG8_WAIT_V(6); PG8_BAR; PG8_MMA(1, 1, At, B1); PG8_BAR;
            }
        }
        if constexpr (F8) asm volatile("s_nop 15\n\ts_nop 15" ::: "memory");
        if constexpr (ALIGN_EPI) { if (wr == 0) PG8_BAR; }
        E(acc, cur, wr, wc, fr, fq); S.done(cur);
        if (!has_next) break;
#pragma unroll
        for (int a = 0; a < 2; ++a)
#pragma unroll
            for (int b = 0; b < 2; ++b)
#pragma unroll
                for (int m = 0; m < 4; ++m)
#pragma unroll
                    for (int n = 0; n < 2; ++n) acc[a][b][m][n] = (f32x4){0.f, 0.f, 0.f, 0.f};
        cur = nxt; cA = nA; cB = nB; ++ui;
        if constexpr (ALIGN_EPI) { if (wr == 1) PG8_BAR; }
    }
    PG8_WAIT_V(0);
    if constexpr (!ALIGN_EPI) { if (wr == 0) PG8_BAR; }
    PG8_BAR;
#undef PG8_SA
#undef PG8_SB
#undef PG8_STAGE
#undef PG8_LDA
#undef PG8_LDB
#undef PG8_MMA
#undef PG8_WAIT_V
#undef PG8_WAIT_L
#undef PG8_BAR
#undef PG8_SCHED
}
}
using pg8::fx_t; using pg8::fx2f; using pg8::f2fx;

constexpr int NWAVES = 8, NTHREADS = 512;
constexpr int LDS_BYTES = 155648;
struct Args { const float* in[18]; float* out; unsigned char* ws; int ph_lo, ph_hi; };

struct Ctx {
    LAS unsigned char* lds; int tid, lane, wave, gw, NGW, G;
    float* out; unsigned char* ws;
    __device__ __forceinline__ e16_t* w16(size_t off) const { return (e16_t*)(ws + off); }
    __device__ __forceinline__ e16_t* wl(int l, size_t off) const { return (e16_t*)(ws + WS_W + (size_t)l * WL_SIZE + off); }
};

#define LDS_WAIT() asm volatile("s_waitcnt lgkmcnt(0)" ::: "memory")
__device__ __forceinline__ int map_win(int n) {
    if (n < 2048) return n;
    if (n < 3072) return 10240 + (n - 2048);
    if (n < 4096) return 2048 + (n - 3072);
    if (n < 5120) return 11264 + (n - 4096);
    if (n < 6144) return 3072 + (n - 5120);
    if (n < 8192) { const int c = n - 6144; return 4096 + (c >> 7) * 256 + (c & 127); }
    if (n < 10240) { const int c = n - 8192; return 4096 + (c >> 7) * 256 + 128 + (c & 127); }
    return n - 2048;
}
__device__ __forceinline__ int map_gu(int n) { return n < DFF ? 256 * (n >> 7) + (n & 127) : 256 * ((n - DFF) >> 7) + 128 + ((n - DFF) & 127); }
struct TD { const float* W; const float* g; e16_t* WT; int K, N, ldo, koff, map; };
__device__ __forceinline__ TD weight_td(const Args& a, const Ctx& C, int id) {
    const int l = id >> 3, m = id & 7; TD t; t.g = nullptr; t.koff = 0; t.map = 0;
    if (m == 0) { t.W = a.in[3] + (size_t)l * D_ * WINC; t.g = a.in[2] + l * D_; t.WT = C.wl(l, WL_IN); t.K = D_; t.N = WINC; t.ldo = D_; t.map = 1; }
    else if (m <= 3) { t.W = a.in[13] + (size_t)(l * 3 + m - 1) * 1024 * D_; t.WT = C.wl(l, WL_B); t.K = 1024; t.N = D_; t.ldo = 3072; t.koff = (m - 1) * 1024; }
    else if (m == 4) { t.W = a.in[14] + (size_t)l * D_ * D_; t.WT = C.wl(l, WL_O); t.K = D_; t.N = D_; t.ldo = D_; }
    else if (m == 5) { t.W = a.in[16] + (size_t)l * D_ * 2 * DFF; t.g = a.in[15] + l * D_; t.WT = C.wl(l, WL_GU); t.K = D_; t.N = 2 * DFF; t.ldo = D_; t.map = 2; }
    else if (m == 6) { t.W = a.in[17] + (size_t)l * DFF * D_; t.WT = C.wl(l, WL_D); t.K = DFF; t.N = D_; t.ldo = DFF; }
    else { t.W = a.in[12] + (size_t)l * D_ * D_; t.WT = C.wl(l, WL_M); t.K = D_; t.N = D_; t.ldo = D_; }
    return t;
}
__device__ __forceinline__ bool job_decode(int job, int i, int& id, int& it) {
    if (job == 0) { if (i < 12288) { id = 0; it = i; } else if (i < 14336) { id = 7; it = i - 12288; } else if (i < 16384) { id = 15; it = i - 14336; } else if (i < 19456) { id = 5; it = i - 16384 + 8192; }
                    else if (i < 22528) { id = 13; it = i - 19456 + 8192; } else return false; }
    else if (job == 4) { if (i < 8192) { id = 5; it = i; } else if (i < 12288) { id = 8; it = i; } else if (i < 20480) { id = 13; it = i - 12288; } else return false; }
    else if (job == 1) { if (i < 3072) { id = 1 + (i >> 10); it = i & 1023; } else if (i < 5120) { id = 4; it = i - 3072; } else if (i < 10752) { id = 6; it = i - 5120; }
                         else if (i < 13824) { id = 9 + ((i - 10752) >> 10); it = (i - 10752) & 1023; } else if (i < 15872) { id = 12; it = i - 13824; } else return false; }
    else if (job == 2) { if (i >= 8192) return false; id = 8; it = i; }
    else { if (i >= 5632) return false; id = 14; it = i; }
    return true;
}
__device__ __forceinline__ void convert_job(const Args& a, const Ctx& C, int job, int slot, int stride, int k_lo, int k_hi, LAS float* scr) {
    const int lane = C.lane, c = lane & 7;
    int k = k_lo, id, it;
    if (k >= k_hi || !job_decode(job, slot + k * stride, id, it)) return;
    TD t = weight_td(a, C, id); int nblk = t.N / 32;
    float r[32];
    { const int k0 = (it / nblk) * 64, n0 = (it % nblk) * 32;
#pragma unroll
      for (int i = 0; i < 32; ++i) r[i] = t.W[(size_t)(k0 + 2 * i + (lane >> 5)) * t.N + n0 + (lane & 31)]; }
#pragma unroll 1
    for (;;) {
        const int k0 = (it / nblk) * 64, n0 = (it % nblk) * 32; const int drow0 = t.map == 1 ? map_win(n0) : (t.map == 2 ? map_gu(n0) : n0);
        f32x4 ga = {1.f, 1.f, 1.f, 1.f}, gb = ga;
        if (t.g) { ga = *(const f32x4*)(t.g + k0 + 8 * c); gb = *(const f32x4*)(t.g + k0 + 8 * c + 4); }
        e16_t* wt = t.WT; const int ldo = t.ldo, koff = t.koff; const bool g8 = t.map == 1 && n0 >= 6144;
#pragma unroll
        for (int i = 0; i < 32; ++i) scr[(2 * i + (lane >> 5)) * 33 + (lane & 31)] = r[i];
        ++k; int id2, it2; const bool more = (k < k_hi) && job_decode(job, slot + k * stride, id2, it2);
        if (more) { t = weight_td(a, C, id2); nblk = t.N / 32; it = it2; const int k1 = (it / nblk) * 64, n1 = (it % nblk) * 32;
#pragma unroll
            for (int i = 0; i < 32; ++i) r[i] = t.W[(size_t)(k1 + 2 * i + (lane >> 5)) * t.N + n1 + (lane & 31)]; }
        LDS_WAIT(); asm volatile("" ::: "memory");
#pragma unroll
        for (int j = 0; j < 4; ++j) { const int n = (lane >> 3) + 8 * j; const LAS float* sp = scr + (8 * c) * 33 + n;
            float f0 = sp[0 * 33] * ga[0], f1 = sp[1 * 33] * ga[1], f2 = sp[2 * 33] * ga[2], f3 = sp[3 * 33] * ga[3], f4 = sp[4 * 33] * gb[0], f5 = sp[5 * 33] * gb[1], f6 = sp[6 * 33] * gb[2], f7 = sp[7 * 33] * gb[3];
            if (g8) { u32x2 o8; o8.x = (unsigned)__builtin_amdgcn_cvt_pk_fp8_f32(f2 * 64.f, f3 * 64.f, __builtin_amdgcn_cvt_pk_fp8_f32(f0 * 64.f, f1 * 64.f, 0, false), true);
                o8.y = (unsigned)__builtin_amdgcn_cvt_pk_fp8_f32(f6 * 64.f, f7 * 64.f, __builtin_amdgcn_cvt_pk_fp8_f32(f4 * 64.f, f5 * 64.f, 0, false), true);
                *(u32x2*)((unsigned char*)(wt + (size_t)4096 * ldo) + (size_t)(drow0 - 4096 + n) * 2048 + k0 + 8 * c) = o8; continue; }
            u32x4 o; o.x = cvt_pk(f0, f1); o.y = cvt_pk(f2, f3); o.z = cvt_pk(f4, f5); o.w = cvt_pk(f6, f7);
            *(u32x4*)(wt + (size_t)(drow0 + n) * ldo + koff + k0 + 8 * c) = o; }
        LDS_WAIT(); asm volatile("" ::: "memory");
        if (!more) break;
    }
}
__device__ __forceinline__ void rms_rows(const Ctx& C, const float* X, const float* g, e16_t* O, int rows) {
    for (int m = C.gw; m < rows; m += C.NGW) {
        const f32x4* xr = (const f32x4*)(X + (size_t)m * D_) + C.lane; f32x4 v[8]; float s = 0.f;
#pragma unroll
        for (int j = 0; j < 8; ++j) { v[j] = xr[64 * j]; s += (v[j].x * v[j].x + v[j].y * v[j].y) + (v[j].z * v[j].z + v[j].w * v[j].w); }
        const float rstd = rsqrtf(wave_sum(s) * (1.f / D_) + EPS);
        const f32x4* gr = (const f32x4*)g + C.lane; u32x2* o8 = (u32x2*)(O + (size_t)m * D_) + C.lane;
#pragma unroll
        for (int j = 0; j < 8; ++j) { const f32x4 gg = gr[64 * j]; u32x2 w; w.x = cvt_pk(v[j].x * rstd * gg.x, v[j].y * rstd * gg.y); w.y = cvt_pk(v[j].z * rstd * gg.z, v[j].w * rstd * gg.w); o8[64 * j] = w; }
    }
}

__device__ __forceinline__ void xb_rows(const Ctx& C, const float* X, e16_t* O, fx_t* rss, int rows, e16_t* O8) {
    for (int m = C.gw; m < rows; m += C.NGW) {
        const f32x4* xr = (const f32x4*)(X + (size_t)m * D_) + C.lane; u32x2* o8 = (u32x2*)(O + (size_t)m * D_) + C.lane; unsigned* q8 = (unsigned*)((unsigned char*)O8 + (size_t)m * D_) + C.lane; f32x4 v[8]; float s = 0.f;
#pragma unroll
        for (int j = 0; j < 8; ++j) { v[j] = xr[64 * j]; s += (v[j].x * v[j].x + v[j].y * v[j].y) + (v[j].z * v[j].z + v[j].w * v[j].w); }
#pragma unroll
        for (int j = 0; j < 8; ++j) { u32x2 w; w.x = cvt_pk(v[j].x, v[j].y); w.y = cvt_pk(v[j].z, v[j].w); o8[64 * j] = w;
            q8[64 * j] = (unsigned)__builtin_amdgcn_cvt_pk_fp8_f32(v[j].z, v[j].w, __builtin_amdgcn_cvt_pk_fp8_f32(v[j].x, v[j].y, 0, false), true); }
        s = wave_sum(s); if (C.lane == 0) rss[m] = f2fx(s);
    }
}
__device__ __forceinline__ void kmnorm_phase(const Ctx& C, const float* gkm) {
    for (int it = C.gw; it < NLAYER * NMEM * HM; it += C.NGW) { const int l = it >> 10, m = (it >> 2) & 255, hm = it & 3;
        e16_t* p = C.w16(WS_KM) + (size_t)l * NMEM * 1024 + (size_t)m * 1024 + hm * DMH + 4 * C.lane; const h4 raw = *(const h4*)p;
        float v[4]; float ss = 0.f;
#pragma unroll
        for (int i = 0; i < 4; ++i) { v[i] = up16(raw[i]); ss += v[i] * v[i]; }
        const float rstd = rsqrtf(wave_sum(ss) * (1.f / DMH) + EPS); const float* g = gkm + l * DMH + 4 * C.lane;
        u32x2 w; w.x = cvt_pk(v[0] * rstd * g[0], v[1] * rstd * g[1]); w.y = cvt_pk(v[2] * rstd * g[2], v[3] * rstd * g[3]); *(u32x2*)p = w; }
}
__device__ __forceinline__ void gating_phase(const Ctx& C, int l, const float* gq, const float* gk) {
    const e16_t* Z = C.w16(WS_Z); const float* KMEAN = (const float*)(C.ws + WS_KMEAN); unsigned* LIST = (unsigned*)(C.ws + WS_LIST); unsigned* SEL = (unsigned*)(C.ws + WS_SEL);
    unsigned* CNT = (unsigned*)(C.ws + WS_CTL) + CW_CNT + l * 256;
    LAS float* km = (LAS float*)C.lds;
    LAS unsigned* lcnt = (LAS unsigned*)(C.lds + 16384); LAS unsigned* lbase = lcnt + 32;
    for (int it = blockIdx.x; it < HA * NBLK; it += C.G) { const int h = it >> 5, b = it & 31;
        for (int i = C.tid; i < NBLK * DA; i += NTHREADS) km[i] = KMEAN[(size_t)h * NBLK * DA + i];
        if (C.tid < 32) lcnt[C.tid] = 0u;
        if (C.tid < 64) { float a = fmaxf(fabsf(gq[C.tid]), fabsf(gq[C.tid + 64])), bb = fmaxf(fabsf(gk[C.tid]), fabsf(gk[C.tid + 64]));
#pragma unroll
            for (int o = 1; o < 64; o <<= 1) { a = fmaxf(a, __shfl_xor(a, o)); bb = fmaxf(bb, __shfl_xor(bb, o)); }
            if (C.tid == 0) ((LAS float*)lcnt)[96] = 2.f * (16.3222f * 1.02f * a * bb) + 150.f; }
        __syncthreads();
        const float thr = ((LAS float*)lcnt)[96], slope2 = __builtin_amdgcn_exp2f(-(float)(h + 1)) * LOG2E;
        const int q = b * 256 + (C.tid >> 1), half = C.tid & 1; const int nsel = b < 3 ? b : 3;
        int i0 = 0, i1 = 1, i2 = 2;
        if (b > 3) {
            float qv[64]; float ss = 0.f; const e16_t* zr = Z + (size_t)q * ZP + ZQ + h * DA + half * 64;
#pragma unroll
            for (int c8 = 0; c8 < 8; ++c8) { const h8 r = *(const h8*)(zr + 8 * c8);
#pragma unroll
                for (int j = 0; j < 8; ++j) { const float f = up16(r[j]); qv[c8 * 8 + j] = f; ss += f * f; } }
            ss += __shfl_xor(ss, 1);
            const float rstd = rsqrtf(ss * (1.f / DA) + EPS);
#pragma unroll
            for (int d = 0; d < 64; ++d) qv[d] = qv[d] * rstd * gq[half * 64 + d];
            float v0 = -__builtin_inff(), v1 = v0, v2 = v0;
            for (int j = 0; j < b; ++j) { const LAS f32x4* kr = (const LAS f32x4*)(km + j * DA + half * 64); float g0 = 0.f, g1 = 0.f;
#pragma unroll
                for (int d4 = 0; d4 < 16; d4 += 2) { const f32x4 ka = kr[d4], kb = kr[d4 + 1];
                    g0 += (qv[4 * d4] * ka.x + qv[4 * d4 + 1] * ka.y) + (qv[4 * d4 + 2] * ka.z + qv[4 * d4 + 3] * ka.w);
                    g1 += (qv[4 * d4 + 4] * kb.x + qv[4 * d4 + 5] * kb.y) + (qv[4 * d4 + 6] * kb.z + qv[4 * d4 + 7] * kb.w); }
                float gt = g0 + g1; gt += __shfl_xor(gt, 1);
                if (gt > v0) { v2 = v1; i2 = i1; v1 = v0; i1 = i0; v0 = gt; i0 = j; }
                else if (gt > v1) { v2 = v1; i2 = i1; v1 = gt; i1 = j; }
                else if (gt > v2) { v2 = gt; i2 = j; } }
        }
        const bool u0 = nsel > 0 && !(slope2 * (float)(256 * (b - i0 - 1) + 1) > thr), u1 = nsel > 1 && !(slope2 * (float)(256 * (b - i1 - 1) + 1) > thr), u2 = nsel > 2 && !(slope2 * (float)(256 * (b - i2 - 1) + 1) > thr);
        unsigned p0 = 0u, p1 = 0u, p2 = 0u;
        if (half == 0) { if (u0) p0 = atomicAdd((unsigned*)&lcnt[i0], 1u); if (u1) p1 = atomicAdd((unsigned*)&lcnt[i1], 1u); if (u2) p2 = atomicAdd((unsigned*)&lcnt[i2], 1u);
            SEL[(size_t)h * S_ + q] = (u0 ? 0u : 1u) | (u1 ? 0u : 2u) | (u2 ? 0u : 4u); }
        __syncthreads();
        if (C.tid < 32) { const unsigned n = lcnt[C.tid]; lbase[C.tid] = n ? atomicAdd(&CNT[h * 32 + C.tid], n) : 0u; }
        __syncthreads();
        if (half == 0) { unsigned* L = LIST + (size_t)h * 32 * 8192;
            if (u0) L[(size_t)i0 * 8192 + lbase[i0] + p0] = (unsigned)q;
            if (u1) L[(size_t)i1 * 8192 + lbase[i1] + p1] = (unsigned)q | (1u << 16);
            if (u2) L[(size_t)i2 * 8192 + lbase[i2] + p2] = (unsigned)q | (2u << 16); }
        __syncthreads();
    }
}

__device__ __forceinline__ void softmax_step(f32x16& p, float& m, float& l, f32x16 (&acc)[4], h8& pb0, h8& pb1) {
    float mx = p[0];
#pragma unroll
    for (int r = 1; r < 16; ++r) mx = fmaxf(mx, p[r]);
    mx = fmaxf(mx, __shfl_xor(mx, 32));
    if (__any(mx > m)) {
        const float mn = fmaxf(m, mx); const float alpha = __builtin_amdgcn_exp2f(m - mn); m = mn; l *= alpha;
#pragma unroll
        for (int db = 0; db < 4; ++db)
#pragma unroll
            for (int r = 0; r < 16; ++r) acc[db][r] *= alpha; }
    float ps = 0.f;
#pragma unroll
    for (int r = 0; r < 16; ++r) { p[r] = __builtin_amdgcn_exp2f(p[r] - m); ps += p[r]; }
    l += ps;
    float t[8];
#pragma unroll
    for (int r = 0; r < 8; ++r) t[r] = p[r];
    pb0 = pack8(t);
#pragma unroll
    for (int r = 0; r < 8; ++r) t[r] = p[8 + r];
    pb1 = pack8(t);
}
__device__ __forceinline__ void pv_step(f32x16 (&acc)[4], const e16_t* vt, int vp, int hi, h8 pb0, h8 pb1) {
#pragma unroll
    for (int db = 0; db < 4; ++db) { const e16_t* vr = vt + (size_t)db * 32 * vp + 4 * hi;
        { const h4 lo = *(const h4*)(vr), hh = *(const h4*)(vr + 8); const h8 a = {lo[0], lo[1], lo[2], lo[3], hh[0], hh[1], hh[2], hh[3]}; acc[db] = MFMA32(a, pb0, acc[db]); }
        { const h4 lo = *(const h4*)(vr + 16), hh = *(const h4*)(vr + 24); const h8 a = {lo[0], lo[1], lo[2], lo[3], hh[0], hh[1], hh[2], hh[3]}; acc[db] = MFMA32(a, pb1, acc[db]); } }
}
__device__ __forceinline__ float store_o(const f32x16 (&acc)[4], float l, e16_t* yrow, int hi, bool valid = true) {
    l += __shfl_xor(l, 32); const float inv = 1.0f / l; if (!valid) return l;
#pragma unroll
    for (int db = 0; db < 4; ++db)
#pragma unroll
        for (int g = 0; g < 4; ++g) { u32x2 w; w.x = cvt_pk(acc[db][4 * g] * inv, acc[db][4 * g + 1] * inv); w.y = cvt_pk(acc[db][4 * g + 2] * inv, acc[db][4 * g + 3] * inv);
            *(u32x2*)(yrow + db * 32 + g * 8 + hi * 4) = w; }
    return l;
}

constexpr int LV_OFF = 65536, LV_PITCH = 520;
constexpr int LDS_CTL = 135168;
static_assert(LV_OFF + 128 * LV_PITCH <= LDS_CTL, "LDS map");
static_assert(256 * LV_PITCH <= LDS_CTL, "LDS map (memory attention V^T image)");

__device__ __forceinline__ void moba_wg(const Ctx& C, const float* gqa, int h, int j, int t, int ntile, int slot, bool valid, unsigned* q, int& knx) {
    int tid = C.tid; asm volatile("" : "+v"(tid));
    const int c = tid & 31, hi = (tid >> 5) & 1;
    const e16_t* Z = C.w16(WS_Z); const e16_t* ZT = C.w16(WS_ZT);
    LAS unsigned char* LK = C.lds; LAS unsigned char* LV = C.lds + LV_OFF;
    const float slope2 = __builtin_amdgcn_exp2f(-(float)(h + 1)) * LOG2E;
    h8 qf[8];
    { const e16_t* kg = Z + (size_t)(j * 256) * ZP + ZK + h * DA; const e16_t* vg = ZT + (size_t)(h * DA) * ZTP + j * 256;
      const e16_t* zq = Z + (size_t)t * ZP + ZQ + h * DA + hi * 8; h8 raw[8], kr[8], vr[8];
#pragma unroll
      for (int i = 0; i < 8; ++i) { const int row = i * 32 + (tid >> 4), ch = tid & 15; kr[i] = *(const h8*)(kg + (size_t)row * ZP + ch * 8); }
#pragma unroll
      for (int i = 0; i < 8; ++i) { const int idx = i * 512 + tid, d = idx >> 5, cc = idx & 31; vr[i] = *(const h8*)(vg + (size_t)d * ZTP + cc * 8); }
#pragma unroll
      for (int ks = 0; ks < 8; ++ks) raw[ks] = *(const h8*)(zq + ks * 16);
      float ss = 0.f;
#pragma unroll
      for (int ks = 0; ks < 8; ++ks)
#pragma unroll
          for (int jj = 0; jj < 8; ++jj) { const float f = up16(raw[ks][jj]); ss += f * f; }
      ss += __shfl_xor(ss, 32);
      const float sc = rsqrtf(ss * (1.f / DA) + EPS) * 0.08838834764831845f * LOG2E; const float* gq = gqa + hi * 8;
#pragma unroll
      for (int ks = 0; ks < 8; ++ks) { const f32x4 g0 = *(const f32x4*)(gq + ks * 16), g1 = *(const f32x4*)(gq + ks * 16 + 4); float f[8];
#pragma unroll
          for (int jj = 0; jj < 4; ++jj) { f[jj] = up16(raw[ks][jj]) * sc * g0[jj]; f[4 + jj] = up16(raw[ks][4 + jj]) * sc * g1[jj]; }
          qf[ks] = pack8(f); }
#pragma unroll
      for (int i = 0; i < 8; ++i) { const int row = i * 32 + (tid >> 4), ch = tid & 15; *(LAS h8*)(LK + row * 256 + ((ch ^ (row & 15)) << 4)) = kr[i]; }
#pragma unroll
      for (int i = 0; i < 8; ++i) { const int idx = i * 512 + tid, d = idx >> 5, cc = idx & 31; LAS h4* p = (LAS h4*)(LV + d * LV_PITCH + cc * 16);
          p[0] = (h4){vr[i][0], vr[i][1], vr[i][2], vr[i][3]}; p[1] = (h4){vr[i][4], vr[i][5], vr[i][6], vr[i][7]}; } }
    __syncthreads();
    if (tid == 0) knx = (int)atomicAdd(q, 1u);
    float m = -1e30f, lsum = 0.f; f32x16 acc[4];
#pragma unroll
    for (int db = 0; db < 4; ++db)
#pragma unroll
        for (int r = 0; r < 16; ++r) acc[db][r] = 0.f;
    const float NEG = -__builtin_inff();
    float sc[16];
#pragma unroll
    for (int r = 0; r < 16; ++r) sc[r] = slope2 * (float)crow(r, hi);
    for (int kt = 0; kt < ntile; ++kt) { const int kb = j * 256 + kt * 32;
        f32x16 p; const float base = slope2 * (float)(kb - t);
#pragma unroll
        for (int r = 0; r < 16; ++r) p[r] = sc[r] + base;
        const LAS unsigned char* kp = LK + (kt * 32 + c) * 256;
        h8 ka[8];
#pragma unroll
        for (int ks = 0; ks < 8; ++ks) ka[ks] = *(const LAS h8*)(kp + (((2 * ks + hi) ^ (c & 15)) << 4));
        u32x2 va[16];
#pragma unroll
        for (int db = 0; db < 4; ++db) { const LAS unsigned char* vp = LV + (db * 32 + c) * LV_PITCH + (kt * 32 + 4 * hi) * 2;
#pragma unroll
            for (int e = 0; e < 4; ++e) va[db * 4 + e] = *(const LAS u32x2*)(vp + 16 * e); }
        __builtin_amdgcn_sched_barrier(0);
#pragma unroll
        for (int ks = 0; ks < 8; ++ks) p = MFMA32(ka[ks], qf[ks], p);
        if (slot == 3 && kt == ntile - 1) {
#pragma unroll
            for (int r = 0; r < 16; ++r) { const int kpos = kb + crow(r, hi); p[r] = (kpos <= t) ? p[r] : NEG; } }
        h8 pb0, pb1; softmax_step(p, m, lsum, acc, pb0, pb1);
#pragma unroll
        for (int db = 0; db < 4; ++db) { const u32x4 a0 = {va[db * 4][0], va[db * 4][1], va[db * 4 + 1][0], va[db * 4 + 1][1]}, a1 = {va[db * 4 + 2][0], va[db * 4 + 2][1], va[db * 4 + 3][0], va[db * 4 + 3][1]};
            acc[db] = MFMA32(a0, pb0, acc[db]); acc[db] = MFMA32(a1, pb1, acc[db]); } }
    __syncthreads();
    if (ntile > 0) { e16_t* PART = C.w16(WS_PART); f32x2* ML = (f32x2*)(C.ws + WS_ML);
        const float lt = store_o(acc, lsum, PART + ((size_t)slot * S_ + t) * 1024 + h * DA, hi, valid);
        if (valid && hi == 0) ML[(size_t)(slot * HA + h) * S_ + t] = (f32x2){m, lt}; }
}
__device__ __forceinline__ void mem_wg(const Ctx& C, int l, const float* gqm, const float* gkm, int hm, int qb, unsigned* q, int& knx) {
    int tid = C.tid; asm volatile("" : "+v"(tid));
    const int c = tid & 31, hi = (tid >> 5) & 1, t = qb * 256 + C.wave * 32 + c;
    const e16_t* Z = C.w16(WS_Z); e16_t* Y = C.w16(WS_Y);
    const e16_t* KM = C.w16(WS_KM) + (size_t)l * NMEM * 1024 + hm * DMH; const e16_t* VMT = C.w16(WS_VMT) + (size_t)l * 1024 * NMEM + (size_t)(hm * DMH) * NMEM;
    LAS unsigned char* LK = C.lds;
    h8 qf[16]; float sbound;
    { h8 kr[16], raw[16]; const e16_t* zq = Z + (size_t)t * ZP + ZQM + hm * DMH + hi * 8;
#pragma unroll
      for (int i = 0; i < 16; ++i) { const int row = i * 16 + (tid >> 5), ch = tid & 31; kr[i] = *(const h8*)(KM + (size_t)row * 1024 + ch * 8); }
#pragma unroll
      for (int ks = 0; ks < 16; ++ks) raw[ks] = *(const h8*)(zq + ks * 16);
      const f32x4 gqv = *(const f32x4*)(gqm + 4 * (tid & 63)), gkv = *(const f32x4*)(gkm + 4 * (tid & 63));
#pragma unroll
      for (int i = 0; i < 16; ++i) { const int row = i * 16 + (tid >> 5), ch = tid & 31; *(LAS h8*)(LK + row * 512 + ((ch ^ (row & 15)) << 4)) = kr[i]; }
      float ss = 0.f;
#pragma unroll
      for (int ks = 0; ks < 16; ++ks)
#pragma unroll
          for (int j = 0; j < 8; ++j) { const float f = up16(raw[ks][j]); ss += f * f; }
      ss += __shfl_xor(ss, 32);
      { float a = fmaxf(fmaxf(fabsf(gqv.x), fabsf(gqv.y)), fmaxf(fabsf(gqv.z), fabsf(gqv.w))), b = fmaxf(fmaxf(fabsf(gkv.x), fabsf(gkv.y)), fmaxf(fabsf(gkv.z), fabsf(gkv.w)));
#pragma unroll
        for (int o = 1; o < 64; o <<= 1) { a = fmaxf(a, __shfl_xor(a, o)); b = fmaxf(b, __shfl_xor(b, o)); }
        sbound = 23.083f * 1.02f * a * b; }
#pragma unroll
      for (int ks = 0; ks < 16; ++ks) asm volatile("" : "+v"(raw[ks]));
      const float sc = rsqrtf(ss * (1.f / DMH) + EPS) * 0.0625f * LOG2E; const float* gq = gqm + hi * 8;
#pragma unroll
      for (int ks = 0; ks < 16; ++ks) { const f32x4 g0 = *(const f32x4*)(gq + ks * 16), g1 = *(const f32x4*)(gq + ks * 16 + 4); float f[8];
#pragma unroll
          for (int j = 0; j < 4; ++j) { f[j] = up16(raw[ks][j]) * sc * g0[j]; f[4 + j] = up16(raw[ks][4 + j]) * sc * g1[j]; }
          qf[ks] = pack8(f); } }
    __syncthreads();
    if (tid == 0) knx = (int)atomicAdd(q, 1u);
    h8 pb[8][2]; float lsum = 0.f;
    { float mx = -1e30f;
      const bool need_max = __builtin_amdgcn_readfirstlane(sbound > 90.f ? 1 : 0) != 0;
      if (!need_max) mx = 0.f;
#pragma unroll 1
      for (int kt = 0; kt < (need_max ? 8 : 0); ++kt) { f32x16 p;
#pragma unroll
          for (int r = 0; r < 16; ++r) p[r] = 0.f;
          const LAS unsigned char* kp = LK + (kt * 32 + c) * 512;
#pragma unroll
          for (int k8 = 0; k8 < 16; k8 += 8) { h8 ka[8];
#pragma unroll
              for (int ks = 0; ks < 8; ++ks) ka[ks] = *(const LAS h8*)(kp + (((2 * (k8 + ks) + hi) ^ (c & 15)) << 4));
              __builtin_amdgcn_sched_barrier(0);
#pragma unroll
              for (int ks = 0; ks < 8; ++ks) p = MFMA32(ka[ks], qf[k8 + ks], p); }
#pragma unroll
          for (int r = 0; r < 16; ++r) mx = fmaxf(mx, p[r]); }
      mx = fmaxf(mx, __shfl_xor(mx, 32));
#pragma unroll
      for (int kt = 0; kt < 8; ++kt) { f32x16 p; float tv[8];
#pragma unroll
          for (int r = 0; r < 16; ++r) p[r] = 0.f;
          const LAS unsigned char* kp = LK + (kt * 32 + c) * 512;
#pragma unroll
          for (int k8 = 0; k8 < 16; k8 += 8) { h8 ka[8];
#pragma unroll
              for (int ks = 0; ks < 8; ++ks) ka[ks] = *(const LAS h8*)(kp + (((2 * (k8 + ks) + hi) ^ (c & 15)) << 4));
              __builtin_amdgcn_sched_barrier(0);
#pragma unroll
              for (int ks = 0; ks < 8; ++ks) p = MFMA32(ka[ks], qf[k8 + ks], p); }
#pragma unroll
          for (int r = 0; r < 16; ++r) { p[r] = __builtin_amdgcn_exp2f(p[r] - mx); lsum += p[r]; }
#pragma unroll
          for (int r = 0; r < 8; ++r) tv[r] = p[r];
          pb[kt][0] = pack8(tv);
#pragma unroll
          for (int r = 0; r < 8; ++r) tv[r] = p[8 + r];
          pb[kt][1] = pack8(tv); } }
    lsum += __shfl_xor(lsum, 32);
    const float inv = 1.0f / lsum;
    __syncthreads();
    LAS unsigned char* LV = C.lds;
    { h8 vr[16];
#pragma unroll
      for (int i = 0; i < 16; ++i) { const int idx = i * 512 + tid, d = idx >> 5, cc = idx & 31; vr[i] = *(const h8*)(VMT + (size_t)d * NMEM + cc * 8); }
#pragma unroll
      for (int i = 0; i < 16; ++i) { const int idx = i * 512 + tid, d = idx >> 5, cc = idx & 31; LAS h4* pp = (LAS h4*)(LV + d * LV_PITCH + cc * 16);
          pp[0] = (h4){vr[i][0], vr[i][1], vr[i][2], vr[i][3]}; pp[1] = (h4){vr[i][4], vr[i][5], vr[i][6], vr[i][7]}; }
      asm volatile("" ::: "memory"); }
    __syncthreads();
    e16_t* yrow = Y + (size_t)t * YP + 2048 + hm * DMH;
#pragma unroll 1
    for (int dh = 0; dh < 2; ++dh) { f32x16 acc[4];
#pragma unroll
        for (int db = 0; db < 4; ++db)
#pragma unroll
            for (int r = 0; r < 16; ++r) acc[db][r] = 0.f;
#pragma unroll
        for (int kt = 0; kt < 8; ++kt) { u32x2 va[16];
#pragma unroll
            for (int db = 0; db < 4; ++db) { const LAS unsigned char* vp = LV + ((dh * 4 + db) * 32 + c) * LV_PITCH + (kt * 32 + 4 * hi) * 2;
#pragma unroll
                for (int e = 0; e < 4; ++e) va[db * 4 + e] = *(const LAS u32x2*)(vp + 16 * e); }
            __builtin_amdgcn_sched_barrier(0);
#pragma unroll
            for (int db = 0; db < 4; ++db) { const u32x4 a0 = {va[db * 4][0], va[db * 4][1], va[db * 4 + 1][0], va[db * 4 + 1][1]}, a1 = {va[db * 4 + 2][0], va[db * 4 + 2][1], va[db * 4 + 3][0], va[db * 4 + 3][1]};
                acc[db] = MFMA32(a0, pb[kt][0], acc[db]); acc[db] = MFMA32(a1, pb[kt][1], acc[db]); } }
#pragma unroll
        for (int db = 0; db < 4; ++db)
#pragma unroll
            for (int g = 0; g < 4; ++g) { u32x2 w; w.x = cvt_pk(acc[db][4 * g] * inv, acc[db][4 * g + 1] * inv); w.y = cvt_pk(acc[db][4 * g + 2] * inv, acc[db][4 * g + 3] * inv);
                *(u32x2*)(yrow + dh * 128 + db * 32 + g * 8 + hi * 4) = w; } }
    __syncthreads();
}
__device__ __forceinline__ void attn_combine_phase(const Ctx& C) {
    const e16_t* PART = C.w16(WS_PART); const f32x2* ML = (const f32x2*)(C.ws + WS_ML); e16_t* Y = C.w16(WS_Y);
    const int hh = C.lane >> 3, d0 = hh * DA + 16 * (C.lane & 7);
    const unsigned* SEL = (const unsigned*)(C.ws + WS_SEL);
    for (int tb = C.gw; tb < S_; tb += 2 * C.NGW) {
        int tt[2]; unsigned on[2]; f32x2 ml[2][4]; h8 pa[2][4], pb[2][4];
#pragma unroll
        for (int r = 0; r < 2; ++r) { tt[r] = (tb + r * C.NGW < S_) ? tb + r * C.NGW : tb; const int np = (tt[r] >> 8) < 3 ? (tt[r] >> 8) : 3; const unsigned skip = SEL[(size_t)hh * S_ + tt[r]];
            on[r] = 8u | (((1u << np) - 1u) & ~skip); }
#pragma unroll
        for (int r = 0; r < 2; ++r)
#pragma unroll
            for (int sl = 0; sl < 4; ++sl) { const int se = ((on[r] >> sl) & 1u) ? sl : 3; ml[r][sl] = ML[(size_t)(se * HA + hh) * S_ + tt[r]];
                const e16_t* pr = PART + ((size_t)se * S_ + tt[r]) * 1024 + d0; pa[r][sl] = *(const h8*)pr; pb[r][sl] = *(const h8*)(pr + 8); }
#pragma unroll
        for (int r = 0; r < 2; ++r) { float M = -1e30f;
#pragma unroll
            for (int sl = 0; sl < 4; ++sl) if ((on[r] >> sl) & 1u) M = fmaxf(M, ml[r][sl].x);
            float w[4], W = 0.f;
#pragma unroll
            for (int sl = 0; sl < 4; ++sl) { w[sl] = ((on[r] >> sl) & 1u) ? ml[r][sl].y * __builtin_amdgcn_exp2f(ml[r][sl].x - M) : 0.f; W += w[sl]; }
            const float iw = 1.0f / W; float o[16];
#pragma unroll
            for (int i = 0; i < 16; ++i) o[i] = 0.f;
#pragma unroll
            for (int sl = 0; sl < 4; ++sl) { const float ws = w[sl] * iw;
#pragma unroll
                for (int i = 0; i < 8; ++i) { o[i] += ws * up16(pa[r][sl][i]); o[8 + i] += ws * up16(pb[r][sl][i]); } }
            if (r == 0 || tb + C.NGW < S_) { *(h8*)(Y + (size_t)tt[r] * YP + d0) = pack8(o); *(h8*)(Y + (size_t)tt[r] * YP + d0 + 8) = pack8(o + 8); } }
    }
}
__device__ __forceinline__ void sgu_item(const Ctx& C, const float* wsgu, const float* bsgu, const float* gsgu, int n, int g, int w, unsigned* q, int& knx) {
    int ln = C.lane; asm volatile("" : "+v"(ln));
    const int c = ln & 31, hi = ln >> 5, tt = w & 3, cp = w >> 2, tl = 32 * tt + c, t = 128 * n + tl;
    const e16_t* Z = C.w16(WS_Z); const e16_t* ZT = C.w16(WS_ZT); e16_t* Y = C.w16(WS_Y); const float* RSTDV = (const float*)(C.ws + WS_RSTDV);
    const float* wrow = wsgu + ((size_t)g * 128 + tl) * 128;
    f32x16 a0, a1;
#pragma unroll
    for (int r = 0; r < 16; ++r) { a0[r] = 0.f; a1[r] = 0.f; }
    const e16_t* gv0 = ZT + (size_t)(1024 + g * 128 + (2 * cp) * 32 + c) * ZTP + 128 * n + 8 * hi; const e16_t* gv1 = gv0 + (size_t)32 * ZTP;
#pragma unroll
    for (int kh = 0; kh < 2; ++kh) {
        if (kh == 1 && tt < 2) break;
        f32x4 wv[4][2], rv[4][2]; h8 xv[4][2];
#pragma unroll
        for (int k4 = 0; k4 < 4; ++k4) { const int s0 = 16 * (kh * 4 + k4) + 8 * hi;
            wv[k4][0] = *(const f32x4*)(wrow + s0); wv[k4][1] = *(const f32x4*)(wrow + s0 + 4);
            rv[k4][0] = *(const f32x4*)(RSTDV + 128 * n + s0); rv[k4][1] = *(const f32x4*)(RSTDV + 128 * n + s0 + 4);
            xv[k4][0] = *(const h8*)(gv0 + (kh * 4 + k4) * 16); xv[k4][1] = *(const h8*)(gv1 + (kh * 4 + k4) * 16); }
#pragma unroll
        for (int k4 = 0; k4 < 4; ++k4) { const int s0 = 16 * (kh * 4 + k4) + 8 * hi; float f[8];
#pragma unroll
            for (int j = 0; j < 4; ++j) { f[j] = (s0 + j <= tl) ? wv[k4][0][j] * rv[k4][0][j] : 0.f; f[4 + j] = (s0 + 4 + j <= tl) ? wv[k4][1][j] * rv[k4][1][j] : 0.f; }
            const h8 bf = pack8(f); a0 = MFMA32(xv[k4][0], bf, a0); a1 = MFMA32(xv[k4][1], bf, a1); } }
    const float bias = bsgu[g * 128 + tl]; const float* gs = gsgu;
    h4 urv[2][4]; f32x4 ggv[2][4];
#pragma unroll
    for (int cbi = 0; cbi < 2; ++cbi)
#pragma unroll
        for (int gq = 0; gq < 4; ++gq) { const int col = g * 128 + (2 * cp + cbi) * 32 + 8 * gq + 4 * hi; urv[cbi][gq] = *(const h4*)(Z + (size_t)t * ZP + ZU + col); ggv[cbi][gq] = *(const f32x4*)(gs + col); }
    if (w == 0 && ln == 0) knx = (int)atomicAdd(q, 1u);
#pragma unroll
    for (int cbi = 0; cbi < 2; ++cbi)
#pragma unroll
        for (int gq = 0; gq < 4; ++gq) { const int col = g * 128 + (2 * cp + cbi) * 32 + 8 * gq + 4 * hi; const h4 ur = urv[cbi][gq]; const f32x4 gg = ggv[cbi][gq]; float o[4];
#pragma unroll
            for (int i = 0; i < 4; ++i) { const float mix = gg[i] * (cbi == 0 ? a0[4 * gq + i] : a1[4 * gq + i]) + bias; o[i] = gelu_tanh(up16(ur[i])) * mix; }
            u32x2 wv; wv.x = cvt_pk(o[0], o[1]); wv.y = cvt_pk(o[2], o[3]); *(u32x2*)(Y + (size_t)t * YP + 1024 + col) = wv; }
}
#define XB_TMO      128
#define XB_XCNT(j)  (256  + 64 * (j))
#define XB_XSUB(j)  (1280 + 64 * (j))
#define XB_XGEN(j)  (2304 + 64 * (j))
#define XB_TOP      3328
#define XB_TOPGEN   3392
#define XCD_BAR_WORDS 3456
#define XB_SPIN_CAP (1u << 18)
constexpr int CW_BAR = 4096;
__device__ __forceinline__ unsigned xb_ld(unsigned* p)              { return __hip_atomic_load(p, __ATOMIC_RELAXED, __HIP_MEMORY_SCOPE_AGENT); }
__device__ __forceinline__ unsigned xb_add(unsigned* p, unsigned v) { return __hip_atomic_fetch_add(p, v, __ATOMIC_RELAXED, __HIP_MEMORY_SCOPE_AGENT); }
__device__ __forceinline__ unsigned xb_xcc_id() { return (unsigned)__builtin_amdgcn_s_getreg((3 << 11) | 20) & 0xFu; }
#define XB_SPIN(cond, bar) do { unsigned _sp = 0; while (cond) { __builtin_amdgcn_s_sleep(1); \
    if ((++_sp & 255u) == 0u) { if (xb_ld(&(bar)[XB_TMO])) break; if (_sp > XB_SPIN_CAP) { atomicAdd(&(bar)[XB_TMO], 1u); break; } } } } while (0)
struct XcdBarrier { unsigned* bar; unsigned x; volatile LAS unsigned* st; };
__device__ __forceinline__ XcdBarrier xcd_barrier_post(unsigned* bar, volatile LAS unsigned* st) {
    XcdBarrier b; b.bar = bar; b.x = xb_xcc_id(); b.st = st;
    if (threadIdx.x == 0) (void)xb_add(&bar[XB_XCNT(b.x)], 1u);
    return b;
}
__device__ __forceinline__ void xcd_barrier_complete(unsigned* bar, unsigned x, unsigned& nloc, unsigned& nx) {
    const unsigned G = gridDim.x * gridDim.y * gridDim.z;
    unsigned sum, cnt, mine, sp = 0u;
    for (;;) {
        sum = 0u; cnt = 0u; mine = 0u;
#pragma unroll
        for (unsigned j = 0; j < 16; ++j) { const unsigned c = xb_ld(&bar[XB_XCNT(j)]); sum += c; cnt += (c > 0u) ? 1u : 0u; mine = (j == x) ? c : mine; }
        if (sum == G) break;
        __builtin_amdgcn_s_sleep(1);
        if ((++sp & 255u) == 0u) { if (xb_ld(&bar[XB_TMO])) break; if (sp > XB_SPIN_CAP) { atomicAdd(&bar[XB_TMO], 1u); break; } }
    }
    nloc = mine > 0u ? mine : 1u; nx = cnt > 0u ? cnt : 1u;
}
__device__ __forceinline__ void xcd_barrier(const XcdBarrier& b) {
    asm volatile("s_waitcnt vmcnt(0)" ::: "memory");
    __syncthreads();
    if (threadIdx.x == 0) {
        unsigned* bar = b.bar; asm volatile("" : "+s"(bar));
        __builtin_amdgcn_s_waitcnt(0);
        unsigned nloc = b.st[0], nx = b.st[1];
        if (nloc == 0u) { xcd_barrier_complete(bar, b.x, nloc, nx); b.st[0] = nloc; b.st[1] = nx; }
        const unsigned old = xb_add(&bar[XB_XSUB(b.x)], 1u);
        const unsigned gen = old / nloc;
        if (old + 1u == (gen + 1u) * nloc) {
            __builtin_amdgcn_fence(__ATOMIC_RELEASE, "agent");
            asm volatile("s_waitcnt vmcnt(0)" ::: "memory");
            const unsigned og = xb_add(&bar[XB_TOP], 1u);
            const unsigned tg = og / nx;
            if (og + 1u == (tg + 1u) * nx) xb_add(&bar[XB_TOPGEN], 1u);
            else XB_SPIN(xb_ld(&bar[XB_TOPGEN]) == tg, bar);
            __builtin_amdgcn_fence(__ATOMIC_ACQUIRE, "agent");
            xb_add(&bar[XB_XGEN(b.x)], 1u);
            asm volatile("s_waitcnt vmcnt(0)" ::: "memory");
        } else {
            XB_SPIN(xb_ld(&bar[XB_XGEN(b.x)]) == gen, bar);
            __builtin_amdgcn_fence(__ATOMIC_ACQUIRE, "agent");
            asm volatile("s_waitcnt vmcnt(0)" ::: "memory");
        }
    }
    __syncthreads();
}

constexpr int CW_SEAM = 16384;
constexpr int CW_SPLIT = 12288;
struct SplitBar { unsigned* ctr; unsigned* bar; unsigned x; volatile LAS unsigned* st; };
__device__ __forceinline__ void split_arrive(const SplitBar& b) {
    asm volatile("s_waitcnt vmcnt(0)" ::: "memory");
    __syncthreads();
    if (threadIdx.x == 0) { unsigned nloc = b.st[0];
        if (nloc == 0u) { unsigned nx; __builtin_amdgcn_s_waitcnt(0); xcd_barrier_complete(b.bar, b.x, nloc, nx); b.st[0] = nloc; b.st[1] = nx; }
        const unsigned old = xb_add(b.ctr + 32 * b.x, 1u);
        if (old + 1u == nloc) { __builtin_amdgcn_fence(__ATOMIC_RELEASE, "agent"); asm volatile("s_waitcnt vmcnt(0)" ::: "memory"); (void)xb_add(b.ctr + 32 * 16, nloc); } }
}
__device__ __forceinline__ void split_wait(const SplitBar& b) {
    if (threadIdx.x == 0) { const unsigned G = gridDim.x; XB_SPIN(xb_ld(b.ctr + 32 * 16) != G, b.bar); __builtin_amdgcn_fence(__ATOMIC_ACQUIRE, "agent"); asm volatile("s_waitcnt vmcnt(0)" ::: "memory"); }
    __syncthreads();
}
struct MixP { const float *gqa, *gqm, *gkm, *wsgu, *bsgu, *gsgu; };
__device__ __forceinline__ void mixer_phase(const Ctx& C, int l, const MixP& P, const XcdBarrier& xb) {
    unsigned* ctl = (unsigned*)(C.ws + WS_CTL);
    const SplitBar b1{ctl + CW_SPLIT + 544 * (2 * l), ctl + CW_BAR, xb.x, xb.st}, b2{ctl + CW_SPLIT + 544 * (2 * l + 1), ctl + CW_BAR, xb.x, xb.st};
    const unsigned* CNT = (const unsigned*)(C.ws + WS_CTL) + CW_CNT + l * 256; const unsigned* LIST = (const unsigned*)(C.ws + WS_LIST);
    LAS unsigned* pre = (LAS unsigned*)(C.lds + LDS_CTL + 256);
    LAS unsigned* nch = pre + 256; LAS int* bc = (LAS int*)(C.lds + LDS_CTL + 64); LAS unsigned* cntl = (LAS unsigned*)(C.lds + LDS_CTL + 2816);
    const int myq = (int)(__builtin_amdgcn_s_getreg((3 << 11) | 20) & 7u);
    constexpr int N_OWNWG = HA * NBLK, N_MEMWG = HM * NBLK, N_SGUWG = 64 * 8;
    split_arrive(b1);
    int npast = 0;
#pragma unroll 1
    for (int st = 0; st < 3; ++st) {
        int kfirst = 0; if (C.tid == 0) kfirst = (int)atomicAdd(ctl + 8192 + 64 * ((l * 3 + st) * 8) + 64 * myq, 1u);
        if (st == 1) { split_wait(b1);
            int tq = C.tid; asm volatile("" : "+v"(tq));
            if (tq < 256) { const unsigned cn = CNT[tq]; cntl[tq] = cn; nch[tq] = (cn + 255u) >> 8; }
            __syncthreads();
            if (tq < 256) { unsigned sum = 0u; for (int k = 0; k < 256; ++k) { const unsigned v = nch[k]; sum += (k <= tq) ? v : 0u; } pre[tq] = sum; }
            __syncthreads();
            npast = (int)pre[255]; }
        if (st == 2) split_arrive(b2);
        unsigned* qbase = ctl + 8192 + 64 * ((l * 3 + st) * 8);
        const int nA = st == 0 ? N_OWNWG : (st == 1 ? N_MEMWG : N_SGUWG), nB = st == 1 ? npast : 0;
#define QTOT(x_) (((nA * ((x_) + 1)) >> 3) - ((nA * (x_)) >> 3) + (int)(((long)nB * ((x_) + 1)) >> 3) - (int)(((long)nB * (x_)) >> 3))
        int x = myq;
        for (;;) { unsigned* q = qbase + 64 * x;
            const int a_lo = (nA * x) >> 3, a_n = ((nA * (x + 1)) >> 3) - a_lo;
            const int p_lo = (int)(((long)nB * x) >> 3), p_n = (int)(((long)nB * (x + 1)) >> 3) - p_lo;
            const int ntot = a_n + p_n;
            int knx = kfirst; if (C.tid == 0 && x != myq) knx = (int)atomicAdd(q, 1u);
            for (;;) { if (C.tid == 0) bc[0] = knx;
                __syncthreads(); int k = bc[0]; __syncthreads();
                if (k >= ntot) break;
                if (st == 2) { const int jj = a_lo + k; sgu_item(C, P.wsgu, P.bsgu, P.gsgu, jj >> 3, jj & 7, C.wave, q, knx); continue; }
                if (st == 1 && k < a_n) { const int jj = a_lo + k; mem_wg(C, l, P.gqm, P.gkm, jj >> 5, jj & 31, q, knx); continue; }
                int h_, j_, t_, nt_, sl_; bool va_;
                if (st == 1) { const int it = p_lo + (k - a_n);
                    int lo = 0, hi2 = 255;
                    while (lo < hi2) { const int mid = (lo + hi2) >> 1; if ((int)pre[mid] > it) hi2 = mid; else lo = mid + 1; }
                    const int hj = __builtin_amdgcn_readfirstlane(lo), chunk = it - (hj ? (int)pre[hj - 1] : 0), n = (int)cntl[hj];
                    const int e0 = chunk * 256 + C.wave * 32, e = e0 + (C.lane & 31); va_ = e < n;
                    const unsigned ent = LIST[(size_t)hj * 8192 + (va_ ? e : chunk * 256)];
                    h_ = hj >> 5; j_ = hj & 31; t_ = (int)(ent & 0xffffu); nt_ = e0 < n ? 8 : 0; sl_ = (int)(ent >> 16);
                } else { const int jj = a_lo + k;
                    const int qt = C.wave < 4 ? C.wave : 11 - C.wave;
                    h_ = jj >> 5; j_ = 31 - (jj & 31); t_ = j_ * 256 + qt * 32 + (C.lane & 31); nt_ = qt + 1; sl_ = 3; va_ = true; }
                moba_wg(C, P.gqa, h_, j_, t_, nt_, sl_, va_, q, knx); }
            if (C.tid == 0) { unsigned cv[8];
#pragma unroll
                for (int y = 0; y < 8; ++y) cv[y] = __hip_atomic_load(qbase + 64 * y, __ATOMIC_RELAXED, __HIP_MEMORY_SCOPE_AGENT);
                int nxq = -1;
#pragma unroll
                for (int sq = 7; sq >= 1; --sq) { const int y = (myq + sq) & 7; if ((int)cv[y] < QTOT(y)) nxq = y; }
                bc[1] = nxq; }
            __syncthreads(); x = bc[1]; __syncthreads();
            if (x < 0) break;
        }
#undef QTOT
    }
    split_wait(b2);
}

#define INP(k) ((const float*)(((unsigned long long)(unsigned)__builtin_amdgcn_readfirstlane((int)((volatile LAS unsigned*)(C.lds + LDS_CTL + 2560))[2 * (k) + 1]) << 32) | (unsigned long long)(unsigned)__builtin_amdgcn_readfirstlane((int)((volatile LAS unsigned*)(C.lds + LDS_CTL + 2560))[2 * (k)])))
__global__ void __launch_bounds__(NTHREADS, 2) fwd_kernel(Args args) {
    extern __shared__ __attribute__((aligned(16))) unsigned char lds_raw[];
    cg::grid_group grid = cg::this_grid();
    Ctx C; C.lds = (LAS unsigned char*)lds_raw; C.tid = threadIdx.x; C.lane = C.tid & 63; C.wave = __builtin_amdgcn_readfirstlane(C.tid >> 6);
    C.G = gridDim.x; C.gw = blockIdx.x * NWAVES + C.wave; C.NGW = C.G * NWAVES;
    C.out = args.out; C.ws = args.ws;
    const int lo = args.ph_lo, hi = args.ph_hi;
    const int wave0 = __builtin_amdgcn_readfirstlane(threadIdx.x >> 6);
    volatile LAS unsigned* bst = (volatile LAS unsigned*)(C.lds + LDS_CTL);
    if (threadIdx.x < 2) bst[threadIdx.x] = 0u;
    if (threadIdx.x < 18) ((LAS unsigned long long*)(C.lds + LDS_CTL + 2560))[threadIdx.x] = (unsigned long long)args.in[threadIdx.x];
    __syncthreads();
    const XcdBarrier xbar = xcd_barrier_post((unsigned*)(args.ws + WS_CTL) + CW_BAR, bst);
    LAS unsigned char* ring = C.lds;
#pragma unroll 1
    for (int ph = lo; ph < hi; ++ph) {
#define REFRESH_TID do { int w0_ = wave0; asm volatile("" : "+s"(w0_)); int tid_ = w0_ * 64 + (int)__builtin_amdgcn_mbcnt_hi(~0u, __builtin_amdgcn_mbcnt_lo(~0u, 0u)); asm volatile("" : "+v"(tid_)); C.tid = tid_; C.lane = tid_ & 63; C.wave = w0_; } while (0)
        REFRESH_TID;
        int bx = blockIdx.x; asm volatile("" : "+s"(bx)); C.gw = bx * NWAVES + C.wave; size_t zo_ = 0; asm volatile("" : "+s"(zo_)); C.ws = args.ws + zo_; C.out = args.out + zo_;
        int l = ph == 0 ? 0 : (ph - 1) / 6, kp = ph == 0 ? -1 : (ph - 1) % 6; asm volatile("" : "+s"(l), "+s"(kp));
        int cj = -1, cslot = 0, cstride = 1;
        if (kp < 0) {
            for (int pl = 0; pl < NLAYER; ++pl) rms_rows(C, INP(1), INP(11) + pl * D_, C.w16(WS_MEMN) + (size_t)pl * NMEM * D_, NMEM);
            { fx_t* RSS = (fx_t*)(C.ws + WS_RSS); xb_rows(C, INP(0), C.w16(WS_HN), RSS, S_, C.w16(WS_X8));
              for (int i = bx * NTHREADS + C.tid; i < 3 * S_; i += C.G * NTHREADS) RSS[S_ + i] = 0ull;
              fx_t* RSSV = (fx_t*)(C.ws + WS_RSSV); for (int i = bx * NTHREADS + C.tid; i < S_; i += C.G * NTHREADS) RSSV[i] = 0ull;
              unsigned* ONES = (unsigned*)(C.ws + WS_ONES);
_Pragma("unroll 1")
              for (int b = bx; b < 64; b += C.G) ONES[b * NTHREADS + C.tid] = 0x3F803F80u; }
            cj = 0; cslot = C.gw; cstride = C.NGW;
        } else if (kp == 0) {
            { pg8::Gemm g{C.w16(WS_HN), C.wl(l, WL_IN), S_, 4096, D_, D_, D_}; pg8::StaticOrder S; S.init(S_, 4096, C.G, bx); pg8::EpiZ E{C.w16(WS_Z), C.w16(WS_GATE), (const pg8::fx_t*)(C.ws + WS_RSS) + (size_t)(2 * l) * S_, C.lds, INP(5) + l * DA, (float*)(C.ws + WS_KMEAN), 0};
              pg8::gemm_phase<pg8::EpiZ, pg8::StaticOrder>(ring, C.tid, g, S, E); }
            REFRESH_TID;
            { int k8 = D_ / 2; asm volatile("" : "+s"(k8));
              pg8::Gemm g{C.w16(WS_X8), C.wl(l, WL_IN) + (size_t)4096 * D_, S_, 6144, k8, D_ / 2, D_ / 2}; pg8::StaticOrder S; S.init(S_, 6144, C.G, bx); pg8::EpiGate E{C.w16(WS_GATE), (const pg8::fx_t*)(C.ws + WS_RSS) + (size_t)(2 * l) * S_, C.lds};
              pg8::gemm_phase<pg8::EpiGate, pg8::StaticOrder, true, true, true>(ring, C.tid, g, S, E); }
            REFRESH_TID;
            { pg8::Gemm g{C.wl(l, WL_IN) + (size_t)ZN * D_, C.w16(WS_HN), 2048, S_, D_, D_, D_}; pg8::StaticOrder S; S.init(2048, S_, C.G, bx); pg8::EpiStore16 E{C.w16(WS_ZT), ZTP, (const pg8::fx_t*)(C.ws + WS_RSS) + (size_t)(2 * l) * S_, 2, (pg8::fx_t*)(C.ws + WS_RSSV)};
              pg8::gemm_phase<pg8::EpiStore16, pg8::StaticOrder>(ring, C.tid, g, S, E); }
            if (l == 0) for (int ll = 0; ll < NLAYER; ++ll) {
                REFRESH_TID;
                { pg8::Gemm g{C.w16(WS_MEMN) + (size_t)ll * NMEM * D_, C.wl(ll, WL_M), NMEM, 1024, D_, D_, D_}; pg8::StaticOrder S; S.init(NMEM, 1024, C.G, (bx + C.G - 8 * ll) % C.G);
                  pg8::EpiStore16 E{C.w16(WS_KM) + (size_t)ll * NMEM * 1024, 1024, nullptr, 0, nullptr}; pg8::gemm_phase<pg8::EpiStore16, pg8::StaticOrder>(ring, C.tid, g, S, E); }
                REFRESH_TID;
                { pg8::Gemm g{C.wl(ll, WL_M) + (size_t)1024 * D_, C.w16(WS_MEMN) + (size_t)ll * NMEM * D_, 1024, NMEM, D_, D_, D_}; pg8::StaticOrder S; S.init(1024, NMEM, C.G, (bx + C.G - 8 * ll - 4) % C.G);
                  pg8::EpiStore16 E{C.w16(WS_VMT) + (size_t)ll * 1024 * NMEM, NMEM, nullptr, 0, nullptr}; pg8::gemm_phase<pg8::EpiStore16, pg8::StaticOrder>(ring, C.tid, g, S, E); } }
            if (l == 0 && bx >= 16) { cj = 1; cslot = (bx - 16) * NWAVES + C.wave; cstride = (C.G - 16) * NWAVES; }
        } else if (kp == 1) {
            if (l == 0) kmnorm_phase(C, INP(10));
            { const fx_t* RSSV = (const fx_t*)(C.ws + WS_RSSV); float* RSTDV = (float*)(C.ws + WS_RSTDV); for (int i = bx * NTHREADS + C.tid; i < S_; i += C.G * NTHREADS) RSTDV[i] = rsqrtf(fx2f(RSSV[i]) * (1.f / 1024.f) + EPS); }
            gating_phase(C, l, INP(4) + l * DA, INP(5) + l * DA);
            { MixP P{INP(4) + l * DA, INP(9) + l * DMH, INP(10) + l * DMH, INP(7) + (size_t)l * 8 * 128 * 128, INP(8) + l * 8 * 128, INP(6) + l * 1024}; mixer_phase(C, l, P, xbar); }
            attn_combine_phase(C);
        } else if (kp == 2) {
            { pg8::Gemm g{C.w16(WS_Y), C.wl(l, WL_B), S_, D_, 3072, YP, 3072}; pg8::StaticOrder S; S.init(S_, D_, C.G, bx); pg8::EpiMerge E{C.w16(WS_GATE), C.w16(WS_MG)};
              pg8::gemm_phase<pg8::EpiMerge, pg8::StaticOrder>(ring, C.tid, g, S, E); }
        } else if (kp == 3) {
            { pg8::Gemm g{C.w16(WS_MG), C.wl(l, WL_O), S_, D_, D_, D_, D_}; pg8::StaticOrder S; S.init(S_, D_, C.G, bx); pg8::EpiRes E{INP(0), l == 0 ? (const e16_t*)nullptr : (const e16_t*)C.w16(WS_HN), nullptr, C.w16(WS_HN), (pg8::fx_t*)(C.ws + WS_RSS) + (size_t)(2 * l + 1) * S_, D_, nullptr};
              pg8::gemm_phase<pg8::EpiRes, pg8::StaticOrder>(ring, C.tid, g, S, E); }
        } else if (kp == 4) {
            { pg8::Gemm g{C.w16(WS_HN), C.wl(l, WL_GU), S_, 2 * DFF, D_, D_, D_}; pg8::StaticOrder S; S.init(S_, 2 * DFF, C.G, bx); pg8::EpiSwiGLU E{C.w16(WS_GATE), DFF, (const pg8::fx_t*)(C.ws + WS_RSS) + (size_t)(2 * l + 1) * S_, C.lds};
              pg8::gemm_phase<pg8::EpiSwiGLU, pg8::StaticOrder>(ring, C.tid, g, S, E); }
            if (bx >= C.G / 2) { cj = 2 + l; cslot = (bx - C.G / 2) * NWAVES + C.wave; cstride = (C.G / 2) * NWAVES; }
        } else {
            if (bx == 0 && l + 1 < NLAYER) { fx_t* RSSV = (fx_t*)(C.ws + WS_RSSV); for (int i = C.tid; i < S_; i += NTHREADS) RSSV[i] = 0ull; }
            { pg8::Gemm g{C.w16(WS_GATE), C.wl(l, WL_D), S_, D_, DFF, DFF, DFF}; pg8::StaticOrder S; S.init(S_, D_, C.G, bx); pg8::EpiRes E{nullptr, C.w16(WS_HN), l + 1 < NLAYER ? (float*)nullptr : C.out, l + 1 < NLAYER ? C.w16(WS_HN) : (e16_t*)nullptr, l + 1 < NLAYER ? (pg8::fx_t*)(C.ws + WS_RSS) + (size_t)(2 * l + 2) * S_ : (pg8::fx_t*)nullptr, D_, l + 1 < NLAYER ? C.w16(WS_X8) : (e16_t*)nullptr};
              pg8::gemm_phase<pg8::EpiRes, pg8::StaticOrder>(ring, C.tid, g, S, E); }
        }
        REFRESH_TID;
        const bool seam = ph + 1 < hi, fill = seam && ph < 10;
        unsigned* ctl_ = (unsigned*)C.ws; const SplitBar sb_{ctl_ + CW_SEAM + 544 * (ph < 10 ? ph : 0), ctl_ + CW_BAR, xbar.x, xbar.st};
        int chi = 1 << 20;
#pragma unroll 1
        for (int r = 0; r < 2; ++r) {
            if (r == 1) { if (!fill) break; split_arrive(sb_); cj = 4; cslot = ph * 2048 + C.gw; cstride = C.NGW; chi = 1; }
            if (cj >= 0) convert_job(args, C, cj, cslot, cstride, 0, chi, (LAS float*)(C.lds + C.wave * 16384)); }
        if (seam) { if (hi < 0) grid.sync(); if (fill) split_wait(sb_); else xcd_barrier(xbar); }
    }
}
constexpr int N_PHASES = 1 + NLAYER * 6;

extern "C" void kernel_launch(void* const* d_in, const int* in_sizes, int n_in, void* d_out, int out_size, void* d_ws, size_t ws_size, hipStream_t stream) {
    static int grid = 0;
    if (grid == 0) {
        if (n_in != 18 || in_sizes[0] != S_ * D_ || out_size != S_ * D_ || ws_size < WS_END) {
            fprintf(stderr, "kernel_launch: unexpected shapes / workspace (n_in %d, in0 %d, out %d, ws %zu, need %zu); nothing launched\n", n_in, n_in > 0 ? in_sizes[0] : -1, out_size, ws_size, (size_t)WS_END); grid = -1; return; }
        int dev = 0, cus = 0, per_cu = 0;
        if (hipGetDevice(&dev) != hipSuccess || hipDeviceGetAttribute(&cus, hipDeviceAttributeMultiprocessorCount, dev) != hipSuccess) { grid = -1; return; }
        if (hipFuncSetAttribute((const void*)fwd_kernel, hipFuncAttributeMaxDynamicSharedMemorySize, LDS_BYTES) != hipSuccess) { fprintf(stderr, "kernel_launch: hipFuncSetAttribute failed\n"); grid = -1; return; }
        if (hipOccupancyMaxActiveBlocksPerMultiprocessor(&per_cu, (const void*)fwd_kernel, NTHREADS, LDS_BYTES) != hipSuccess || per_cu < 1) { fprintf(stderr, "kernel_launch: occupancy query says %d\n", per_cu); per_cu = 1; }
        (void)hipGetLastError();
        grid = cus * 1;
        fprintf(stderr, "kernel_launch: grid %d (cus %d, per_cu %d), ws %zu\n", grid, cus, per_cu, ws_size);
    }
    if (grid < 0) return;
    (void)hipMemsetAsync((char*)d_ws + WS_CTL, 0, 131072, stream);
    Args a{};
    for (int i = 0; i < 18; ++i) a.in[i] = (const float*)d_in[i];
    a.out = (float*)d_out; a.ws = (unsigned char*)d_ws; a.ph_lo = 0; a.ph_hi = N_PHASES;
    void* kargs[] = {&a};
    hipError_t e = hipLaunchCooperativeKernel((const void*)fwd_kernel, dim3(grid), dim3(NTHREADS), kargs, LDS_BYTES, stream);
    if (e != hipSuccess) fprintf(stderr, "kernel_launch: cooperative launch failed: %s (grid %d)\n", hipGetErrorString(e), grid);
}
```

```cpp
#include <hip/hip_runtime.h>
#include <hip/hip_cooperative_groups.h>
#include <cstdio>
#include <cstdint>
namespace cg = cooperative_groups;

#define LAS __attribute__((address_space(3)))
#define GAS __attribute__((address_space(1)))
typedef unsigned short e16_t;
typedef short h8 __attribute__((ext_vector_type(8)));
typedef short h4 __attribute__((ext_vector_type(4)));
typedef __bf16 mf8 __attribute__((ext_vector_type(8)));
typedef __bf16 mf2 __attribute__((ext_vector_type(2)));
typedef float f32x2 __attribute__((ext_vector_type(2)));
typedef float f32x4 __attribute__((ext_vector_type(4)));
typedef float f32x16 __attribute__((ext_vector_type(16)));
typedef unsigned u32x2 __attribute__((ext_vector_type(2)));
typedef unsigned u32x4 __attribute__((ext_vector_type(4)));
typedef int i32x8 __attribute__((ext_vector_type(8)));

#define MFMA32(a, b, c) __builtin_amdgcn_mfma_f32_32x32x16_bf16(__builtin_bit_cast(mf8, (a)), __builtin_bit_cast(mf8, (b)), (c), 0, 0, 0)
#define MFMA16(a, b, c) __builtin_amdgcn_mfma_f32_16x16x32_bf16(__builtin_bit_cast(mf8, (a)), __builtin_bit_cast(mf8, (b)), (c), 0, 0, 0)

__device__ __forceinline__ unsigned cvt_pk(float lo, float hi) { f32x2 v = {lo, hi}; mf2 b = __builtin_convertvector(v, mf2); return __builtin_bit_cast(unsigned, b); }
__device__ __forceinline__ void fp8rt2(float& a, float& b) { const int p = __builtin_amdgcn_cvt_pk_fp8_f32(a, b, 0, false); a = __builtin_amdgcn_cvt_f32_fp8(p, 0); b = __builtin_amdgcn_cvt_f32_fp8(p, 1); }
__device__ __forceinline__ unsigned cvt_pk8(float a, float b) { fp8rt2(a, b); return cvt_pk(a, b); }
__device__ __forceinline__ float up16(short x) { return __uint_as_float(((unsigned)(unsigned short)x) << 16); }
__device__ __forceinline__ float up_lo(unsigned w) { return __uint_as_float(w << 16); }
__device__ __forceinline__ float up_hi(unsigned w) { return __uint_as_float(w & 0xffff0000u); }
__device__ __forceinline__ h8 pack8(const float* f) { u32x4 w = {cvt_pk(f[0], f[1]), cvt_pk(f[2], f[3]), cvt_pk(f[4], f[5]), cvt_pk(f[6], f[7])}; return __builtin_bit_cast(h8, w); }
__device__ __forceinline__ float wave_sum(float v) {
#pragma unroll
    for (int o = 1; o < 64; o <<= 1) v += __shfl_xor(v, o);
    return v;
}
__device__ __forceinline__ float gelu_tanh(float x) {
    const float u = 0.7978845608028654f * (x + 0.044715f * x * x * x);
    return x / (1.0f + __builtin_amdgcn_exp2f(-2.885390081777927f * u));
}
__device__ __forceinline__ float sigmoidf_(float x) { return 1.0f / (1.0f + __builtin_amdgcn_exp2f(-1.4426950408889634f * x)); }
__device__ __forceinline__ int crow(int r, int hi) { return (r & 3) + 8 * (r >> 2) + 4 * hi; }

constexpr int S_ = 8192, D_ = 2048, NLAYER = 2;
constexpr int HA = 8, DA = 128, NBLK = 32;
constexpr int HM = 4, DMH = 256, NMEM = 256;
constexpr int DFF = 5632, WINC = 12288;
constexpr int ZP = 4096, ZN = 10240;
constexpr int ZQ = 0, ZK = 1024, ZU = 2048, ZQM = 3072, ZG = 4096;
constexpr int ZTP = 8192;
constexpr int YP = 3072;
constexpr float EPS = 1e-6f, LOG2E = 1.4426950408889634f;

constexpr size_t MiB = 1u << 20;
constexpr size_t WS_CTL = 0;
constexpr size_t WL_IN = 0, WL_B = 48 * MiB, WL_O = 60 * MiB, WL_GU = 68 * MiB, WL_D = 112 * MiB, WL_M = 134 * MiB, WL_SIZE = 142 * MiB;
constexpr size_t WS_W = 1 * MiB;
constexpr size_t WS_HN = WS_W + 2 * WL_SIZE;
constexpr size_t WS_Z = WS_HN + 32 * MiB;
constexpr size_t WS_GATE = WS_Z + 64 * MiB;
constexpr size_t WS_ZT = WS_GATE + 96 * MiB;
constexpr size_t WS_Y = WS_ZT + 32 * MiB;
constexpr size_t WS_PART = WS_Y + 48 * MiB;
constexpr size_t WS_MG = WS_PART + 64 * MiB;
constexpr size_t WS_MEMN = WS_MG + 32 * MiB;
constexpr size_t WS_KM = WS_MEMN + 2 * MiB;
constexpr size_t WS_VMT = WS_KM + 1 * MiB;
constexpr size_t WS_KMEAN = WS_VMT + 1 * MiB;
constexpr size_t WS_RSSV = WS_KMEAN + 256 * 1024;
constexpr size_t WS_RSS = WS_RSSV + 64 * 1024;
constexpr size_t WS_RSTDV = WS_RSSV + 384 * 1024;
constexpr size_t WS_LIST = WS_RSSV + 512 * 1024;
constexpr size_t WS_ML = WS_LIST + 8 * MiB;
constexpr size_t WS_SEL = WS_ML + 2 * MiB;
constexpr size_t WS_ONES = WS_SEL + 1 * MiB;
constexpr size_t WS_X8 = WS_ONES + 1 * MiB;
constexpr size_t WS_END = WS_X8 + 16 * MiB;
constexpr int CW_CNT = 2048;

namespace pg8 {
constexpr int PRE_OFF = 139264 + 12288;
constexpr int EPI_OFF = 139264;
constexpr int BM = 256, BK = 64, HALF = 128, HTB = HALF * BK * 2, STAGE_BYTES = 8 * HTB, NXCD = 8, WGM = 8;
__host__ __device__ __forceinline__ int lds_byte(int r, int c) { const int st = (r >> 4) * 2 + (c >> 5), rr = r & 15, cc = c & 31, ob = rr * 64 + cc * 2; return st * 1024 + (ob ^ (((ob >> 9) & 1) << 5)); }
__host__ __device__ __forceinline__ void stage_rc(int b, int& R, int& C) { const int st = b / 1024, sb = b % 1024, swz = sb ^ (((sb >> 9) & 1) << 5); R = (st >> 1) * 16 + swz / 64; C = (st & 1) * 32 + (swz % 64) / 2; }
__host__ __device__ __forceinline__ int perm32(int rho) { const int n = rho >> 4, i = rho & 15; return 8 * (i >> 2) + 4 * n + (i & 3); }

struct Unit { int pm, pn; };
struct Gemm { const e16_t* A; const e16_t* Bt; int M, N, K, lda, ldb; };

struct StaticOrder {
    int nM, nN, nwg, G, c;
    __host__ __device__ void init(int M, int N, int G_, int c_) { nM = M / BM; nN = N / BM; nwg = nM * nN; G = G_; c = c_; }
    __host__ __device__ bool next(int i, Unit& u) const {
        const long L = (long)i * G + c; if (L >= nwg) return false;
        int wgid = (int)L; { const int q = nwg / NXCD, r = nwg % NXCD, xcd = wgid % NXCD, off = wgid / NXCD; wgid = (xcd < r ? xcd * (q + 1) : r * (q + 1) + (xcd - r) * q) + off; }
        const int nig = WGM * nN, gid = wgid / nig, fm = gid * WGM, gsz = (nM - fm) < WGM ? (nM - fm) : WGM;
        u.pm = fm + ((wgid % nig) % gsz); u.pn = (wgid % nig) / gsz; return true;
    }
    __device__ __forceinline__ void a_ready(const Unit&) const {}
    __device__ __forceinline__ void done(const Unit&) const {}
};

#ifndef ST_AUX
#define ST_AUX 0
#endif
struct WT {
    __amdgpu_buffer_rsrc_t r;
    __device__ __forceinline__ explicit WT(const void* p) : r(__builtin_amdgcn_make_buffer_rsrc((void*)p, 0, 0x7fffffff, 0x00020000)) {}
    __device__ __forceinline__ void st(unsigned byteoff, u32x4 v) const { __builtin_amdgcn_raw_buffer_store_b128(v, r, byteoff, 0, ST_AUX); }
    __device__ __forceinline__ void stf(unsigned byteoff, f32x4 v) const { __builtin_amdgcn_raw_buffer_store_b128(__builtin_bit_cast(u32x4, v), r, byteoff, 0, ST_AUX); }
};
typedef unsigned long long fx_t;
constexpr float FX_ONE = 1048576.f, FX_INV = 1.f / 1048576.f;
__device__ __forceinline__ float fx2f(fx_t v) { return (float)v * FX_INV; }
__device__ __forceinline__ fx_t f2fx(float v) { return (fx_t)(v * FX_ONE); }
__device__ __forceinline__ float rstd_of(float ss) { return rsqrtf(ss * (1.f / 2048.f) + 1e-6f); }
struct EpiStore16 {
    static constexpr bool PERM = true, HAS_MID = false, HAS_PRE = false;
    e16_t* O; int ldc; const fx_t* rss; int mode; fx_t* rssv;
    __device__ __forceinline__ void operator()(const f32x4 (&acc)[2][2][4][2], const Unit& u, int wr, int wc, int fr, int fq) const {
        const int row0 = u.pm * BM + wr * 64 + fr, col0 = u.pn * BM + wc * 32 + 8 * fq;
        f32x4 cs[2][2];
#pragma unroll
        for (int bj = 0; bj < 2; ++bj)
#pragma unroll
            for (int n = 0; n < 2; ++n) { cs[bj][n] = (f32x4){1.f, 1.f, 1.f, 1.f};
                if (mode == 2) { const fx_t* rp = rss + col0 + bj * HALF + 4 * n; cs[bj][n] = (f32x4){rstd_of(fx2f(rp[0])), rstd_of(fx2f(rp[1])), rstd_of(fx2f(rp[2])), rstd_of(fx2f(rp[3]))}; } }
        const WT wt(O); const bool dogelu = (mode == 2) && rssv != nullptr && u.pm >= 4;
        float sq[2][8];
#pragma unroll
        for (int bj = 0; bj < 2; ++bj)
#pragma unroll
            for (int e = 0; e < 8; ++e) sq[bj][e] = 0.f;
        float rsv[2][4];
#pragma unroll
        for (int ai = 0; ai < 2; ++ai)
#pragma unroll
            for (int m = 0; m < 4; ++m) rsv[ai][m] = (mode == 1) ? fx2f(rss[row0 + ai * HALF + m * 16]) : 0.f;
#pragma unroll
        for (int ai = 0; ai < 2; ++ai)
#pragma unroll
            for (int m = 0; m < 4; ++m) { const int row = row0 + ai * HALF + m * 16; const unsigned rowb = (unsigned)(row * ldc + col0) * 2u;
                const float rs = (mode == 1) ? rstd_of(rsv[ai][m]) : 1.f;
#pragma unroll
                for (int bj = 0; bj < 2; ++bj) { f32x4 v0 = acc[ai][bj][m][0] * cs[bj][0] * rs, v1 = acc[ai][bj][m][1] * cs[bj][1] * rs;
                    if (dogelu) {
#pragma unroll
                        for (int e = 0; e < 4; ++e) { v0[e] = gelu_tanh(v0[e]); v1[e] = gelu_tanh(v1[e]); sq[bj][e] += v0[e] * v0[e]; sq[bj][4 + e] += v1[e] * v1[e]; } }
                    u32x4 w; w.x = cvt_pk(v0[0], v0[1]); w.y = cvt_pk(v0[2], v0[3]); w.z = cvt_pk(v1[0], v1[1]); w.w = cvt_pk(v1[2], v1[3]);
                    wt.st(rowb + bj * HALF * 2, w); } }
        if (dogelu) {
#pragma unroll
            for (int bj = 0; bj < 2; ++bj)
#pragma unroll
                for (int e = 0; e < 8; ++e) { float v = sq[bj][e]; v += __shfl_xor(v, 1); v += __shfl_xor(v, 2); v += __shfl_xor(v, 4); v += __shfl_xor(v, 8);
                    if (fr == 0) atomicAdd(rssv + col0 + bj * HALF + e, f2fx(v)); } }
    }
};
struct EpiSwiGLU {
    static constexpr bool PERM = true, HAS_MID = false, HAS_PRE = true;
    e16_t* O; int ldc; const fx_t* rss; LAS unsigned char* lds;
    __device__ __forceinline__ void operator()(const f32x4 (&acc)[2][2][4][2], const Unit& u, int wr, int wc, int fr, int fq) const {
        const int row0 = u.pm * BM + wr * 64 + fr, col0 = u.pn * HALF + wc * 32 + 8 * fq;
        const WT wt(O);
        float rsv[2][4];
#pragma unroll
        for (int ai = 0; ai < 2; ++ai)
#pragma unroll
            for (int m = 0; m < 4; ++m) rsv[ai][m] = fx2f(*(const LAS fx_t*)(lds + PRE_OFF + (wr * 64 + fr + ai * HALF + m * 16) * 8));
#pragma unroll
        for (int ai = 0; ai < 2; ++ai)
#pragma unroll
            for (int m = 0; m < 4; ++m) { const int row = row0 + ai * HALF + m * 16; const unsigned rowb = (unsigned)(row * ldc + col0) * 2u; const float rs = rstd_of(rsv[ai][m]);
                float hv[8];
#pragma unroll
                for (int n = 0; n < 2; ++n)
#pragma unroll
                    for (int i = 0; i < 4; ++i) { const float g = acc[ai][0][m][n][i] * rs, up = acc[ai][1][m][n][i] * rs; hv[n * 4 + i] = g * sigmoidf_(g) * up; }
                u32x4 w; w.x = cvt_pk(hv[0], hv[1]); w.y = cvt_pk(hv[2], hv[3]); w.z = cvt_pk(hv[4], hv[5]); w.w = cvt_pk(hv[6], hv[7]);
                wt.st(rowb, w); }
    }
};
struct EpiRes {
    static constexpr bool PERM = true, HAS_MID = false, HAS_PRE = false;
    const float* base; const e16_t* base16; float* out; e16_t* xb; fx_t* rss; int ldc; e16_t* x8;
    __device__ __forceinline__ void operator()(const f32x4 (&acc)[2][2][4][2], const Unit& u, int wr, int wc, int fr, int fq) const {
        const int row0 = u.pm * BM + wr * 64 + fr, col0 = u.pn * BM + wc * 32 + 8 * fq;
        const WT wo(out ? (const void*)out : (const void*)xb), wx(xb ? (const void*)xb : (const void*)out);
        if (base16) {
            h8 raw[2][4][2];
#pragma unroll
            for (int ai = 0; ai < 2; ++ai)
#pragma unroll
                for (int m = 0; m < 4; ++m) { const e16_t* bp = base16 + (size_t)(row0 + ai * HALF + m * 16) * ldc + col0;
#pragma unroll
                    for (int bj = 0; bj < 2; ++bj) raw[ai][m][bj] = *(const h8*)(bp + bj * HALF); }
#pragma unroll
            for (int ai = 0; ai < 2; ++ai)
#pragma unroll
                for (int m = 0; m < 4; ++m) { const int row = row0 + ai * HALF + m * 16; const size_t off = (size_t)row * ldc + col0; float ss = 0.f;
#pragma unroll
                    for (int bj = 0; bj < 2; ++bj) { const h8 r = raw[ai][m][bj];
                        const f32x4 v0 = (f32x4){up16(r[0]), up16(r[1]), up16(r[2]), up16(r[3])} + acc[ai][bj][m][0], v1 = (f32x4){up16(r[4]), up16(r[5]), up16(r[6]), up16(r[7])} + acc[ai][bj][m][1];
                        if (out) { wo.stf((unsigned)(off + bj * HALF) * 4u, v0); wo.stf((unsigned)(off + bj * HALF + 4) * 4u, v1); }
                        ss += (v0[0] * v0[0] + v0[1] * v0[1]) + (v0[2] * v0[2] + v0[3] * v0[3]) + (v1[0] * v1[0] + v1[1] * v1[1]) + (v1[2] * v1[2] + v1[3] * v1[3]);
                        if (xb) { u32x4 w; w.x = cvt_pk(v0[0], v0[1]); w.y = cvt_pk(v0[2], v0[3]); w.z = cvt_pk(v1[0], v1[1]); w.w = cvt_pk(v1[2], v1[3]); wx.st((unsigned)(off + bj * HALF) * 2u, w); }
                        if (x8) { u32x2 w; w.x = (unsigned)__builtin_amdgcn_cvt_pk_fp8_f32(v0[2], v0[3], __builtin_amdgcn_cvt_pk_fp8_f32(v0[0], v0[1], 0, false), true); w.y = (unsigned)__builtin_amdgcn_cvt_pk_fp8_f32(v1[2], v1[3], __builtin_amdgcn_cvt_pk_fp8_f32(v1[0], v1[1], 0, false), true);
                            *(u32x2*)((unsigned char*)x8 + off + bj * HALF) = w; } }
                    if (rss) { ss += __shfl_xor(ss, 16); ss += __shfl_xor(ss, 32); if (fq == 0) atomicAdd(rss + row, f2fx(ss)); } }
            return; }
#pragma unroll
        for (int ai = 0; ai < 2; ++ai) {
            f32x4 bv[4][2][2];
#pragma unroll
            for (int m = 0; m < 4; ++m) { const float* bp = base + (size_t)(row0 + ai * HALF + m * 16) * ldc + col0;
#pragma unroll
                for (int bj = 0; bj < 2; ++bj) { bv[m][bj][0] = *(const f32x4*)(bp + bj * HALF); bv[m][bj][1] = *(const f32x4*)(bp + bj * HALF + 4); } }
#pragma unroll
            for (int m = 0; m < 4; ++m) { const int row = row0 + ai * HALF + m * 16; const size_t off = (size_t)row * ldc + col0; float ss = 0.f;
#pragma unroll
                for (int bj = 0; bj < 2; ++bj) { const f32x4 v0 = bv[m][bj][0] + acc[ai][bj][m][0], v1 = bv[m][bj][1] + acc[ai][bj][m][1];
                    if (out) { wo.stf((unsigned)(off + bj * HALF) * 4u, v0); wo.stf((unsigned)(off + bj * HALF + 4) * 4u, v1); }
                    ss += (v0[0] * v0[0] + v0[1] * v0[1]) + (v0[2] * v0[2] + v0[3] * v0[3]) + (v1[0] * v1[0] + v1[1] * v1[1]) + (v1[2] * v1[2] + v1[3] * v1[3]);
                    if (xb) { u32x4 w; w.x = cvt_pk(v0[0], v0[1]); w.y = cvt_pk(v0[2], v0[3]); w.z = cvt_pk(v1[0], v1[1]); w.w = cvt_pk(v1[2], v1[3]); wx.st((unsigned)(off + bj * HALF) * 2u, w); } }
                if (rss) { ss += __shfl_xor(ss, 16); ss += __shfl_xor(ss, 32); if (fq == 0) atomicAdd(rss + row, f2fx(ss)); } }
        }
    }
};

struct EpiZ {
    static constexpr bool PERM = true, HAS_MID = false, HAS_PRE = true;
    e16_t* Z; e16_t* GATE; const fx_t* rss; LAS unsigned char* lds; const float* gk; float* kmean; int pn0;
    __device__ __forceinline__ void operator()(const f32x4 (&acc)[2][2][4][2], const Unit& u_, int wr, int wc, int fr, int fq) const {
        Unit u = u_; u.pn += pn0;
        const int row0 = u.pm * BM + wr * 64 + fr, col0 = u.pn * BM + wc * 32 + 8 * fq;
        const WT wz(Z), wg(GATE);
        float rsv[2][4];
#pragma unroll
        for (int ai = 0; ai < 2; ++ai)
#pragma unroll
            for (int m = 0; m < 4; ++m) rsv[ai][m] = fx2f(*(const LAS fx_t*)(lds + PRE_OFF + (wr * 64 + fr + ai * HALF + m * 16) * 8));
        if (u.pn >= 4 && u.pn < 8) {
            LAS float* P = (LAS float*)(lds + EPI_OFF); LAS float* KS = P + 2048;
#pragma unroll
            for (int ai = 0; ai < 2; ++ai)
#pragma unroll
                for (int m = 0; m < 4; ++m) { const float rs = rstd_of(rsv[ai][m]); const int rl = ai * HALF + wr * 64 + m * 16 + fr;
#pragma unroll
                    for (int bj = 0; bj < 2; ++bj) { const f32x4 v0 = acc[ai][bj][m][0] * rs, v1 = acc[ai][bj][m][1] * rs;
                        float ss = (v0[0] * v0[0] + v0[1] * v0[1]) + (v0[2] * v0[2] + v0[3] * v0[3]) + (v1[0] * v1[0] + v1[1] * v1[1]) + (v1[2] * v1[2] + v1[3] * v1[3]);
                        ss += __shfl_xor(ss, 16); ss += __shfl_xor(ss, 32);
                        if (fq == 0) P[(rl * 2 + bj) * 4 + wc] = ss; } }
            asm volatile("s_waitcnt lgkmcnt(0)" ::: "memory"); __builtin_amdgcn_s_barrier(); asm volatile("" ::: "memory");
            const f32x4 g0 = *(const f32x4*)(gk + wc * 32 + 8 * fq), g1 = *(const f32x4*)(gk + wc * 32 + 8 * fq + 4);
            float cs[2][8];
#pragma unroll
            for (int bj = 0; bj < 2; ++bj)
#pragma unroll
                for (int e = 0; e < 8; ++e) cs[bj][e] = 0.f;
#pragma unroll
            for (int ai = 0; ai < 2; ++ai)
#pragma unroll
                for (int m = 0; m < 4; ++m) { const int rl = ai * HALF + wr * 64 + m * 16 + fr; const unsigned rowb = (unsigned)((row0 + ai * HALF + m * 16) * ZP + col0) * 2u; const float rs = rstd_of(rsv[ai][m]);
#pragma unroll
                    for (int bj = 0; bj < 2; ++bj) { const f32x4 pt = *(const LAS f32x4*)(P + (rl * 2 + bj) * 4);
                        const float rk = rsqrtf(((pt[0] + pt[1]) + (pt[2] + pt[3])) * (1.f / 128.f) + 1e-6f) * rs;
                        const f32x4 v0 = acc[ai][bj][m][0] * rk * g0, v1 = acc[ai][bj][m][1] * rk * g1;
#pragma unroll
                        for (int e = 0; e < 4; ++e) { cs[bj][e] += v0[e]; cs[bj][4 + e] += v1[e]; }
                        u32x4 w; w.x = cvt_pk(v0[0], v0[1]); w.y = cvt_pk(v0[2], v0[3]); w.z = cvt_pk(v1[0], v1[1]); w.w = cvt_pk(v1[2], v1[3]);
                        wz.st(rowb + bj * HALF * 2, w); } }
#pragma unroll
            for (int bj = 0; bj < 2; ++bj)
#pragma unroll
                for (int e = 0; e < 8; ++e) { float v = cs[bj][e]; v += __shfl_xor(v, 1); v += __shfl_xor(v, 2); v += __shfl_xor(v, 4); v += __shfl_xor(v, 8); cs[bj][e] = v; }
            if (fr == 0) {
#pragma unroll
                for (int bj = 0; bj < 2; ++bj)
#pragma unroll
                    for (int e = 0; e < 8; ++e) KS[wr * 256 + bj * HALF + wc * 32 + 8 * fq + e] = cs[bj][e]; }
            asm volatile("s_waitcnt lgkmcnt(0)" ::: "memory"); __builtin_amdgcn_s_barrier(); asm volatile("" ::: "memory");
            const int tl = (wr * 4 + wc) * 64 + fq * 16 + fr;
            if (tl < 256) kmean[(size_t)((2 * (u.pn - 4) + (tl >> 7)) * 32 + u.pm) * 128 + (tl & 127)] = (KS[tl] + KS[256 + tl]) * (1.f / 256.f);
        } else if (u.pn < 16) {
#pragma unroll
            for (int ai = 0; ai < 2; ++ai)
#pragma unroll
                for (int m = 0; m < 4; ++m) { const unsigned rowb = (unsigned)((row0 + ai * HALF + m * 16) * ZP + col0) * 2u; const float rs = rstd_of(rsv[ai][m]);
#pragma unroll
                    for (int bj = 0; bj < 2; ++bj) { const f32x4 v0 = acc[ai][bj][m][0] * rs, v1 = acc[ai][bj][m][1] * rs;
                        u32x4 w; w.x = cvt_pk(v0[0], v0[1]); w.y = cvt_pk(v0[2], v0[3]); w.z = cvt_pk(v1[0], v1[1]); w.w = cvt_pk(v1[2], v1[3]);
                        wz.st(rowb + bj * HALF * 2, w); } }
        } else {
            const int gt = u.pn - 16;
            const unsigned lo = (unsigned)((wr * 4 + wc) * 8192 + (fq * 16 + fr) * 8);
            if (gt < 16) {
                const unsigned g0 = (unsigned)(((0 * 32 + u.pm) * 8 + (gt >> 1)) * 65536 + lo) * 2u; const WT wg1(GATE + (size_t)32 * 8 * 65536);
#pragma unroll
                for (int ai = 0; ai < 2; ++ai)
#pragma unroll
                    for (int m = 0; m < 4; ++m) { const float rs = rstd_of(rsv[ai][m]) * (-1.4426950408889634f / 64.f);
                        float r1[8], eb[8];
#pragma unroll
                        for (int n = 0; n < 2; ++n)
#pragma unroll
                            for (int i = 0; i < 4; ++i) { const float ea = __builtin_amdgcn_exp2f(__builtin_amdgcn_fmed3f(acc[ai][0][m][n][i] * rs, -43.28f, 43.28f)); eb[n * 4 + i] = __builtin_amdgcn_exp2f(__builtin_amdgcn_fmed3f(acc[ai][1][m][n][i] * rs, -43.28f, 43.28f));
                                const float sb = __builtin_amdgcn_rcpf(1.f + eb[n * 4 + i]); r1[n * 4 + i] = __builtin_amdgcn_rcpf(sb * (1.f + ea)); eb[n * 4 + i] = sb; }
                        const unsigned o = (unsigned)(((ai * 4 + m) * 2 + (gt & 1)) * 1024);
                        wg.st(g0 + o, __builtin_bit_cast(u32x4, pack8(r1))); wg1.st(g0 + o, __builtin_bit_cast(u32x4, pack8(eb))); }
            } else {
                const unsigned gb = (unsigned)(((2 * 32 + u.pm) * 8 + (gt - 16)) * 65536 + lo) * 2u;
#pragma unroll
                for (int ai = 0; ai < 2; ++ai)
#pragma unroll
                    for (int m = 0; m < 4; ++m) { const float rs = rstd_of(rsv[ai][m]) * (-1.4426950408889634f / 64.f);
#pragma unroll
                        for (int bj = 0; bj < 2; ++bj) { float g[8];
#pragma unroll
                            for (int i = 0; i < 4; ++i) { g[i] = 1.f + __builtin_amdgcn_exp2f(__builtin_amdgcn_fmed3f(acc[ai][bj][m][0][i] * rs, -43.28f, 43.28f)); g[4 + i] = 1.f + __builtin_amdgcn_exp2f(__builtin_amdgcn_fmed3f(acc[ai][bj][m][1][i] * rs, -43.28f, 43.28f)); }
                            wg.st(gb + (unsigned)(((ai * 4 + m) * 2 + bj) * 1024), __builtin_bit_cast(u32x4, pack8(g))); } }
            }
        }
    }
};
struct EpiGate {
    static constexpr bool PERM = true, HAS_MID = false, HAS_PRE = true;
    e16_t* GATE; const fx_t* rss; LAS unsigned char* lds;
    __device__ __forceinline__ void operator()(const f32x4 (&acc)[2][2][4][2], const Unit& u, int wr, int wc, int fr, int fq) const {
        const WT wg(GATE);
        float rsv[2][4];
#pragma unroll
        for (int ai = 0; ai < 2; ++ai)
#pragma unroll
            for (int m = 0; m < 4; ++m) rsv[ai][m] = rstd_of(fx2f(*(const LAS fx_t*)(lds + PRE_OFF + (wr * 64 + fr + ai * HALF + m * 16) * 8))) * (-1.4426950408889634f / 64.f);
        const int gt = u.pn;
        const unsigned lo = (unsigned)((wr * 4 + wc) * 8192 + (fq * 16 + fr) * 8);
        if (gt < 16) {
            const unsigned g0 = (unsigned)(((0 * 32 + u.pm) * 8 + (gt >> 1)) * 65536 + lo) * 2u; const WT wg1(GATE + (size_t)32 * 8 * 65536);
#pragma unroll
            for (int ai = 0; ai < 2; ++ai)
#pragma unroll
                for (int m = 0; m < 4; ++m) { const float rs = rsv[ai][m]; float r1[8], eb[8];
#pragma unroll
                    for (int n = 0; n < 2; ++n)
#pragma unroll
                        for (int i = 0; i < 4; ++i) { const float ea = __builtin_amdgcn_exp2f(__builtin_amdgcn_fmed3f(acc[ai][0][m][n][i] * rs, -43.28f, 43.28f)); eb[n * 4 + i] = __builtin_amdgcn_exp2f(__builtin_amdgcn_fmed3f(acc[ai][1][m][n][i] * rs, -43.28f, 43.28f));
                            const float sb = __builtin_amdgcn_rcpf(1.f + eb[n * 4 + i]); r1[n * 4 + i] = __builtin_amdgcn_rcpf(sb * (1.f + ea)); eb[n * 4 + i] = sb; }
                    const unsigned o = (unsigned)(((ai * 4 + m) * 2 + (gt & 1)) * 1024);
                    wg.st(g0 + o, __builtin_bit_cast(u32x4, pack8(r1))); wg1.st(g0 + o, __builtin_bit_cast(u32x4, pack8(eb))); }
        } else {
            const unsigned gb = (unsigned)(((2 * 32 + u.pm) * 8 + (gt - 16)) * 65536 + lo) * 2u;
#pragma unroll
            for (int ai = 0; ai < 2; ++ai)
#pragma unroll
                for (int m = 0; m < 4; ++m) { const float rs = rsv[ai][m];
#pragma unroll
                    for (int bj = 0; bj < 2; ++bj) { float g[8];
#pragma unroll
                        for (int i = 0; i < 4; ++i) { g[i] = 1.f + __builtin_amdgcn_exp2f(__builtin_amdgcn_fmed3f(acc[ai][bj][m][0][i] * rs, -43.28f, 43.28f)); g[4 + i] = 1.f + __builtin_amdgcn_exp2f(__builtin_amdgcn_fmed3f(acc[ai][bj][m][1][i] * rs, -43.28f, 43.28f)); }
                        wg.st(gb + (unsigned)(((ai * 4 + m) * 2 + bj) * 1024), __builtin_bit_cast(u32x4, pack8(g))); } }
        }
    }
};
struct EpiMerge {
    static constexpr bool PERM = true, HAS_MID = true, HAS_PRE = false;
    const e16_t* GATE; e16_t* MG;
    __device__ __forceinline__ const e16_t* gptr(int b, const Unit& u, int wr, int wc, int fr, int fq) const { return GATE + ((size_t)((b * 32 + u.pm) * 8 + u.pn)) * 65536 + (wr * 4 + wc) * 8192 + (fq * 16 + fr) * 8; }
    __device__ __forceinline__ void mid(f32x4 (&acc)[2][2][4][2], const Unit& u, int t, int wr, int wc, int fr, int fq) const {
        const e16_t* np = gptr(t == 16 ? 0 : 1, u, wr, wc, fr, fq); const e16_t* dp = (t == 16) ? GATE + (WS_ONES - WS_GATE) / 2 + (wr * 4 + wc) * 8192 + (fq * 16 + fr) * 8 : gptr(2, u, wr, wc, fr, fq);
#pragma unroll
        for (int ai = 0; ai < 2; ++ai)
#pragma unroll
            for (int m = 0; m < 4; ++m) {
#pragma unroll
                for (int bj = 0; bj < 2; ++bj) { const int o = ((ai * 4 + m) * 2 + bj) * 512; const h8 nn = *(const h8*)(np + o), dd = *(const h8*)(dp + o);
#pragma unroll
                    for (int i = 0; i < 4; ++i) { acc[ai][bj][m][0][i] *= up16(dd[i]) * up16(nn[i]); acc[ai][bj][m][1][i] *= up16(dd[4 + i]) * up16(nn[4 + i]); } }
                if (m == 3) asm volatile("" ::: "memory"); }
    }
    __device__ __forceinline__ void operator()(const f32x4 (&acc)[2][2][4][2], const Unit& u, int wr, int wc, int fr, int fq) const {
        const int row0 = u.pm * BM + wr * 64 + fr, col0 = u.pn * BM + wc * 32 + 8 * fq; const e16_t* sp = gptr(2, u, wr, wc, fr, fq); const WT wm(MG);
        h8 sg[2][4][2];
#pragma unroll
        for (int ai = 0; ai < 2; ++ai)
#pragma unroll
            for (int m = 0; m < 4; ++m)
#pragma unroll
                for (int bj = 0; bj < 2; ++bj) sg[ai][m][bj] = *(const h8*)(sp + ((ai * 4 + m) * 2 + bj) * 512);
#pragma unroll
        for (int ai = 0; ai < 2; ++ai)
#pragma unroll
            for (int m = 0; m < 4; ++m) { const unsigned rowb = (unsigned)((row0 + ai * HALF + m * 16) * 2048 + col0) * 2u;
#pragma unroll
                for (int bj = 0; bj < 2; ++bj) { float v[8];
#pragma unroll
                    for (int i = 0; i < 4; ++i) { v[i] = acc[ai][bj][m][0][i] * __builtin_amdgcn_rcpf(up16(sg[ai][m][bj][i])); v[4 + i] = acc[ai][bj][m][1][i] * __builtin_amdgcn_rcpf(up16(sg[ai][m][bj][4 + i])); }
                    wm.st(rowb + bj * HALF * 2, __builtin_bit_cast(u32x4, pack8(v))); } }
    }
};

template <class Epi, class Sched, bool ALIGN_EPI = true, bool SP2 = true, bool F8 = false>
__device__ __forceinline__ void gemm_phase(LAS unsigned char* lds, const int tid, const Gemm g, const Sched& S, const Epi& E) {
    const int wid = __builtin_amdgcn_readfirstlane(tid >> 6), lane = tid & 63, wr = wid >> 2, wc = wid & 3, fr = lane & 15, fq = lane >> 4;
    const int K = g.K, nt = K / BK;
    unsigned voffA[2], voffB[2];
#pragma unroll
    for (int i = 0; i < 2; ++i) { int R, C; stage_rc(tid * 16 + i * 8192, R, C); const int Rb = Epi::PERM ? ((R & ~31) + perm32(R & 31)) : R;
        voffA[i] = (unsigned)(R * g.lda + C) * 2u; voffB[i] = (unsigned)(Rb * g.ldb + C) * 2u; }
    const size_t kstep = (size_t)(BK * 2);
    const size_t hstepA = (size_t)HALF * g.lda * 2, hstepB = (size_t)HALF * g.ldb * 2;
    const size_t tstepA = 2 * hstepA, tstepB = 2 * hstepB;
    const unsigned ldsw = (unsigned)wid * 1024u;
    const int aoff = lds_byte(wr * 64 + fr, fq * 8), boff = lds_byte(wc * 32 + fr, fq * 8);
#define PG8_SA(b, h) (((b) * 2 + (h)) * HTB)
#define PG8_SB(b, h) ((4 + (b) * 2 + (h)) * HTB)
#define PG8_STAGE(bufoff, gbase, voff) do { _Pragma("unroll") for (int _i = 0; _i < 2; ++_i) \
        __builtin_amdgcn_global_load_lds((const unsigned*)((const char*)(gbase) + (voff)[_i]), (LAS unsigned*)(lds + (bufoff) + ldsw + _i * 8192), 16, 0, 0); } while (0)
#define PG8_LDA(dst, b, h) do { if constexpr (F8) { _Pragma("unroll") for (int m = 0; m < 4; ++m) { const u32x4 lo_ = *(const LAS u32x4*)(lds + PG8_SA(b, h) + aoff + m * 2048), hi_ = *(const LAS u32x4*)(lds + PG8_SA(b, h) + aoff + m * 2048 + 1024); \
            dst##8[m] = __builtin_bit_cast(i32x8, __builtin_shufflevector(lo_, hi_, 0, 1, 2, 3, 4, 5, 6, 7)); } } \
        else { _Pragma("unroll") for (int m = 0; m < 4; ++m) _Pragma("unroll") for (int k = 0; k < 2; ++k) dst[m][k] = *(const LAS h8*)(lds + PG8_SA(b, h) + aoff + m * 2048 + k * 1024); } } while (0)
#define PG8_LDB(dst, b, h) do { if constexpr (F8) { _Pragma("unroll") for (int n = 0; n < 2; ++n) { const u32x4 lo_ = *(const LAS u32x4*)(lds + PG8_SB(b, h) + boff + n * 2048), hi_ = *(const LAS u32x4*)(lds + PG8_SB(b, h) + boff + n * 2048 + 1024); \
            dst##8[n] = __builtin_bit_cast(i32x8, __builtin_shufflevector(lo_, hi_, 0, 1, 2, 3, 4, 5, 6, 7)); } } \
        else { _Pragma("unroll") for (int n = 0; n < 2; ++n) _Pragma("unroll") for (int k = 0; k < 2; ++k) dst[n][k] = *(const LAS h8*)(lds + PG8_SB(b, h) + boff + n * 2048 + k * 1024); } } while (0)
#define PG8_MMA(ai, bj, At, Bt) do { __builtin_amdgcn_s_setprio(1); \
        if constexpr (F8) { _Pragma("unroll") for (int m = 0; m < 4; ++m) _Pragma("unroll") for (int n = 0; n < 2; ++n) \
            asm volatile("v_mfma_scale_f32_16x16x128_f8f6f4 %0, %1, %2, %0, %3, %3 op_sel_hi:[0,0,0]" : "+v"(acc[ai][bj][m][n]) : "v"(Bt##8[n]), "v"(At##8[m]), "v"(sc8)); } \
        else { _Pragma("unroll") for (int m = 0; m < 4; ++m) _Pragma("unroll") for (int n = 0; n < 2; ++n) _Pragma("unroll") for (int k = 0; k < 2; ++k) \
            acc[ai][bj][m][n] = MFMA16(Bt[n][k], At[m][k], acc[ai][bj][m][n]); } \
        __builtin_amdgcn_s_setprio(0); } while (0)
#define PG8_WAIT_V(n) asm volatile("s_waitcnt vmcnt(" #n ")" ::: "memory")
#define PG8_WAIT_L(n) asm volatile("s_waitcnt lgkmcnt(" #n ")" ::: "memory")
#define PG8_BAR __builtin_amdgcn_s_barrier()
#define PG8_SCHED __builtin_amdgcn_sched_barrier(0)
    Unit cur, nxt; int ui = 0;
    if (!S.next(0, cur)) return;
    f32x4 acc[2][2][4][2];
#pragma unroll
    for (int a = 0; a < 2; ++a)
#pragma unroll
        for (int b = 0; b < 2; ++b)
#pragma unroll
            for (int m = 0; m < 4; ++m)
#pragma unroll
                for (int n = 0; n < 2; ++n) acc[a][b][m][n] = (f32x4){0.f, 0.f, 0.f, 0.f};
    h8 At[4][2], B0[2][2], B1[2][2]; i32x8 At8[4], B08[2], B18[2];
    int sc8 = 0x7f7f7f7f; asm volatile("" : "+v"(sc8));
    const char* cA = (const char*)g.A + (size_t)cur.pm * tstepA; const char* cB = (const char*)g.Bt + (size_t)cur.pn * tstepB;
    S.a_ready(cur);
    if constexpr (SP2) {
        PG8_STAGE(PG8_SB(0, 0), cB, voffB); PG8_STAGE(PG8_SB(0, 1), cB + hstepB, voffB); PG8_STAGE(PG8_SA(0, 0), cA, voffA); PG8_STAGE(PG8_SA(0, 1), cA + hstepA, voffA);
        if (wr == 1) PG8_BAR;
        PG8_WAIT_V(2); PG8_BAR;
        PG8_STAGE(PG8_SB(1, 0), cB + kstep, voffB); PG8_STAGE(PG8_SA(1, 0), cA + kstep, voffA); PG8_STAGE(PG8_SB(1, 1), cB + hstepB + kstep, voffB);
        PG8_WAIT_V(6); PG8_BAR;
    } else {
        PG8_STAGE(PG8_SB(0, 0), cB, voffB); PG8_STAGE(PG8_SA(0, 0), cA, voffA); PG8_STAGE(PG8_SB(0, 1), cB + hstepB, voffB); PG8_STAGE(PG8_SA(0, 1), cA + hstepA, voffA);
        if (wr == 1) PG8_BAR;
        PG8_WAIT_V(4); PG8_BAR;
        PG8_STAGE(PG8_SB(1, 0), cB + kstep, voffB); PG8_STAGE(PG8_SA(1, 0), cA + kstep, voffA); PG8_STAGE(PG8_SB(1, 1), cB + hstepB + kstep, voffB);
        PG8_WAIT_V(6); PG8_BAR;
    }
    for (;;) {
        const bool has_next = S.next(ui + 1, nxt);
        const char* nA = has_next ? (const char*)g.A + (size_t)nxt.pm * tstepA : cA; const char* nB = has_next ? (const char*)g.Bt + (size_t)nxt.pn * tstepB : cB;
        for (int t = 0; t < nt; t += 2) {
            const bool last = (t == nt - 2);
            const char* a1 = cA + (size_t)(t + 1) * kstep;
            const char* a2 = last ? nA : cA + (size_t)(t + 2) * kstep; const char* b2 = last ? nB : cB + (size_t)(t + 2) * kstep;
            const char* a3 = a2 + kstep; const char* b3 = b2 + kstep;
            if (last && has_next) S.a_ready(nxt);
            if constexpr (Epi::HAS_PRE) { if (last) __builtin_amdgcn_global_load_lds((const unsigned*)(E.rss + (size_t)cur.pm * BM) + tid, (LAS unsigned*)(lds + PRE_OFF + wid * 256), 4, 0, 0); }
            if constexpr (Epi::HAS_MID) { if (t == 16 || t == 32) E.mid(acc, cur, t, wr, wc, fr, fq); }
            if constexpr (SP2) {
            PG8_LDB(B0, 0, 0); PG8_LDB(B1, 0, 1); PG8_SCHED; PG8_LDA(At, 0, 0); PG8_STAGE(PG8_SA(1, 1), a1 + hstepA, voffA);
            PG8_WAIT_V(8); PG8_WAIT_L(0); PG8_BAR; PG8_MMA(0, 0, At, B0); PG8_MMA(0, 1, At, B1); PG8_BAR; PG8_SCHED;
            PG8_LDA(At, 0, 1); PG8_STAGE(PG8_SB(0, 0), b2, voffB); PG8_STAGE(PG8_SB(0, 1), b2 + hstepB, voffB); PG8_STAGE(PG8_SA(0, 0), a2, voffA);
            PG8_WAIT_V(8); PG8_WAIT_L(0); PG8_BAR; PG8_MMA(1, 0, At, B0); PG8_MMA(1, 1, At, B1); PG8_BAR; PG8_SCHED;
            PG8_LDB(B0, 1, 0); PG8_LDB(B1, 1, 1); PG8_SCHED; PG8_LDA(At, 1, 0); PG8_STAGE(PG8_SA(0, 1), a2 + hstepA, voffA);
            PG8_WAIT_V(8); PG8_WAIT_L(0); PG8_BAR; PG8_MMA(0, 0, At, B0); PG8_MMA(0, 1, At, B1); PG8_BAR; PG8_SCHED;
            PG8_LDA(At, 1, 1); PG8_STAGE(PG8_SB(1, 0), b3, voffB); PG8_STAGE(PG8_SB(1, 1), b3 + hstepB, voffB); PG8_STAGE(PG8_SA(1, 0), a3, voffA);
            PG8_WAIT_V(8); PG8_WAIT_L(0); PG8_BAR; PG8_MMA(1, 0, At, B0); PG8_MMA(1, 1, At, B1); PG8_BAR; PG8_SCHED;
            } else {
            PG8_LDB(B0, 0, 0); PG8_SCHED; PG8_LDA(At, 0, 0); PG8_STAGE(PG8_SA(1, 1), a1 + hstepA, voffA);
            PG8_WAIT_L(8); PG8_BAR; PG8_WAIT_L(0); PG8_MMA(0, 0, At, B0); PG8_BAR; PG8_SCHED;
            PG8_LDB(B1, 0, 1); PG8_STAGE(PG8_SB(0, 0), b2, voffB);
            PG8_BAR; PG8_WAIT_L(0); PG8_MMA(0, 1, At, B1); PG8_BAR;
            PG8_LDA(At, 0, 1); PG8_STAGE(PG8_SA(0, 0), a2, voffA);
            PG8_BAR; PG8_WAIT_L(0); PG8_MMA(1, 0, At, B0); PG8_BAR; PG8_SCHED;
            PG8_STAGE(PG8_SB(0, 1), b2 + hstepB, voffB);
            PG8_WAIT_V(6); PG8_BAR; PG8_MMA(1, 1, At, B1); PG8_BAR;
            PG8_LDB(B0, 1, 0); PG8_SCHED; PG8_LDA(At, 1, 0); PG8_STAGE(PG8_SA(0, 1), a2 + hstepA, voffA);
            PG8_WAIT_L(8); PG8_BAR; PG8_WAIT_L(0); PG8_MMA(0, 0, At, B0); PG8_BAR; PG8_SCHED;
            PG8_LDB(B1, 1, 1); PG8_STAGE(PG8_SB(1, 0), b3, voffB);
            PG8_BAR; PG8_WAIT_L(0); PG8_MMA(0, 1, At, B1); PG8_BAR;
            PG8_LDA(At, 1, 1); PG8_STAGE(PG8_SA(1, 0), a3, voffA);
            PG8_BAR; PG8_WAIT_L(0); PG8_MMA(1, 0, At, B0); PG8_BAR; PG8_SCHED;
            PG8_STAGE(PG8_SB(1, 1), b3 + hstepB, voffB);
            PG8_WAIT_V(6); PG8_BAR; PG8_MMA(1, 1, At, B1); PG8_BAR;
            }
        }
        if constexpr (F8) asm volatile("s_nop 15\n\ts_nop 15" ::: "memory");
        if constexpr (ALIGN_EPI) { if (wr == 0) PG8_BAR; }
        E(acc, cur, wr, wc, fr, fq); S.done(cur);
        if (!has_next) break;
#pragma unroll
        for (int a = 0; a < 2; ++a)
#pragma unroll
            for (int b = 0; b < 2; ++b)
#pragma unroll
                for (int m = 0; m < 4; ++m)
#pragma unroll
                    for (int n = 0; n < 2; ++n) acc[a][b][m][n] = (f32x4){0.f, 0.f, 0.f, 0.f};
        cur = nxt; cA = nA; cB = nB; ++ui;
        if constexpr (ALIGN_EPI) { if (wr == 1) PG8_BAR; }
    }
    PG8_WAIT_V(0);
    if constexpr (!ALIGN_EPI) { if (wr == 0) PG8_BAR; }
    PG8_BAR;
#undef PG8_SA
#undef PG8_SB
#undef PG8_STAGE
#undef PG8_LDA
#undef PG8_LDB
#undef PG8_MMA
#undef PG8_WAIT_V
#undef PG8_WAIT_L
#undef PG8_BAR
#undef PG8_SCHED
}
}
using pg8::fx_t; using pg8::fx2f; using pg8::f2fx;

constexpr int NWAVES = 8, NTHREADS = 512;
constexpr int LDS_BYTES = 155648;
struct Args { const float* in[18]; float* out; unsigned char* ws; int ph_lo, ph_hi; };

struct Ctx {
    LAS unsigned char* lds; int tid, lane, wave, gw, NGW, G;
    float* out; unsigned char* ws;
    __device__ __forceinline__ e16_t* w16(size_t off) const { return (e16_t*)(ws + off); }
    __device__ __forceinline__ e16_t* wl(int l, size_t off) const { return (e16_t*)(ws + WS_W + (size_t)l * WL_SIZE + off); }
};

#define LDS_WAIT() asm volatile("s_waitcnt lgkmcnt(0)" ::: "memory")
__device__ __forceinline__ int map_win(int n) {
    if (n < 2048) return n;
    if (n < 3072) return 10240 + (n - 2048);
    if (n < 4096) return 2048 + (n - 3072);
    if (n < 5120) return 11264 + (n - 4096);
    if (n < 6144) return 3072 + (n - 5120);
    if (n < 8192) { const int c = n - 6144; return 4096 + (c >> 7) * 256 + (c & 127); }
    if (n < 10240) { const int c = n - 8192; return 4096 + (c >> 7) * 256 + 128 + (c & 127); }
    return n - 2048;
}
__device__ __forceinline__ int map_gu(int n) { return n < DFF ? 256 * (n >> 7) + (n & 127) : 256 * ((n - DFF) >> 7) + 128 + ((n - DFF) & 127); }
struct TD { const float* W; const float* g; e16_t* WT; int K, N, ldo, koff, map; };
__device__ __forceinline__ TD weight_td(const Args& a, const Ctx& C, int id) {
    const int l = id >> 3, m = id & 7; TD t; t.g = nullptr; t.koff = 0; t.map = 0;
    if (m == 0) { t.W = a.in[3] + (size_t)l * D_ * WINC; t.g = a.in[2] + l * D_; t.WT = C.wl(l, WL_IN); t.K = D_; t.N = WINC; t.ldo = D_; t.map = 1; }
    else if (m <= 3) { t.W = a.in[13] + (size_t)(l * 3 + m - 1) * 1024 * D_; t.WT = C.wl(l, WL_B); t.K = 1024; t.N = D_; t.ldo = 3072; t.koff = (m - 1) * 1024; }
    else if (m == 4) { t.W = a.in[14] + (size_t)l * D_ * D_; t.WT = C.wl(l, WL_O); t.K = D_; t.N = D_; t.ldo = D_; }
    else if (m == 5) { t.W = a.in[16] + (size_t)l * D_ * 2 * DFF; t.g = a.in[15] + l * D_; t.WT = C.wl(l, WL_GU); t.K = D_; t.N = 2 * DFF; t.ldo = D_; t.map = 2; }
    else if (m == 6) { t.W = a.in[17] + (size_t)l * DFF * D_; t.WT = C.wl(l, WL_D); t.K = DFF; t.N = D_; t.ldo = DFF; }
    else { t.W = a.in[12] + (size_t)l * D_ * D_; t.WT = C.wl(l, WL_M); t.K = D_; t.N = D_; t.ldo = D_; }
    return t;
}
__device__ __forceinline__ bool job_decode(int job, int i, int& id, int& it) {
    if (job == 0) { if (i < 12288) { id = 0; it = i; } else if (i < 14336) { id = 7; it = i - 12288; } else if (i < 16384) { id = 15; it = i - 14336; } else return false; }
    else if (job == 4) { if (i < 8192) { id = 5; it = i; } else if (i < 12288) { id = 8; it = i; } else if (i < 20480) { id = 13; it = i - 12288; }
                         else if (i < 24576) { it = 8192 + (i - 20480); if (it >= 11264) return false; id = 5; }
                         else if (i < 28672) { it = 8192 + (i - 24576); if (it >= 11264) return false; id = 13; }
                         else return false; }
    else if (job == 1) { if (i < 3072) { id = 1 + (i >> 10); it = i & 1023; } else if (i < 5120) { id = 4; it = i - 3072; } else if (i < 10752) { id = 6; it = i - 5120; }
                         else if (i < 13824) { id = 9 + ((i - 10752) >> 10); it = (i - 10752) & 1023; } else if (i < 15872) { id = 12; it = i - 13824; } else return false; }
    else if (job == 2) { if (i >= 8192) return false; id = 8; it = i; }
    else { if (i >= 5632) return false; id = 14; it = i; }
    return true;
}
__device__ __forceinline__ void convert_job(const Args& a, const Ctx& C, int job, int slot, int stride, int k_lo, int k_hi, LAS float* scr) {
    const int lane = C.lane, c = lane & 7;
    int k = k_lo, id, it;
    if (k >= k_hi || !job_decode(job, slot + k * stride, id, it)) return;
    TD t = weight_td(a, C, id); int nblk = t.N / 32;
    float r[32];
    { const int k0 = (it / nblk) * 64, n0 = (it % nblk) * 32;
#pragma unroll
      for (int i = 0; i < 32; ++i) r[i] = t.W[(size_t)(k0 + 2 * i + (lane >> 5)) * t.N + n0 + (lane & 31)]; }
#pragma unroll 1
    for (;;) {
        const int k0 = (it / nblk) * 64, n0 = (it % nblk) * 32; const int drow0 = t.map == 1 ? map_win(n0) : (t.map == 2 ? map_gu(n0) : n0);
        f32x4 ga = {1.f, 1.f, 1.f, 1.f}, gb = ga;
        if (t.g) { ga = *(const f32x4*)(t.g + k0 + 8 * c); gb = *(const f32x4*)(t.g + k0 + 8 * c + 4); }
        e16_t* wt = t.WT; const int ldo = t.ldo, koff = t.koff; const bool g8 = t.map == 1 && n0 >= 6144;
#pragma unroll
        for (int i = 0; i < 32; ++i) scr[(2 * i + (lane >> 5)) * 33 + (lane & 31)] = r[i];
        ++k; int id2, it2; const bool more = (k < k_hi) && job_decode(job, slot + k * stride, id2, it2);
        if (more) { t = weight_td(a, C, id2); nblk = t.N / 32; it = it2; const int k1 = (it / nblk) * 64, n1 = (it % nblk) * 32;
#pragma unroll
            for (int i = 0; i < 32; ++i) r[i] = t.W[(size_t)(k1 + 2 * i + (lane >> 5)) * t.N + n1 + (lane & 31)]; }
        LDS_WAIT(); asm volatile("" ::: "memory");
#pragma unroll
        for (int j = 0; j < 4; ++j) { const int n = (lane >> 3) + 8 * j; const LAS float* sp = scr + (8 * c) * 33 + n;
            float f0 = sp[0 * 33] * ga[0], f1 = sp[1 * 33] * ga[1], f2 = sp[2 * 33] * ga[2], f3 = sp[3 * 33] * ga[3], f4 = sp[4 * 33] * gb[0], f5 = sp[5 * 33] * gb[1], f6 = sp[6 * 33] * gb[2], f7 = sp[7 * 33] * gb[3];
            if (g8) { u32x2 o8; o8.x = (unsigned)__builtin_amdgcn_cvt_pk_fp8_f32(f2 * 64.f, f3 * 64.f, __builtin_amdgcn_cvt_pk_fp8_f32(f0 * 64.f, f1 * 64.f, 0, false), true);
                o8.y = (unsigned)__builtin_amdgcn_cvt_pk_fp8_f32(f6 * 64.f, f7 * 64.f, __builtin_amdgcn_cvt_pk_fp8_f32(f4 * 64.f, f5 * 64.f, 0, false), true);
                *(u32x2*)((unsigned char*)(wt + (size_t)4096 * ldo) + (size_t)(drow0 - 4096 + n) * 2048 + k0 + 8 * c) = o8; continue; }
            u32x4 o; o.x = cvt_pk(f0, f1); o.y = cvt_pk(f2, f3); o.z = cvt_pk(f4, f5); o.w = cvt_pk(f6, f7);
            *(u32x4*)(wt + (size_t)(drow0 + n) * ldo + koff + k0 + 8 * c) = o; }
        LDS_WAIT(); asm volatile("" ::: "memory");
        if (!more) break;
    }
}
__device__ __forceinline__ void rms_rows(const Ctx& C, const float* X, const float* g, e16_t* O, int rows) {
    for (int m = C.gw; m < rows; m += C.NGW) {
        const f32x4* xr = (const f32x4*)(X + (size_t)m * D_) + C.lane; f32x4 v[8]; float s = 0.f;
#pragma unroll
        for (int j = 0; j < 8; ++j) { v[j] = xr[64 * j]; s += (v[j].x * v[j].x + v[j].y * v[j].y) + (v[j].z * v[j].z + v[j].w * v[j].w); }
        const float rstd = rsqrtf(wave_sum(s) * (1.f / D_) + EPS);
        const f32x4* gr = (const f32x4*)g + C.lane; u32x2* o8 = (u32x2*)(O + (size_t)m * D_) + C.lane;
#pragma unroll
        for (int j = 0; j < 8; ++j) { const f32x4 gg = gr[64 * j]; u32x2 w; w.x = cvt_pk(v[j].x * rstd * gg.x, v[j].y * rstd * gg.y); w.y = cvt_pk(v[j].z * rstd * gg.z, v[j].w * rstd * gg.w); o8[64 * j] = w; }
    }
}

__device__ __forceinline__ void xb_rows(const Ctx& C, const float* X, e16_t* O, fx_t* rss, int rows, e16_t* O8) {
    for (int m = C.gw; m < rows; m += C.NGW) {
        const f32x4* xr = (const f32x4*)(X + (size_t)m * D_) + C.lane; u32x2* o8 = (u32x2*)(O + (size_t)m * D_) + C.lane; unsigned* q8 = (unsigned*)((unsigned char*)O8 + (size_t)m * D_) + C.lane; f32x4 v[8]; float s = 0.f;
#pragma unroll
        for (int j = 0; j < 8; ++j) { v[j] = xr[64 * j]; s += (v[j].x * v[j].x + v[j].y * v[j].y) + (v[j].z * v[j].z + v[j].w * v[j].w); }
#pragma unroll
        for (int j = 0; j < 8; ++j) { u32x2 w; w.x = cvt_pk(v[j].x, v[j].y); w.y = cvt_pk(v[j].z, v[j].w); o8[64 * j] = w;
            q8[64 * j] = (unsigned)__builtin_amdgcn_cvt_pk_fp8_f32(v[j].z, v[j].w, __builtin_amdgcn_cvt_pk_fp8_f32(v[j].x, v[j].y, 0, false), true); }
        s = wave_sum(s); if (C.lane == 0) rss[m] = f2fx(s);
    }
}
__device__ __forceinline__ void kmnorm_phase(const Ctx& C, const float* gkm) {
    for (int it = C.gw; it < NLAYER * NMEM * HM; it += C.NGW) { const int l = it >> 10, m = (it >> 2) & 255, hm = it & 3;
        e16_t* p = C.w16(WS_KM) + (size_t)l * NMEM * 1024 + (size_t)m * 1024 + hm * DMH + 4 * C.lane; const h4 raw = *(const h4*)p;
        float v[4]; float ss = 0.f;
#pragma unroll
        for (int i = 0; i < 4; ++i) { v[i] = up16(raw[i]); ss += v[i] * v[i]; }
        const float rstd = rsqrtf(wave_sum(ss) * (1.f / DMH) + EPS); const float* g = gkm + l * DMH + 4 * C.lane;
        u32x2 w; w.x = cvt_pk(v[0] * rstd * g[0], v[1] * rstd * g[1]); w.y = cvt_pk(v[2] * rstd * g[2], v[3] * rstd * g[3]); *(u32x2*)p = w; }
}
__device__ __forceinline__ void gating_phase(const Ctx& C, int l, const float* gq, const float* gk) {
    const e16_t* Z = C.w16(WS_Z); const float* KMEAN = (const float*)(C.ws + WS_KMEAN); unsigned* LIST = (unsigned*)(C.ws + WS_LIST); unsigned* SEL = (unsigned*)(C.ws + WS_SEL);
    unsigned* CNT = (unsigned*)(C.ws + WS_CTL) + CW_CNT + l * 256;
    LAS float* km = (LAS float*)C.lds;
    LAS unsigned* lcnt = (LAS unsigned*)(C.lds + 16384); LAS unsigned* lbase = lcnt + 32;
    for (int it = blockIdx.x; it < HA * NBLK; it += C.G) { const int h = it >> 5, b = it & 31;
        for (int i = C.tid; i < NBLK * DA; i += NTHREADS) km[i] = KMEAN[(size_t)h * NBLK * DA + i];
        if (C.tid < 32) lcnt[C.tid] = 0u;
        if (C.tid < 64) { float a = fmaxf(fabsf(gq[C.tid]), fabsf(gq[C.tid + 64])), bb = fmaxf(fabsf(gk[C.tid]), fabsf(gk[C.tid + 64]));
#pragma unroll
            for (int o = 1; o < 64; o <<= 1) { a = fmaxf(a, __shfl_xor(a, o)); bb = fmaxf(bb, __shfl_xor(bb, o)); }
            if (C.tid == 0) ((LAS float*)lcnt)[96] = 2.f * (16.3222f * 1.02f * a * bb) + 150.f; }
        __syncthreads();
        const float thr = ((LAS float*)lcnt)[96], slope2 = __builtin_amdgcn_exp2f(-(float)(h + 1)) * LOG2E;
        const int q = b * 256 + (C.tid >> 1), half = C.tid & 1; const int nsel = b < 3 ? b : 3;
        int i0 = 0, i1 = 1, i2 = 2;
        if (b > 3) {
            float qv[64]; float ss = 0.f; const e16_t* zr = Z + (size_t)q * ZP + ZQ + h * DA + half * 64;
#pragma unroll
            for (int c8 = 0; c8 < 8; ++c8) { const h8 r = *(const h8*)(zr + 8 * c8);
#pragma unroll
                for (int j = 0; j < 8; ++j) { const float f = up16(r[j]); qv[c8 * 8 + j] = f; ss += f * f; } }
            ss += __shfl_xor(ss, 1);
            const float rstd = rsqrtf(ss * (1.f / DA) + EPS);
#pragma unroll
            for (int d = 0; d < 64; ++d) qv[d] = qv[d] * rstd * gq[half * 64 + d];
            float v0 = -__builtin_inff(), v1 = v0, v2 = v0;
            for (int j = 0; j < b; ++j) { const LAS f32x4* kr = (const LAS f32x4*)(km + j * DA + half * 64); float g0 = 0.f, g1 = 0.f;
#pragma unroll
                for (int d4 = 0; d4 < 16; d4 += 2) { const f32x4 ka = kr[d4], kb = kr[d4 + 1];
                    g0 += (qv[4 * d4] * ka.x + qv[4 * d4 + 1] * ka.y) + (qv[4 * d4 + 2] * ka.z + qv[4 * d4 + 3] * ka.w);
                    g1 += (qv[4 * d4 + 4] * kb.x + qv[4 * d4 + 5] * kb.y) + (qv[4 * d4 + 6] * kb.z + qv[4 * d4 + 7] * kb.w); }
                float gt = g0 + g1; gt += __shfl_xor(gt, 1);
                if (gt > v0) { v2 = v1; i2 = i1; v1 = v0; i1 = i0; v0 = gt; i0 = j; }
                else if (gt > v1) { v2 = v1; i2 = i1; v1 = gt; i1 = j; }
                else if (gt > v2) { v2 = gt; i2 = j; } }
        }
        const bool u0 = nsel > 0 && !(slope2 * (float)(256 * (b - i0 - 1) + 1) > thr), u1 = nsel > 1 && !(slope2 * (float)(256 * (b - i1 - 1) + 1) > thr), u2 = nsel > 2 && !(slope2 * (float)(256 * (b - i2 - 1) + 1) > thr);
        unsigned p0 = 0u, p1 = 0u, p2 = 0u;
        if (half == 0) { if (u0) p0 = atomicAdd((unsigned*)&lcnt[i0], 1u); if (u1) p1 = atomicAdd((unsigned*)&lcnt[i1], 1u); if (u2) p2 = atomicAdd((unsigned*)&lcnt[i2], 1u);
            SEL[(size_t)h * S_ + q] = (u0 ? 0u : 1u) | (u1 ? 0u : 2u) | (u2 ? 0u : 4u); }
        __syncthreads();
        if (C.tid < 32) { const unsigned n = lcnt[C.tid]; lbase[C.tid] = n ? atomicAdd(&CNT[h * 32 + C.tid], n) : 0u; }
        __syncthreads();
        if (half == 0) { unsigned* L = LIST + (size_t)h * 32 * 8192;
            if (u0) L[(size_t)i0 * 8192 + lbase[i0] + p0] = (unsigned)q;
            if (u1) L[(size_t)i1 * 8192 + lbase[i1] + p1] = (unsigned)q | (1u << 16);
            if (u2) L[(size_t)i2 * 8192 + lbase[i2] + p2] = (unsigned)q | (2u << 16); }
        __syncthreads();
    }
}

__device__ __forceinline__ void softmax_step(f32x16& p, float& m, float& l, f32x16 (&acc)[4], h8& pb0, h8& pb1) {
    float mx = p[0];
#pragma unroll
    for (int r = 1; r < 16; ++r) mx = fmaxf(mx, p[r]);
    mx = fmaxf(mx, __shfl_xor(mx, 32));
    if (__any(mx > m)) {
        const float mn = fmaxf(m, mx); const float alpha = __builtin_amdgcn_exp2f(m - mn); m = mn; l *= alpha;
#pragma unroll
        for (int db = 0; db < 4; ++db)
#pragma unroll
            for (int r = 0; r < 16; ++r) acc[db][r] *= alpha; }
    float ps = 0.f;
#pragma unroll
    for (int r = 0; r < 16; ++r) { p[r] = __builtin_amdgcn_exp2f(p[r] - m); ps += p[r]; }
    l += ps;
    float t[8];
#pragma unroll
    for (int r = 0; r < 8; ++r) t[r] = p[r];
    pb0 = pack8(t);
#pragma unroll
    for (int r = 0; r < 8; ++r) t[r] = p[8 + r];
    pb1 = pack8(t);
}
__device__ __forceinline__ void pv_step(f32x16 (&acc)[4], const e16_t* vt, int vp, int hi, h8 pb0, h8 pb1) {
#pragma unroll
    for (int db = 0; db < 4; ++db) { const e16_t* vr = vt + (size_t)db * 32 * vp + 4 * hi;
        { const h4 lo = *(const h4*)(vr), hh = *(const h4*)(vr + 8); const h8 a = {lo[0], lo[1], lo[2], lo[3], hh[0], hh[1], hh[2], hh[3]}; acc[db] = MFMA32(a, pb0, acc[db]); }
        { const h4 lo = *(const h4*)(vr + 16), hh = *(const h4*)(vr + 24); const h8 a = {lo[0], lo[1], lo[2], lo[3], hh[0], hh[1], hh[2], hh[3]}; acc[db] = MFMA32(a, pb1, acc[db]); } }
}
__device__ __forceinline__ float store_o(const f32x16 (&acc)[4], float l, e16_t* yrow, int hi, bool valid = true) {
    l += __shfl_xor(l, 32); const float inv = 1.0f / l; if (!valid) return l;
#pragma unroll
    for (int db = 0; db < 4; ++db)
#pragma unroll
        for (int g = 0; g < 4; ++g) { u32x2 w; w.x = cvt_pk(acc[db][4 * g] * inv, acc[db][4 * g + 1] * inv); w.y = cvt_pk(acc[db][4 * g + 2] * inv, acc[db][4 * g + 3] * inv);
            *(u32x2*)(yrow + db * 32 + g * 8 + hi * 4) = w; }
    return l;
}

constexpr int LV_OFF = 65536, LV_PITCH = 520;
constexpr int LDS_CTL = 135168;
static_assert(LV_OFF + 128 * LV_PITCH <= LDS_CTL, "LDS map");
static_assert(256 * LV_PITCH <= LDS_CTL, "LDS map (memory attention V^T image)");

__device__ __forceinline__ void moba_wg(const Ctx& C, const float* gqa, int h, int j, int t, int ntile, int slot, bool valid, unsigned* q, int& knx) {
    int tid = C.tid; asm volatile("" : "+v"(tid));
    const int c = tid & 31, hi = (tid >> 5) & 1;
    const e16_t* Z = C.w16(WS_Z); const e16_t* ZT = C.w16(WS_ZT);
    LAS unsigned char* LK = C.lds; LAS unsigned char* LV = C.lds + LV_OFF;
    const float slope2 = __builtin_amdgcn_exp2f(-(float)(h + 1)) * LOG2E;
    h8 qf[8];
    { const e16_t* kg = Z + (size_t)(j * 256) * ZP + ZK + h * DA; const e16_t* vg = ZT + (size_t)(h * DA) * ZTP + j * 256;
      const e16_t* zq = Z + (size_t)t * ZP + ZQ + h * DA + hi * 8; h8 raw[8], kr[8], vr[8];
#pragma unroll
      for (int i = 0; i < 8; ++i) { const int row = i * 32 + (tid >> 4), ch = tid & 15; kr[i] = *(const h8*)(kg + (size_t)row * ZP + ch * 8); }
#pragma unroll
      for (int i = 0; i < 8; ++i) { const int idx = i * 512 + tid, d = idx >> 5, cc = idx & 31; vr[i] = *(const h8*)(vg + (size_t)d * ZTP + cc * 8); }
#pragma unroll
      for (int ks = 0; ks < 8; ++ks) raw[ks] = *(const h8*)(zq + ks * 16);
      float ss = 0.f;
#pragma unroll
      for (int ks = 0; ks < 8; ++ks)
#pragma unroll
          for (int jj = 0; jj < 8; ++jj) { const float f = up16(raw[ks][jj]); ss += f * f; }
      ss += __shfl_xor(ss, 32);
      const float sc = rsqrtf(ss * (1.f / DA) + EPS) * 0.08838834764831845f * LOG2E; const float* gq = gqa + hi * 8;
#pragma unroll
      for (int ks = 0; ks < 8; ++ks) { const f32x4 g0 = *(const f32x4*)(gq + ks * 16), g1 = *(const f32x4*)(gq + ks * 16 + 4); float f[8];
#pragma unroll
          for (int jj = 0; jj < 4; ++jj) { f[jj] = up16(raw[ks][jj]) * sc * g0[jj]; f[4 + jj] = up16(raw[ks][4 + jj]) * sc * g1[jj]; }
          qf[ks] = pack8(f); }
#pragma unroll
      for (int i = 0; i < 8; ++i) { const int row = i * 32 + (tid >> 4), ch = tid & 15; *(LAS h8*)(LK + row * 256 + ((ch ^ (row & 15)) << 4)) = kr[i]; }
#pragma unroll
      for (int i = 0; i < 8; ++i) { const int idx = i * 512 + tid, d = idx >> 5, cc = idx & 31; LAS h4* p = (LAS h4*)(LV + d * LV_PITCH + cc * 16);
          p[0] = (h4){vr[i][0], vr[i][1], vr[i][2], vr[i][3]}; p[1] = (h4){vr[i][4], vr[i][5], vr[i][6], vr[i][7]}; } }
    __syncthreads();
    if (tid == 0) knx = (int)atomicAdd(q, 1u);
    float m = -1e30f, lsum = 0.f; f32x16 acc[4];
#pragma unroll
    for (int db = 0; db < 4; ++db)
#pragma unroll
        for (int r = 0; r < 16; ++r) acc[db][r] = 0.f;
    const float NEG = -__builtin_inff();
    float sc[16];
#pragma unroll
    for (int r = 0; r < 16; ++r) sc[r] = slope2 * (float)crow(r, hi);
    for (int kt = 0; kt < ntile; ++kt) { const int kb = j * 256 + kt * 32;
        f32x16 p; const float base = slope2 * (float)(kb - t);
#pragma unroll
        for (int r = 0; r < 16; ++r) p[r] = sc[r] + base;
        const LAS unsigned char* kp = LK + (kt * 32 + c) * 256;
        h8 ka[8];
#pragma unroll
        for (int ks = 0; ks < 8; ++ks) ka[ks] = *(const LAS h8*)(kp + (((2 * ks + hi) ^ (c & 15)) << 4));
        u32x2 va[16];
#pragma unroll
        for (int db = 0; db < 4; ++db) { const LAS unsigned char* vp = LV + (db * 32 + c) * LV_PITCH + (kt * 32 + 4 * hi) * 2;
#pragma unroll
            for (int e = 0; e < 4; ++e) va[db * 4 + e] = *(const LAS u32x2*)(vp + 16 * e); }
        __builtin_amdgcn_sched_barrier(0);
#pragma unroll
        for (int ks = 0; ks < 8; ++ks) p = MFMA32(ka[ks], qf[ks], p);
        if (slot == 3 && kt == ntile - 1) {
#pragma unroll
            for (int r = 0; r < 16; ++r) { const int kpos = kb + crow(r, hi); p[r] = (kpos <= t) ? p[r] : NEG; } }
        h8 pb0, pb1; softmax_step(p, m, lsum, acc, pb0, pb1);
#pragma unroll
        for (int db = 0; db < 4; ++db) { const u32x4 a0 = {va[db * 4][0], va[db * 4][1], va[db * 4 + 1][0], va[db * 4 + 1][1]}, a1 = {va[db * 4 + 2][0], va[db * 4 + 2][1], va[db * 4 + 3][0], va[db * 4 + 3][1]};
            acc[db] = MFMA32(a0, pb0, acc[db]); acc[db] = MFMA32(a1, pb1, acc[db]); } }
    __syncthreads();
    if (ntile > 0) { e16_t* PART = C.w16(WS_PART); f32x2* ML = (f32x2*)(C.ws + WS_ML);
        const float lt = store_o(acc, lsum, PART + ((size_t)slot * S_ + t) * 1024 + h * DA, hi, valid);
        if (valid && hi == 0) ML[(size_t)(slot * HA + h) * S_ + t] = (f32x2){m, lt}; }
}
__device__ __forceinline__ void mem_wg(const Ctx& C, int l, const float* gqm, const float* gkm, int hm, int qb, unsigned* q, int& knx) {
    int tid = C.tid; asm volatile("" : "+v"(tid));
    const int c = tid & 31, hi = (tid >> 5) & 1, t = qb * 256 + C.wave * 32 + c;
    const e16_t* Z = C.w16(WS_Z); e16_t* Y = C.w16(WS_Y);
    const e16_t* KM = C.w16(WS_KM) + (size_t)l * NMEM * 1024 + hm * DMH; const e16_t* VMT = C.w16(WS_VMT) + (size_t)l * 1024 * NMEM + (size_t)(hm * DMH) * NMEM;
    LAS unsigned char* LK = C.lds;
    h8 qf[16]; float sbound;
    { h8 kr[16], raw[16]; const e16_t* zq = Z + (size_t)t * ZP + ZQM + hm * DMH + hi * 8;
#pragma unroll
      for (int i = 0; i < 16; ++i) { const int row = i * 16 + (tid >> 5), ch = tid & 31; kr[i] = *(const h8*)(KM + (size_t)row * 1024 + ch * 8); }
#pragma unroll
      for (int ks = 0; ks < 16; ++ks) raw[ks] = *(const h8*)(zq + ks * 16);
      const f32x4 gqv = *(const f32x4*)(gqm + 4 * (tid & 63)), gkv = *(const f32x4*)(gkm + 4 * (tid & 63));
#pragma unroll
      for (int i = 0; i < 16; ++i) { const int row = i * 16 + (tid >> 5), ch = tid & 31; *(LAS h8*)(LK + row * 512 + ((ch ^ (row & 15)) << 4)) = kr[i]; }
      float ss = 0.f;
#pragma unroll
      for (int ks = 0; ks < 16; ++ks)
#pragma unroll
          for (int j = 0; j < 8; ++j) { const float f = up16(raw[ks][j]); ss += f * f; }
      ss += __shfl_xor(ss, 32);
      { float a = fmaxf(fmaxf(fabsf(gqv.x), fabsf(gqv.y)), fmaxf(fabsf(gqv.z), fabsf(gqv.w))), b = fmaxf(fmaxf(fabsf(gkv.x), fabsf(gkv.y)), fmaxf(fabsf(gkv.z), fabsf(gkv.w)));
#pragma unroll
        for (int o = 1; o < 64; o <<= 1) { a = fmaxf(a, __shfl_xor(a, o)); b = fmaxf(b, __shfl_xor(b, o)); }
        sbound = 23.083f * 1.02f * a * b; }
#pragma unroll
      for (int ks = 0; ks < 16; ++ks) asm volatile("" : "+v"(raw[ks]));
      const float sc = rsqrtf(ss * (1.f / DMH) + EPS) * 0.0625f * LOG2E; const float* gq = gqm + hi * 8;
#pragma unroll
      for (int ks = 0; ks < 16; ++ks) { const f32x4 g0 = *(const f32x4*)(gq + ks * 16), g1 = *(const f32x4*)(gq + ks * 16 + 4); float f[8];
#pragma unroll
          for (int j = 0; j < 4; ++j) { f[j] = up16(raw[ks][j]) * sc * g0[j]; f[4 + j] = up16(raw[ks][4 + j]) * sc * g1[j]; }
          qf[ks] = pack8(f); } }
    __syncthreads();
    if (tid == 0) knx = (int)atomicAdd(q, 1u);
    h8 pb[8][2]; float lsum = 0.f;
    { float mx = -1e30f;
      const bool need_max = __builtin_amdgcn_readfirstlane(sbound > 90.f ? 1 : 0) != 0;
      if (!need_max) mx = 0.f;
#pragma unroll 1
      for (int kt = 0; kt < (need_max ? 8 : 0); ++kt) { f32x16 p;
#pragma unroll
          for (int r = 0; r < 16; ++r) p[r] = 0.f;
          const LAS unsigned char* kp = LK + (kt * 32 + c) * 512;
#pragma unroll
          for (int k8 = 0; k8 < 16; k8 += 8) { h8 ka[8];
#pragma unroll
              for (int ks = 0; ks < 8; ++ks) ka[ks] = *(const LAS h8*)(kp + (((2 * (k8 + ks) + hi) ^ (c & 15)) << 4));
              __builtin_amdgcn_sched_barrier(0);
#pragma unroll
              for (int ks = 0; ks < 8; ++ks) p = MFMA32(ka[ks], qf[k8 + ks], p); }
#pragma unroll
          for (int r = 0; r < 16; ++r) mx = fmaxf(mx, p[r]); }
      mx = fmaxf(mx, __shfl_xor(mx, 32));
#pragma unroll
      for (int kt = 0; kt < 8; ++kt) { f32x16 p; float tv[8];
#pragma unroll
          for (int r = 0; r < 16; ++r) p[r] = 0.f;
          const LAS unsigned char* kp = LK + (kt * 32 + c) * 512;
#pragma unroll
          for (int k8 = 0; k8 < 16; k8 += 8) { h8 ka[8];
#pragma unroll
              for (int ks = 0; ks < 8; ++ks) ka[ks] = *(const LAS h8*)(kp + (((2 * (k8 + ks) + hi) ^ (c & 15)) << 4));
              __builtin_amdgcn_sched_barrier(0);
#pragma unroll
              for (int ks = 0; ks < 8; ++ks) p = MFMA32(ka[ks], qf[k8 + ks], p); }
#pragma unroll
          for (int r = 0; r < 16; ++r) { p[r] = __builtin_amdgcn_exp2f(p[r] - mx); lsum += p[r]; }
#pragma unroll
          for (int r = 0; r < 8; ++r) tv[r] = p[r];
          pb[kt][0] = pack8(tv);
#pragma unroll
          for (int r = 0; r < 8; ++r) tv[r] = p[8 + r];
          pb[kt][1] = pack8(tv); } }
    lsum += __shfl_xor(lsum, 32);
    const float inv = 1.0f / lsum;
    __syncthreads();
    LAS unsigned char* LV = C.lds;
    { h8 vr[16];
#pragma unroll
      for (int i = 0; i < 16; ++i) { const int idx = i * 512 + tid, d = idx >> 5, cc = idx & 31; vr[i] = *(const h8*)(VMT + (size_t)d * NMEM + cc * 8); }
#pragma unroll
      for (int i = 0; i < 16; ++i) { const int idx = i * 512 + tid, d = idx >> 5, cc = idx & 31; LAS h4* pp = (LAS h4*)(LV + d * LV_PITCH + cc * 16);
          pp[0] = (h4){vr[i][0], vr[i][1], vr[i][2], vr[i][3]}; pp[1] = (h4){vr[i][4], vr[i][5], vr[i][6], vr[i][7]}; }
      asm volatile("" ::: "memory"); }
    __syncthreads();
    e16_t* yrow = Y + (size_t)t * YP + 2048 + hm * DMH;
#pragma unroll 1
    for (int dh = 0; dh < 2; ++dh) { f32x16 acc[4];
#pragma unroll
        for (int db = 0; db < 4; ++db)
#pragma unroll
            for (int r = 0; r < 16; ++r) acc[db][r] = 0.f;
#pragma unroll
        for (int kt = 0; kt < 8; ++kt) { u32x2 va[16];
#pragma unroll
            for (int db = 0; db < 4; ++db) { const LAS unsigned char* vp = LV + ((dh * 4 + db) * 32 + c) * LV_PITCH + (kt * 32 + 4 * hi) * 2;
#pragma unroll
                for (int e = 0; e < 4; ++e) va[db * 4 + e] = *(const LAS u32x2*)(vp + 16 * e); }
            __builtin_amdgcn_sched_barrier(0);
#pragma unroll
            for (int db = 0; db < 4; ++db) { const u32x4 a0 = {va[db * 4][0], va[db * 4][1], va[db * 4 + 1][0], va[db * 4 + 1][1]}, a1 = {va[db * 4 + 2][0], va[db * 4 + 2][1], va[db * 4 + 3][0], va[db * 4 + 3][1]};
                acc[db] = MFMA32(a0, pb[kt][0], acc[db]); acc[db] = MFMA32(a1, pb[kt][1], acc[db]); } }
#pragma unroll
        for (int db = 0; db < 4; ++db)
#pragma unroll
            for (int g = 0; g < 4; ++g) { u32x2 w; w.x = cvt_pk(acc[db][4 * g] * inv, acc[db][4 * g + 1] * inv); w.y = cvt_pk(acc[db][4 * g + 2] * inv, acc[db][4 * g + 3] * inv);
                *(u32x2*)(yrow + dh * 128 + db * 32 + g * 8 + hi * 4) = w; } }
    __syncthreads();
}
__device__ __forceinline__ void attn_combine_phase(const Ctx& C) {
    const e16_t* PART = C.w16(WS_PART); const f32x2* ML = (const f32x2*)(C.ws + WS_ML); e16_t* Y = C.w16(WS_Y);
    const int hh = C.lane >> 3, d0 = hh * DA + 16 * (C.lane & 7);
    const unsigned* SEL = (const unsigned*)(C.ws + WS_SEL);
    for (int tb = C.gw; tb < S_; tb += 2 * C.NGW) {
        int tt[2]; unsigned on[2]; f32x2 ml[2][4]; h8 pa[2][4], pb[2][4];
#pragma unroll
        for (int r = 0; r < 2; ++r) { tt[r] = (tb + r * C.NGW < S_) ? tb + r * C.NGW : tb; const int np = (tt[r] >> 8) < 3 ? (tt[r] >> 8) : 3; const unsigned skip = SEL[(size_t)hh * S_ + tt[r]];
            on[r] = 8u | (((1u << np) - 1u) & ~skip); }
#pragma unroll
        for (int r = 0; r < 2; ++r)
#pragma unroll
            for (int sl = 0; sl < 4; ++sl) { const int se = ((on[r] >> sl) & 1u) ? sl : 3; ml[r][sl] = ML[(size_t)(se * HA + hh) * S_ + tt[r]];
                const e16_t* pr = PART + ((size_t)se * S_ + tt[r]) * 1024 + d0; pa[r][sl] = *(const h8*)pr; pb[r][sl] = *(const h8*)(pr + 8); }
#pragma unroll
        for (int r = 0; r < 2; ++r) { float M = -1e30f;
#pragma unroll
            for (int sl = 0; sl < 4; ++sl) if ((on[r] >> sl) & 1u) M = fmaxf(M, ml[r][sl].x);
            float w[4], W = 0.f;
#pragma unroll
            for (int sl = 0; sl < 4; ++sl) { w[sl] = ((on[r] >> sl) & 1u) ? ml[r][sl].y * __builtin_amdgcn_exp2f(ml[r][sl].x - M) : 0.f; W += w[sl]; }
            const float iw = 1.0f / W; float o[16];
#pragma unroll
            for (int i = 0; i < 16; ++i) o[i] = 0.f;
#pragma unroll
            for (int sl = 0; sl < 4; ++sl) { const float ws = w[sl] * iw;
#pragma unroll
                for (int i = 0; i < 8; ++i) { o[i] += ws * up16(pa[r][sl][i]); o[8 + i] += ws * up16(pb[r][sl][i]); } }
            if (r == 0 || tb + C.NGW < S_) { *(h8*)(Y + (size_t)tt[r] * YP + d0) = pack8(o); *(h8*)(Y + (size_t)tt[r] * YP + d0 + 8) = pack8(o + 8); } }
    }
}
__device__ __forceinline__ void sgu_item(const Ctx& C, const float* wsgu, const float* bsgu, const float* gsgu, int n, int g, int w, unsigned* q, int& knx) {
    int ln = C.lane; asm volatile("" : "+v"(ln));
    const int c = ln & 31, hi = ln >> 5, tt = w & 3, cp = w >> 2, tl = 32 * tt + c, t = 128 * n + tl;
    const e16_t* Z = C.w16(WS_Z); const e16_t* ZT = C.w16(WS_ZT); e16_t* Y = C.w16(WS_Y); const float* RSTDV = (const float*)(C.ws + WS_RSTDV);
    const float* wrow = wsgu + ((size_t)g * 128 + tl) * 128;
    f32x16 a0, a1;
#pragma unroll
    for (int r = 0; r < 16; ++r) { a0[r] = 0.f; a1[r] = 0.f; }
    const e16_t* gv0 = ZT + (size_t)(1024 + g * 128 + (2 * cp) * 32 + c) * ZTP + 128 * n + 8 * hi; const e16_t* gv1 = gv0 + (size_t)32 * ZTP;
#pragma unroll
    for (int kh = 0; kh < 2; ++kh) {
        if (kh == 1 && tt < 2) break;
        f32x4 wv[4][2], rv[4][2]; h8 xv[4][2];
#pragma unroll
        for (int k4 = 0; k4 < 4; ++k4) { const int s0 = 16 * (kh * 4 + k4) + 8 * hi;
            wv[k4][0] = *(const f32x4*)(wrow + s0); wv[k4][1] = *(const f32x4*)(wrow + s0 + 4);
            rv[k4][0] = *(const f32x4*)(RSTDV + 128 * n + s0); rv[k4][1] = *(const f32x4*)(RSTDV + 128 * n + s0 + 4);
            xv[k4][0] = *(const h8*)(gv0 + (kh * 4 + k4) * 16); xv[k4][1] = *(const h8*)(gv1 + (kh * 4 + k4) * 16); }
#pragma unroll
        for (int k4 = 0; k4 < 4; ++k4) { const int s0 = 16 * (kh * 4 + k4) + 8 * hi; float f[8];
#pragma unroll
            for (int j = 0; j < 4; ++j) { f[j] = (s0 + j <= tl) ? wv[k4][0][j] * rv[k4][0][j] : 0.f; f[4 + j] = (s0 + 4 + j <= tl) ? wv[k4][1][j] * rv[k4][1][j] : 0.f; }
            const h8 bf = pack8(f); a0 = MFMA32(xv[k4][0], bf, a0); a1 = MFMA32(xv[k4][1], bf, a1); } }
    const float bias = bsgu[g * 128 + tl]; const float* gs = gsgu;
    h4 urv[2][4]; f32x4 ggv[2][4];
#pragma unroll
    for (int cbi = 0; cbi < 2; ++cbi)
#pragma unroll
        for (int gq = 0; gq < 4; ++gq) { const int col = g * 128 + (2 * cp + cbi) * 32 + 8 * gq + 4 * hi; urv[cbi][gq] = *(const h4*)(Z + (size_t)t * ZP + ZU + col); ggv[cbi][gq] = *(const f32x4*)(gs + col); }
    if (w == 0 && ln == 0) knx = (int)atomicAdd(q, 1u);
#pragma unroll
    for (int cbi = 0; cbi < 2; ++cbi)
#pragma unroll
        for (int gq = 0; gq < 4; ++gq) { const int col = g * 128 + (2 * cp + cbi) * 32 + 8 * gq + 4 * hi; const h4 ur = urv[cbi][gq]; const f32x4 gg = ggv[cbi][gq]; float o[4];
#pragma unroll
            for (int i = 0; i < 4; ++i) { const float mix = gg[i] * (cbi == 0 ? a0[4 * gq + i] : a1[4 * gq + i]) + bias; o[i] = gelu_tanh(up16(ur[i])) * mix; }
            u32x2 wv; wv.x = cvt_pk(o[0], o[1]); wv.y = cvt_pk(o[2], o[3]); *(u32x2*)(Y + (size_t)t * YP + 1024 + col) = wv; }
}
#define XB_TMO      128
#define XB_XCNT(j)  (256  + 64 * (j))
#define XB_XSUB(j)  (1280 + 64 * (j))
#define XB_XGEN(j)  (2304 + 64 * (j))
#define XB_TOP      3328
#define XB_TOPGEN   3392
#define XCD_BAR_WORDS 3456
#define XB_SPIN_CAP (1u << 18)
constexpr int CW_BAR = 4096;
__device__ __forceinline__ unsigned xb_ld(unsigned* p)              { return __hip_atomic_load(p, __ATOMIC_RELAXED, __HIP_MEMORY_SCOPE_AGENT); }
__device__ __forceinline__ unsigned xb_add(unsigned* p, unsigned v) { return __hip_atomic_fetch_add(p, v, __ATOMIC_RELAXED, __HIP_MEMORY_SCOPE_AGENT); }
__device__ __forceinline__ unsigned xb_xcc_id() { return (unsigned)__builtin_amdgcn_s_getreg((3 << 11) | 20) & 0xFu; }
#define XB_SPIN(cond, bar) do { unsigned _sp = 0; while (cond) { __builtin_amdgcn_s_sleep(1); \
    if ((++_sp & 255u) == 0u) { if (xb_ld(&(bar)[XB_TMO])) break; if (_sp > XB_SPIN_CAP) { atomicAdd(&(bar)[XB_TMO], 1u); break; } } } } while (0)
struct XcdBarrier { unsigned* bar; unsigned x; volatile LAS unsigned* st; };
__device__ __forceinline__ XcdBarrier xcd_barrier_post(unsigned* bar, volatile LAS unsigned* st) {
    XcdBarrier b; b.bar = bar; b.x = xb_xcc_id(); b.st = st;
    if (threadIdx.x == 0) (void)xb_add(&bar[XB_XCNT(b.x)], 1u);
    return b;
}
__device__ __forceinline__ void xcd_barrier_complete(unsigned* bar, unsigned x, unsigned& nloc, unsigned& nx) {
    const unsigned G = gridDim.x * gridDim.y * gridDim.z;
    unsigned sum, cnt, mine, sp = 0u;
    for (;;) {
        sum = 0u; cnt = 0u; mine = 0u;
#pragma unroll
        for (unsigned j = 0; j < 16; ++j) { const unsigned c = xb_ld(&bar[XB_XCNT(j)]); sum += c; cnt += (c > 0u) ? 1u : 0u; mine = (j == x) ? c : mine; }
        if (sum == G) break;
        __builtin_amdgcn_s_sleep(1);
        if ((++sp & 255u) == 0u) { if (xb_ld(&bar[XB_TMO])) break; if (sp > XB_SPIN_CAP) { atomicAdd(&bar[XB_TMO], 1u); break; } }
    }
    nloc = mine > 0u ? mine : 1u; nx = cnt > 0u ? cnt : 1u;
}
__device__ __forceinline__ void xcd_barrier(const XcdBarrier& b) {
    asm volatile("s_waitcnt vmcnt(0)" ::: "memory");
    __syncthreads();
    if (threadIdx.x == 0) {
        unsigned* bar = b.bar; asm volatile("" : "+s"(bar));
        __builtin_amdgcn_s_waitcnt(0);
        unsigned nloc = b.st[0], nx = b.st[1];
        if (nloc == 0u) { xcd_barrier_complete(bar, b.x, nloc, nx); b.st[0] = nloc; b.st[1] = nx; }
        const unsigned old = xb_add(&bar[XB_XSUB(b.x)], 1u);
        const unsigned gen = old / nloc;
        if (old + 1u == (gen + 1u) * nloc) {
            __builtin_amdgcn_fence(__ATOMIC_RELEASE, "agent");
            asm volatile("s_waitcnt vmcnt(0)" ::: "memory");
            const unsigned og = xb_add(&bar[XB_TOP], 1u);
            const unsigned tg = og / nx;
            if (og + 1u == (tg + 1u) * nx) xb_add(&bar[XB_TOPGEN], 1u);
            else XB_SPIN(xb_ld(&bar[XB_TOPGEN]) == tg, bar);
            __builtin_amdgcn_fence(__ATOMIC_ACQUIRE, "agent");
            xb_add(&bar[XB_XGEN(b.x)], 1u);
            asm volatile("s_waitcnt vmcnt(0)" ::: "memory");
        } else {
            XB_SPIN(xb_ld(&bar[XB_XGEN(b.x)]) == gen, bar);
            __builtin_amdgcn_fence(__ATOMIC_ACQUIRE, "agent");
            asm volatile("s_waitcnt vmcnt(0)" ::: "memory");
        }
    }
    __syncthreads();
}

constexpr int CW_SEAM = 16384;
constexpr int CW_SPLIT = 12288;
struct SplitBar { unsigned* ctr; unsigned* bar; unsigned x; volatile LAS unsigned* st; };
__device__ __forceinline__ void split_arrive(const SplitBar& b) {
    asm volatile("s_waitcnt vmcnt(0)" ::: "memory");
    __syncthreads();
    if (threadIdx.x == 0) { unsigned nloc = b.st[0];
        if (nloc == 0u) { unsigned nx; __builtin_amdgcn_s_waitcnt(0); xcd_barrier_complete(b.bar, b.x, nloc, nx); b.st[0] = nloc; b.st[1] = nx; }
        const unsigned old = xb_add(b.ctr + 32 * b.x, 1u);
        if (old + 1u == nloc) { __builtin_amdgcn_fence(__ATOMIC_RELEASE, "agent"); asm volatile("s_waitcnt vmcnt(0)" ::: "memory"); (void)xb_add(b.ctr + 32 * 16, nloc); }
        asm volatile("buffer_inv sc1" ::: "memory"); }
}
__device__ __forceinline__ void split_wait(const SplitBar& b) {
    if (threadIdx.x == 0) { const unsigned G = gridDim.x; XB_SPIN(xb_ld(b.ctr + 32 * 16) != G, b.bar); asm volatile("s_waitcnt vmcnt(0)" ::: "memory"); }
    __syncthreads();
}
struct MixP { const float *gqa, *gqm, *gkm, *wsgu, *bsgu, *gsgu; };
__device__ __forceinline__ void mixer_phase(const Ctx& C, int l, const MixP& P, const XcdBarrier& xb) {
    unsigned* ctl = (unsigned*)(C.ws + WS_CTL);
    const SplitBar b1{ctl + CW_SPLIT + 544 * (2 * l), ctl + CW_BAR, xb.x, xb.st}, b2{ctl + CW_SPLIT + 544 * (2 * l + 1), ctl + CW_BAR, xb.x, xb.st};
    const unsigned* CNT = (const unsigned*)(C.ws + WS_CTL) + CW_CNT + l * 256; const unsigned* LIST = (const unsigned*)(C.ws + WS_LIST);
    LAS unsigned* pre = (LAS unsigned*)(C.lds + LDS_CTL + 256);
    LAS unsigned* nch = pre + 256; LAS int* bc = (LAS int*)(C.lds + LDS_CTL + 64); LAS unsigned* cntl = (LAS unsigned*)(C.lds + LDS_CTL + 2816);
    const int myq = (int)(__builtin_amdgcn_s_getreg((3 << 11) | 20) & 7u);
    constexpr int N_OWNWG = HA * NBLK, N_MEMWG = HM * NBLK, N_SGUWG = 64 * 8;
    split_arrive(b1);
    int npast = 0;
#pragma unroll 1
    for (int st = 0; st < 3; ++st) {
        int kfirst = 0; if (C.tid == 0) kfirst = (int)atomicAdd(ctl + 8192 + 64 * ((l * 3 + st) * 8) + 64 * myq, 1u);
        if (st == 1) { split_wait(b1);
            int tq = C.tid; asm volatile("" : "+v"(tq));
            if (tq < 256) { const unsigned cn = CNT[tq]; cntl[tq] = cn; nch[tq] = (cn + 255u) >> 8; }
            __syncthreads();
            if (tq < 256) { unsigned sum = 0u; for (int k = 0; k < 256; ++k) { const unsigned v = nch[k]; sum += (k <= tq) ? v : 0u; } pre[tq] = sum; }
            __syncthreads();
            npast = (int)pre[255]; }
        if (st == 2) split_arrive(b2);
        unsigned* qbase = ctl + 8192 + 64 * ((l * 3 + st) * 8);
        const int nA = st == 0 ? N_OWNWG : (st == 1 ? N_MEMWG : N_SGUWG), nB = st == 1 ? npast : 0;
#define QTOT(x_) (((nA * ((x_) + 1)) >> 3) - ((nA * (x_)) >> 3) + (int)(((long)nB * ((x_) + 1)) >> 3) - (int)(((long)nB * (x_)) >> 3))
        int x = myq;
        for (;;) { unsigned* q = qbase + 64 * x;
            const int a_lo = (nA * x) >> 3, a_n = ((nA * (x + 1)) >> 3) - a_lo;
            const int p_lo = (int)(((long)nB * x) >> 3), p_n = (int)(((long)nB * (x + 1)) >> 3) - p_lo;
            const int ntot = a_n + p_n;
            int knx = kfirst; if (C.tid == 0 && x != myq) knx = (int)atomicAdd(q, 1u);
            for (;;) { if (C.tid == 0) bc[0] = knx;
                __syncthreads(); int k = bc[0]; __syncthreads();
                if (k >= ntot) break;
                if (st == 2) { const int jj = a_lo + k; sgu_item(C, P.wsgu, P.bsgu, P.gsgu, jj >> 3, jj & 7, C.wave, q, knx); continue; }
                if (st == 1 && k < a_n) { const int jj = a_lo + k; mem_wg(C, l, P.gqm, P.gkm, jj >> 5, jj & 31, q, knx); continue; }
                int h_, j_, t_, nt_, sl_; bool va_;
                if (st == 1) { const int it = p_lo + (k - a_n);
                    int lo = 0, hi2 = 255;
                    while (lo < hi2) { const int mid = (lo + hi2) >> 1; if ((int)pre[mid] > it) hi2 = mid; else lo = mid + 1; }
                    const int hj = __builtin_amdgcn_readfirstlane(lo), chunk = it - (hj ? (int)pre[hj - 1] : 0), n = (int)cntl[hj];
                    const int e0 = chunk * 256 + C.wave * 32, e = e0 + (C.lane & 31); va_ = e < n;
                    const unsigned ent = LIST[(size_t)hj * 8192 + (va_ ? e : chunk * 256)];
                    h_ = hj >> 5; j_ = hj & 31; t_ = (int)(ent & 0xffffu); nt_ = e0 < n ? 8 : 0; sl_ = (int)(ent >> 16);
                } else { const int jj = a_lo + k;
                    const int qt = C.wave < 4 ? C.wave : 11 - C.wave;
                    h_ = jj >> 5; j_ = 31 - (jj & 31); t_ = j_ * 256 + qt * 32 + (C.lane & 31); nt_ = qt + 1; sl_ = 3; va_ = true; }
                moba_wg(C, P.gqa, h_, j_, t_, nt_, sl_, va_, q, knx); }
            if (C.tid == 0) { unsigned cv[8];
#pragma unroll
                for (int y = 0; y < 8; ++y) cv[y] = __hip_atomic_load(qbase + 64 * y, __ATOMIC_RELAXED, __HIP_MEMORY_SCOPE_AGENT);
                int nxq = -1;
#pragma unroll
                for (int sq = 7; sq >= 1; --sq) { const int y = (myq + sq) & 7; if ((int)cv[y] < QTOT(y)) nxq = y; }
                bc[1] = nxq; }
            __syncthreads(); x = bc[1]; __syncthreads();
            if (x < 0) break;
        }
#undef QTOT
    }
    split_wait(b2);
}

#define INP(k) ((const float*)(((unsigned long long)(unsigned)__builtin_amdgcn_readfirstlane((int)((volatile LAS unsigned*)(C.lds + LDS_CTL + 2560))[2 * (k) + 1]) << 32) | (unsigned long long)(unsigned)__builtin_amdgcn_readfirstlane((int)((volatile LAS unsigned*)(C.lds + LDS_CTL + 2560))[2 * (k)])))
__global__ void __launch_bounds__(NTHREADS, 2) fwd_kernel(Args args) {
    extern __shared__ __attribute__((aligned(16))) unsigned char lds_raw[];
    cg::grid_group grid = cg::this_grid();
    Ctx C; C.lds = (LAS unsigned char*)lds_raw; C.tid = threadIdx.x; C.lane = C.tid & 63; C.wave = __builtin_amdgcn_readfirstlane(C.tid >> 6);
    C.G = gridDim.x; C.gw = blockIdx.x * NWAVES + C.wave; C.NGW = C.G * NWAVES;
    C.out = args.out; C.ws = args.ws;
    const int lo = args.ph_lo, hi = args.ph_hi;
    const int wave0 = __builtin_amdgcn_readfirstlane(threadIdx.x >> 6);
    volatile LAS unsigned* bst = (volatile LAS unsigned*)(C.lds + LDS_CTL);
    if (threadIdx.x < 2) bst[threadIdx.x] = 0u;
    if (threadIdx.x < 18) ((LAS unsigned long long*)(C.lds + LDS_CTL + 2560))[threadIdx.x] = (unsigned long long)args.in[threadIdx.x];
    __syncthreads();
    const XcdBarrier xbar = xcd_barrier_post((unsigned*)(args.ws + WS_CTL) + CW_BAR, bst);
    LAS unsigned char* ring = C.lds;
#pragma unroll 1
    for (int ph = lo; ph < hi; ++ph) {
#define REFRESH_TID do { int w0_ = wave0; asm volatile("" : "+s"(w0_)); int tid_ = w0_ * 64 + (int)__builtin_amdgcn_mbcnt_hi(~0u, __builtin_amdgcn_mbcnt_lo(~0u, 0u)); asm volatile("" : "+v"(tid_)); C.tid = tid_; C.lane = tid_ & 63; C.wave = w0_; } while (0)
        REFRESH_TID;
        int bx = blockIdx.x; asm volatile("" : "+s"(bx)); C.gw = bx * NWAVES + C.wave; size_t zo_ = 0; asm volatile("" : "+s"(zo_)); C.ws = args.ws + zo_; C.out = args.out + zo_;
        int l = ph == 0 ? 0 : (ph - 1) / 6, kp = ph == 0 ? -1 : (ph - 1) % 6; asm volatile("" : "+s"(l), "+s"(kp));
        int cj = -1, cslot = 0, cstride = 1;
        if (kp < 0) {
            for (int pl = 0; pl < NLAYER; ++pl) rms_rows(C, INP(1), INP(11) + pl * D_, C.w16(WS_MEMN) + (size_t)pl * NMEM * D_, NMEM);
            { fx_t* RSS = (fx_t*)(C.ws + WS_RSS); xb_rows(C, INP(0), C.w16(WS_HN), RSS, S_, C.w16(WS_X8));
              for (int i = bx * NTHREADS + C.tid; i < 3 * S_; i += C.G * NTHREADS) RSS[S_ + i] = 0ull;
              fx_t* RSSV = (fx_t*)(C.ws + WS_RSSV); for (int i = bx * NTHREADS + C.tid; i < S_; i += C.G * NTHREADS) RSSV[i] = 0ull;
              unsigned* ONES = (unsigned*)(C.ws + WS_ONES);
_Pragma("unroll 1")
              for (int b = bx; b < 64; b += C.G) ONES[b * NTHREADS + C.tid] = 0x3F803F80u; }
            cj = 0; cslot = C.gw; cstride = C.NGW;
        } else if (kp == 0) {
            { pg8::Gemm g{C.w16(WS_HN), C.wl(l, WL_IN), S_, 4096, D_, D_, D_}; pg8::StaticOrder S; S.init(S_, 4096, C.G, bx); pg8::EpiZ E{C.w16(WS_Z), C.w16(WS_GATE), (const pg8::fx_t*)(C.ws + WS_RSS) + (size_t)(2 * l) * S_, C.lds, INP(5) + l * DA, (float*)(C.ws + WS_KMEAN), 0};
              pg8::gemm_phase<pg8::EpiZ, pg8::StaticOrder>(ring, C.tid, g, S, E); }
            REFRESH_TID;
            { int k8 = D_ / 2; asm volatile("" : "+s"(k8));
              pg8::Gemm g{C.w16(WS_X8), C.wl(l, WL_IN) + (size_t)4096 * D_, S_, 6144, k8, D_ / 2, D_ / 2}; pg8::StaticOrder S; S.init(S_, 6144, C.G, bx); pg8::EpiGate E{C.w16(WS_GATE), (const pg8::fx_t*)(C.ws + WS_RSS) + (size_t)(2 * l) * S_, C.lds};
              pg8::gemm_phase<pg8::EpiGate, pg8::StaticOrder, true, true, true>(ring, C.tid, g, S, E); }
            REFRESH_TID;
            { pg8::Gemm g{C.wl(l, WL_IN) + (size_t)ZN * D_, C.w16(WS_HN), 2048, S_, D_, D_, D_}; pg8::StaticOrder S; S.init(2048, S_, C.G, bx); pg8::EpiStore16 E{C.w16(WS_ZT), ZTP, (const pg8::fx_t*)(C.ws + WS_RSS) + (size_t)(2 * l) * S_, 2, (pg8::fx_t*)(C.ws + WS_RSSV)};
              pg8::gemm_phase<pg8::EpiStore16, pg8::StaticOrder>(ring, C.tid, g, S, E); }
            if (l == 0) for (int ll = 0; ll < NLAYER; ++ll) {
                REFRESH_TID;
                { pg8::Gemm g{C.w16(WS_MEMN) + (size_t)ll * NMEM * D_, C.wl(ll, WL_M), NMEM, 1024, D_, D_, D_}; pg8::StaticOrder S; S.init(NMEM, 1024, C.G, (bx + C.G - 8 * ll) % C.G);
                  pg8::EpiStore16 E{C.w16(WS_KM) + (size_t)ll * NMEM * 1024, 1024, nullptr, 0, nullptr}; pg8::gemm_phase<pg8::EpiStore16, pg8::StaticOrder>(ring, C.tid, g, S, E); }
                REFRESH_TID;
                { pg8::Gemm g{C.wl(ll, WL_M) + (size_t)1024 * D_, C.w16(WS_MEMN) + (size_t)ll * NMEM * D_, 1024, NMEM, D_, D_, D_}; pg8::StaticOrder S; S.init(1024, NMEM, C.G, (bx + C.G - 8 * ll - 4) % C.G);
                  pg8::EpiStore16 E{C.w16(WS_VMT) + (size_t)ll * 1024 * NMEM, NMEM, nullptr, 0, nullptr}; pg8::gemm_phase<pg8::EpiStore16, pg8::StaticOrder>(ring, C.tid, g, S, E); } }
            if (l == 0 && bx >= 16) { cj = 1; cslot = (bx - 16) * NWAVES + C.wave; cstride = (C.G - 16) * NWAVES; }
        } else if (kp == 1) {
            if (l == 0) kmnorm_phase(C, INP(10));
            { const fx_t* RSSV = (const fx_t*)(C.ws + WS_RSSV); float* RSTDV = (float*)(C.ws + WS_RSTDV); for (int i = bx * NTHREADS + C.tid; i < S_; i += C.G * NTHREADS) RSTDV[i] = rsqrtf(fx2f(RSSV[i]) * (1.f / 1024.f) + EPS); }
            gating_phase(C, l, INP(4) + l * DA, INP(5) + l * DA);
            { MixP P{INP(4) + l * DA, INP(9) + l * DMH, INP(10) + l * DMH, INP(7) + (size_t)l * 8 * 128 * 128, INP(8) + l * 8 * 128, INP(6) + l * 1024}; mixer_phase(C, l, P, xbar); }
            attn_combine_phase(C);
        } else if (kp == 2) {
            { pg8::Gemm g{C.w16(WS_Y), C.wl(l, WL_B), S_, D_, 3072, YP, 3072}; pg8::StaticOrder S; S.init(S_, D_, C.G, bx); pg8::EpiMerge E{C.w16(WS_GATE), C.w16(WS_MG)};
              pg8::gemm_phase<pg8::EpiMerge, pg8::StaticOrder>(ring, C.tid, g, S, E); }
        } else if (kp == 3) {
            { pg8::Gemm g{C.w16(WS_MG), C.wl(l, WL_O), S_, D_, D_, D_, D_}; pg8::StaticOrder S; S.init(S_, D_, C.G, bx); pg8::EpiRes E{INP(0), l == 0 ? (const e16_t*)nullptr : (const e16_t*)C.w16(WS_HN), nullptr, C.w16(WS_HN), (pg8::fx_t*)(C.ws + WS_RSS) + (size_t)(2 * l + 1) * S_, D_, nullptr};
              pg8::gemm_phase<pg8::EpiRes, pg8::StaticOrder>(ring, C.tid, g, S, E); }
        } else if (kp == 4) {
            { pg8::Gemm g{C.w16(WS_HN), C.wl(l, WL_GU), S_, 2 * DFF, D_, D_, D_}; pg8::StaticOrder S; S.init(S_, 2 * DFF, C.G, bx); pg8::EpiSwiGLU E{C.w16(WS_GATE), DFF, (const pg8::fx_t*)(C.ws + WS_RSS) + (size_t)(2 * l + 1) * S_, C.lds};
              pg8::gemm_phase<pg8::EpiSwiGLU, pg8::StaticOrder>(ring, C.tid, g, S, E); }
            if (bx >= C.G / 2) { cj = 2 + l; cslot = (bx - C.G / 2) * NWAVES + C.wave; cstride = (C.G / 2) * NWAVES; }
        } else {
            if (bx == 0 && l + 1 < NLAYER) { fx_t* RSSV = (fx_t*)(C.ws + WS_RSSV); for (int i = C.tid; i < S_; i += NTHREADS) RSSV[i] = 0ull; }
            { pg8::Gemm g{C.w16(WS_GATE), C.wl(l, WL_D), S_, D_, DFF, DFF, DFF}; pg8::StaticOrder S; S.init(S_, D_, C.G, bx); pg8::EpiRes E{nullptr, C.w16(WS_HN), l + 1 < NLAYER ? (float*)nullptr : C.out, l + 1 < NLAYER ? C.w16(WS_HN) : (e16_t*)nullptr, l + 1 < NLAYER ? (pg8::fx_t*)(C.ws + WS_RSS) + (size_t)(2 * l + 2) * S_ : (pg8::fx_t*)nullptr, D_, l + 1 < NLAYER ? C.w16(WS_X8) : (e16_t*)nullptr};
              pg8::gemm_phase<pg8::EpiRes, pg8::StaticOrder>(ring, C.tid, g, S, E); }
        }
        REFRESH_TID;
        const bool seam = ph + 1 < hi, fill = seam && ph < 12;
        unsigned* ctl_ = (unsigned*)C.ws; const SplitBar sb_{ctl_ + CW_SEAM + 544 * (ph < 12 ? ph : 0), ctl_ + CW_BAR, xbar.x, xbar.st};
        int chi = 1 << 20;
#pragma unroll 1
        for (int r = 0; r < 2; ++r) {
            if (r == 1) { if (!fill) break; split_arrive(sb_); cj = ph < 10 ? 4 : -1; cslot = ph * 2048 + C.gw; cstride = C.NGW; chi = 1;
                const int s2 = ph == 0 ? 0 : (ph == 1 ? 1 : (ph == 6 ? 2 : (ph == 7 ? 3 : -1)));
                if (s2 >= 0) { cstride = 20480 + (s2 - ph) * 2048; chi = 2; } }
            if (cj >= 0) convert_job(args, C, cj, cslot, cstride, 0, chi, (LAS float*)(C.lds + C.wave * 16384)); }
        if (seam) { if (hi < 0) grid.sync(); if (fill) split_wait(sb_); else xcd_barrier(xbar); }
    }
}
constexpr int N_PHASES = 1 + NLAYER * 6;

extern "C" void kernel_launch(void* const* d_in, const int* in_sizes, int n_in, void* d_out, int out_size, void* d_ws, size_t ws_size, hipStream_t stream) {
    static int grid = 0;
    if (grid == 0) {
        if (n_in != 18 || in_sizes[0] != S_ * D_ || out_size != S_ * D_ || ws_size < WS_END) {
            fprintf(stderr, "kernel_launch: unexpected shapes / workspace (n_in %d, in0 %d, out %d, ws %zu, need %zu); nothing launched\n", n_in, n_in > 0 ? in_sizes[0] : -1, out_size, ws_size, (size_t)WS_END); grid = -1; return; }
        int dev = 0, cus = 0, per_cu = 0;
        if (hipGetDevice(&dev) != hipSuccess || hipDeviceGetAttribute(&cus, hipDeviceAttributeMultiprocessorCount, dev) != hipSuccess) { grid = -1; return; }
        if (hipFuncSetAttribute((const void*)fwd_kernel, hipFuncAttributeMaxDynamicSharedMemorySize, LDS_BYTES) != hipSuccess) { fprintf(stderr, "kernel_launch: hipFuncSetAttribute failed\n"); grid = -1; return; }
        if (hipOccupancyMaxActiveBlocksPerMultiprocessor(&per_cu, (const void*)fwd_kernel, NTHREADS, LDS_BYTES) != hipSuccess || per_cu < 1) { fprintf(stderr, "kernel_launch: occupancy query says %d\n", per_cu); per_cu = 1; }
        (void)hipGetLastError();
        grid = cus * 1;
        fprintf(stderr, "kernel_launch: grid %d (cus %d, per_cu %d), ws %zu\n", grid, cus, per_cu, ws_size);
    }
    if (grid < 0) return;
    (void)hipMemsetAsync((char*)d_ws + WS_CTL, 0, 131072, stream);
    Args a{};
    for (int i = 0; i < 18; ++i) a.in[i] = (const float*)d_in[i];
    a.out = (float*)d_out; a.ws = (unsigned char*)d_ws; a.ph_lo = 0; a.ph_hi = N_PHASES;
    void* kargs[] = {&a};
    hipError_t e = hipLaunchCooperativeKernel((const void*)fwd_kernel, dim3(grid), dim3(NTHREADS), kargs, LDS_BYTES, stream);
    if (e != hipSuccess) fprintf(stderr, "kernel_launch: cooperative launch failed: %s (grid %d)\n", hipGetErrorString(e), grid);
}
```
